# Optimizing an MI355X kernel written in HIP

```python
import math
import jax, jax.numpy as jnp
from jax import lax
import numpy as np

D_MODEL = 1024
BATCH = 16
SEQ = 4096
DEPTH = 4

GRID_W = 64
CTX_LEN = 256
POOL_WIDTH = 512
POOL_GROUPS = 4
POOL_WINDOWS = (2, 4, 8, 16)
GLA_HEADS = 4
GLA_DK = 128
GLA_DV = 256
QK_W = GLA_HEADS * GLA_DK
V_W = GLA_HEADS * GLA_DV
GLA_GATE_RANK = 16
GLA_GATE_TEMP = 16.0
GLA_CHUNK = 64
FFN_HIDDEN = 2816
CONV_WIDTH = 3
DEEPNORM_ALPHA = (2.0 * DEPTH) ** 0.25
DEEPNORM_BETA = (8.0 * DEPTH) ** -0.25
LN_EPS = 1e-6
IN_WIDTHS = (POOL_WIDTH, QK_W, QK_W, V_W, V_W, GLA_GATE_RANK, GLA_GATE_RANK, D_MODEL, D_MODEL)
IN_SPLITS = tuple(int(s) for s in np.cumsum(IN_WIDTHS)[:-1])
N_IN = int(sum(IN_WIDTHS))

kernel_name = "hybrid_pool_gla_convffn_dit"


def layer_norm(x, w=None, b=None):
    xf = x.astype(jnp.float32)
    mu = jnp.mean(xf, -1, keepdims=True)
    var = jnp.mean(jnp.square(xf - mu), -1, keepdims=True)
    y = (xf - mu) * lax.rsqrt(var + LN_EPS)
    if w is not None:
        y = y * w.astype(jnp.float32) + b.astype(jnp.float32)
    return y.astype(x.dtype)


def pos_embed_2d(rows, cols, dim):
    quarter = dim // 4
    omega = 1.0 / (10000.0 ** (jnp.arange(quarter, dtype=jnp.float32) / quarter))
    r = jnp.arange(rows, dtype=jnp.float32)[:, None] * omega
    cl = jnp.arange(cols, dtype=jnp.float32)[:, None] * omega
    er = jnp.concatenate([jnp.sin(r), jnp.cos(r)], -1)
    ec = jnp.concatenate([jnp.sin(cl), jnp.cos(cl)], -1)
    emb = jnp.concatenate([jnp.broadcast_to(er[:, None, :], (rows, cols, dim // 2)),
                           jnp.broadcast_to(ec[None, :, :], (rows, cols, dim // 2))], -1)
    return emb.reshape(rows * cols, dim)


def pool_minus_self(p, axis, window):
    L = p.shape[axis]
    pf = p.astype(jnp.float32)
    pad_cfg = [(0, 0)] * p.ndim
    pad_cfg[axis] = (1, 0)
    cs = jnp.pad(jnp.cumsum(pf, axis=axis), pad_cfg)
    t = jnp.arange(L)
    lo = jnp.clip(t - window // 2, 0, L)
    hi = jnp.clip(t + window // 2, 0, L)
    s = jnp.take(cs, hi, axis=axis) - jnp.take(cs, lo, axis=axis)
    shape = [1] * p.ndim
    shape[axis] = L
    cnt = (hi - lo).astype(jnp.float32).reshape(shape)
    return (s / cnt - pf).astype(p.dtype)


def pool_branch(p, grid, w_pool, pool_scale):
    B, L, Cw = p.shape
    if grid:
        view, axis = p.reshape(B, L // GRID_W, GRID_W, Cw), 2
    else:
        view, axis = p, 1
    gs = Cw // POOL_GROUPS
    ys = [pool_minus_self(view[..., g * gs:(g + 1) * gs], axis, POOL_WINDOWS[g]) for g in range(POOL_GROUPS)]
    y = jnp.stack(ys, axis=-2).reshape(B, L, POOL_GROUPS, gs)
    y = jnp.einsum('blgc,gcd->blgd', y, w_pool).reshape(B, L, Cw)
    return y * pool_scale


def dwconv(h, conv_w, conv_b, grid):
    B, L, F = h.shape
    if grid:
        view, axis = h.reshape(B, L // GRID_W, GRID_W, F), 2
    else:
        view, axis = h, 1
    n = view.shape[axis]
    half = CONV_WIDTH // 2
    pad_cfg = [(0, 0)] * view.ndim
    pad_cfg[axis] = (half, half)
    hp = jnp.pad(view, pad_cfg)
    out = sum(conv_w[k] * lax.slice_in_dim(hp, k, k + n, axis=axis) for k in range(CONV_WIDTH))
    return (out + conv_b).reshape(B, L, F)


def conv_ffn(u, grid, w_up, conv_w, conv_b, w_down):
    a, gt = jnp.split(u @ w_up, 2, axis=-1)
    a = dwconv(a, conv_w, conv_b, grid)
    return (jax.nn.gelu(a, approximate=False) * gt) @ w_down


def gla_chunk(q, k, v, log_a, s0):
    B, L, H, DK = q.shape
    DV = v.shape[-1]
    C = GLA_CHUNK
    N = L // C
    f32 = jnp.float32
    q = q.astype(f32).reshape(B, N, C, H, DK)
    k = k.astype(f32).reshape(B, N, C, H, DK)
    v = v.astype(f32).reshape(B, N, C, H, DV)
    bcum = jnp.cumsum(log_a.astype(f32).reshape(B, N, C, H, DK), axis=2)
    b_last = bcum[:, :, -1:]
    qe = q * jnp.exp(bcum)
    ke = k * jnp.exp(-bcum)
    kend = k * jnp.exp(b_last - bcum)
    mask = jnp.tril(jnp.ones((C, C), dtype=bool))
    att = jnp.where(mask, jnp.einsum('bnihd,bnjhd->bnhij', qe, ke), 0.0)
    o_intra = jnp.einsum('bnhij,bnjhv->bnihv', att, v)

    def step(S, xs):
        qe_n, kend_n, v_n, dec_n = xs
        o_n = jnp.einsum('bihd,bhdv->bihv', qe_n, S)
        S = dec_n[..., None] * S + jnp.einsum('bjhd,bjhv->bhdv', kend_n, v_n)
        return S, o_n

    xs = (jnp.moveaxis(qe, 1, 0), jnp.moveaxis(kend, 1, 0), jnp.moveaxis(v, 1, 0),
          jnp.moveaxis(jnp.exp(b_last[:, :, 0]), 1, 0))
    s_fin, o_inter = lax.scan(step, s0.astype(f32), xs)
    o = o_intra + jnp.moveaxis(o_inter, 0, 1)
    return o.reshape(B, L, H, DV), s_fin


def flip_seq(a):
    return jnp.flip(a, axis=1)


def bi_gla(q, k, v, la_f, la_b, s_f0, s_b0):
    o_f, s_f = gla_chunk(q, k, v, la_f, s_f0)
    o_b, s_b = gla_chunk(flip_seq(q), flip_seq(k), flip_seq(v), flip_seq(la_b), s_b0)
    return o_f + flip_seq(o_b), s_f, s_b


def gla_inputs(q, k, v, zf, zb, w_gate_f, b_gate_f, w_gate_b, b_gate_b):
    B, L = q.shape[:2]
    q = q.reshape(B, L, GLA_HEADS, GLA_DK) * (GLA_DK ** -0.5)
    k = k.reshape(B, L, GLA_HEADS, GLA_DK)
    v = v.reshape(B, L, GLA_HEADS, GLA_DV)
    la_f = (jax.nn.log_sigmoid((zf @ w_gate_f + b_gate_f).astype(jnp.float32)) / GLA_GATE_TEMP).reshape(B, L, GLA_HEADS, GLA_DK)
    la_b = (jax.nn.log_sigmoid((zb @ w_gate_b + b_gate_b).astype(jnp.float32)) / GLA_GATE_TEMP).reshape(B, L, GLA_HEADS, GLA_DK)
    return q, k, v, la_f, la_b


def mixer_out(pool, r, g_pool, g_gla, o, grid, w_pool, pool_scale, gla_norm_w, w_br_pool, w_br_gla, w_out):
    B, L = pool.shape[:2]
    y_pool = pool_branch(pool, grid, w_pool, pool_scale) @ w_br_pool
    of = o * lax.rsqrt(jnp.mean(jnp.square(o), -1, keepdims=True) + LN_EPS)
    of = of.reshape(B, L, V_W) * gla_norm_w.astype(jnp.float32)
    y_gla = (of.astype(r.dtype) * jax.nn.silu(r)) @ w_br_gla
    merged = jax.nn.sigmoid(g_pool) * y_pool + jax.nn.sigmoid(g_gla) * y_gla
    return merged @ w_out


def setup_inputs(seed: int = 0) -> dict:
    key = jax.random.key(seed)
    ks = jax.random.split(key, 25)
    f32 = jnp.float32

    def nrm(k, shape, scale):
        return jax.random.normal(k, shape, f32) * scale

    D, F = D_MODEL, FFN_HIDDEN
    return {
        "x": nrm(ks[0], (BATCH, SEQ, D), 1.0),
        "c": nrm(ks[1], (BATCH, D), 1.0),
        "ctx": nrm(ks[2], (BATCH, CTX_LEN, D), 1.0),
        "c_ctx": nrm(ks[3], (D,), 1.0),
        "w_mod": nrm(ks[4], (DEPTH, D, 6 * D), 0.5 * D ** -0.5),
        "b_mod": nrm(ks[5], (DEPTH, 6 * D), 0.02),
        "w_in": nrm(ks[6], (DEPTH, D, N_IN), D ** -0.5),
        "w_gate_f": nrm(ks[7], (DEPTH, GLA_GATE_RANK, QK_W), GLA_GATE_RANK ** -0.5),
        "b_gate_f": 2.0 + nrm(ks[8], (DEPTH, QK_W), 0.1),
        "w_gate_b": nrm(ks[9], (DEPTH, GLA_GATE_RANK, QK_W), GLA_GATE_RANK ** -0.5),
        "b_gate_b": 2.0 + nrm(ks[10], (DEPTH, QK_W), 0.1),
        "gla_norm_w": 1.0 + nrm(ks[11], (DEPTH, V_W), 0.02),
        "w_pool": nrm(ks[12], (DEPTH, POOL_GROUPS, POOL_WIDTH // POOL_GROUPS, POOL_WIDTH // POOL_GROUPS), (POOL_WIDTH // POOL_GROUPS) ** -0.5),
        "pool_scale": 1.0 + nrm(ks[13], (DEPTH, POOL_WIDTH), 0.02),
        "w_br_pool": nrm(ks[14], (DEPTH, POOL_WIDTH, D), POOL_WIDTH ** -0.5),
        "w_br_gla": nrm(ks[15], (DEPTH, V_W, D), V_W ** -0.5),
        "w_out": nrm(ks[16], (DEPTH, D, D), DEEPNORM_BETA * D ** -0.5),
        "ln1_w": 1.0 + nrm(ks[17], (DEPTH, D), 0.02),
        "ln1_b": nrm(ks[18], (DEPTH, D), 0.02),
        "w_up": nrm(ks[19], (DEPTH, D, 2 * F), D ** -0.5),
        "conv_w": nrm(ks[20], (DEPTH, CONV_WIDTH, F), CONV_WIDTH ** -0.5),
        "conv_b": nrm(ks[21], (DEPTH, F), 0.02),
        "w_down": nrm(ks[22], (DEPTH, F, D), DEEPNORM_BETA * F ** -0.5),
        "ln2_w": 1.0 + nrm(ks[23], (DEPTH, D), 0.02),
        "ln2_b": nrm(ks[24], (DEPTH, D), 0.02),
    }


def reference(x, c, ctx, c_ctx, w_mod, b_mod, w_in, w_gate_f, b_gate_f, w_gate_b, b_gate_b,
              gla_norm_w, w_pool, pool_scale, w_br_pool, w_br_gla, w_out, ln1_w, ln1_b,
              w_up, conv_w, conv_b, w_down, ln2_w, ln2_b):
    B, L, D = x.shape
    rows = L // GRID_W
    x = layer_norm(x + pos_embed_2d(rows, GRID_W, D).astype(x.dtype)[None])
    h = layer_norm(ctx)
    s0 = jnp.zeros((B, GLA_HEADS, GLA_DK, GLA_DV), jnp.float32)

    for l in range(DEPTH):
        last = l == DEPTH - 1
        mx = (jax.nn.silu(c) @ w_mod[l] + b_mod[l])[:, None, :]
        mc = jax.nn.silu(c_ctx) @ w_mod[l] + b_mod[l]
        sh1x, sc1x, g1x, sh2x, sc2x, g2x = jnp.split(mx, 6, axis=-1)
        sh1c, sc1c, g1c, sh2c, sc2c, g2c = jnp.split(mc, 6, axis=-1)

        ux = x * (1.0 + sc1x) + sh1x
        uc = h * (1.0 + sc1c) + sh1c
        px = jnp.split(ux @ w_in[l], IN_SPLITS, axis=-1)
        pc = jnp.split(uc @ w_in[l], IN_SPLITS, axis=-1)
        gx = gla_inputs(px[1], px[2], px[3], px[5], px[6], w_gate_f[l], b_gate_f[l], w_gate_b[l], b_gate_b[l])
        gc = gla_inputs(pc[1], pc[2], pc[3], pc[5], pc[6], w_gate_f[l], b_gate_f[l], w_gate_b[l], b_gate_b[l])
        o_c, s_f, s_b = bi_gla(*gc, s0, s0)
        o_x, _, _ = bi_gla(*gx, s_f, s_b)

        mix_x = mixer_out(px[0], px[4], px[7], px[8], o_x, True, w_pool[l], pool_scale[l],
                          gla_norm_w[l], w_br_pool[l], w_br_gla[l], w_out[l])
        x = layer_norm(DEEPNORM_ALPHA * x + g1x * mix_x, ln1_w[l], ln1_b[l])

        ux2 = x * (1.0 + sc2x) + sh2x
        x = layer_norm(DEEPNORM_ALPHA * x + g2x * conv_ffn(ux2, True, w_up[l], conv_w[l], conv_b[l], w_down[l]),
                       ln2_w[l], ln2_b[l])

        if not last:
            mix_c = mixer_out(pc[0], pc[4], pc[7], pc[8], o_c, False, w_pool[l], pool_scale[l],
                              gla_norm_w[l], w_br_pool[l], w_br_gla[l], w_out[l])
            h = layer_norm(DEEPNORM_ALPHA * h + g1c * mix_c, ln1_w[l], ln1_b[l])
            uc2 = h * (1.0 + sc2c) + sh2c
            h = layer_norm(DEEPNORM_ALPHA * h + g2c * conv_ffn(uc2, False, w_up[l], conv_w[l], conv_b[l], w_down[l]),
                           ln2_w[l], ln2_b[l])
    return x
```

```cpp
#include <hip/hip_runtime.h>
#include <hip/hip_cooperative_groups.h>
#include <cstdio>
#include <cstdint>
namespace cg = cooperative_groups;
namespace pg8 {
#define PG8_LAS __attribute__((address_space(3)))
typedef unsigned short bf16_t;
typedef short bf16x8 __attribute__((ext_vector_type(8)));
typedef float f32x4 __attribute__((ext_vector_type(4)));
typedef unsigned u32x4 __attribute__((ext_vector_type(4)));
constexpr int BM = 256, BK = 64, HALF = 128, HTB = HALF * BK * 2  , STAGE_BYTES = 8 * HTB, NXCD = 8, WGM = 4;

__host__ __device__ __forceinline__ int lds_byte(int r, int c) { const int st = (r >> 4) * 2 + (c >> 5), rr = r & 15, cc = c & 31, ob = rr * 64 + cc * 2; return st * 1024 + (ob ^ (((ob >> 9) & 1) << 5)); }
__host__ __device__ __forceinline__ void stage_rc(int b, int& R, int& C) { const int st = b / 1024, sb = b % 1024, swz = sb ^ (((sb >> 9) & 1) << 5); R = (st >> 1) * 16 + swz / 64; C = (st & 1) * 32 + (swz % 64) / 2; }
__host__ __device__ __forceinline__ int perm32(int rho) { const int n = rho >> 4, i = rho & 15; return 8 * (i >> 2) + 4 * n + (i & 3); }

struct Unit { int pm, pn; };
struct Gemm { const bf16_t* A; const bf16_t* Bt; int M, N, K; };

struct StaticOrder {
    int nM, nN, nwg, G, c;
    __host__ __device__ void init(int M, int N, int G_, int c_) { nM = M / BM; nN = N / BM; nwg = nM * nN; G = G_; c = c_; }
    __host__ __device__ bool next(int i, Unit& u) const {
        const long L = (long)i * G + c; if (L >= nwg) return false;
        int wgid = (int)L; { const int q = nwg / NXCD, r = nwg % NXCD, xcd = wgid % NXCD, off = wgid / NXCD; wgid = (xcd < r ? xcd * (q + 1) : r * (q + 1) + (xcd - r) * q) + off; }
        const int nig = WGM * nN, gid = wgid / nig, fm = gid * WGM, gsz = (nM - fm) < WGM ? (nM - fm) : WGM;
        u.pm = fm + ((wgid % nig) % gsz); u.pn = (wgid % nig) / gsz; return true;
    }
    __device__ __forceinline__ void a_ready(const Unit&) const {}
    __device__ __forceinline__ void done(const Unit&) const {}
};

template <class Epi, class Sched, bool ALIGN_EPI = false, bool SP2 = false>
__device__ __forceinline__ void gemm_phase(PG8_LAS unsigned char* lds, const Gemm g, const Sched& S, const Epi& E, const int wave_s) {
    int lane_; asm volatile("v_mbcnt_lo_u32_b32 %0, -1, 0\n\tv_mbcnt_hi_u32_b32 %0, -1, %0" : "=v"(lane_)); const int lane = lane_, wid = wave_s, tid = wid * 64 + lane, wr = wid >> 2, wc = wid & 3, fr = lane & 15, fq = lane >> 4;
    const int K = g.K, nt = K / BK;
    unsigned voffA[2], voffB[2];
#pragma unroll
    for (int i = 0; i < 2; ++i) { int R, C; stage_rc(tid * 16 + i * 8192, R, C); const int Rb = Epi::PERM ? ((R & ~31) + perm32(R & 31)) : R;
        voffA[i] = (unsigned)(R * K + C) * 2u; voffB[i] = (unsigned)(Rb * K + C) * 2u; }
    const size_t kstep = (size_t)(BK * 2);
    const size_t hstep = (size_t)HALF * K * 2;
    const size_t tstep = 2 * hstep;
    const unsigned ldsw = (unsigned)wid * 1024u;
    const int aoff = lds_byte(wr * 64 + fr, fq * 8), boff = lds_byte(wc * 32 + fr, fq * 8);
#define PG8_SA(b, h) (((b) * 2 + (h)) * HTB)
#define PG8_SB(b, h) ((4 + (b) * 2 + (h)) * HTB)
#define PG8_STAGE(bufoff, gbase, voff) do { _Pragma("unroll") for (int _i = 0; _i < 2; ++_i) \
        __builtin_amdgcn_global_load_lds((const unsigned*)((const char*)(gbase) + (voff)[_i]), (PG8_LAS unsigned*)(lds + (bufoff) + ldsw + _i * 8192), 16, 0, 0); } while (0)
#define PG8_LDA(dst, b, h) do { _Pragma("unroll") for (int m = 0; m < 4; ++m) _Pragma("unroll") for (int k = 0; k < 2; ++k) dst[m][k] = *(const PG8_LAS bf16x8*)(lds + PG8_SA(b, h) + aoff + m * 2048 + k * 1024); } while (0)
#define PG8_LDB(dst, b, h) do { _Pragma("unroll") for (int n = 0; n < 2; ++n) _Pragma("unroll") for (int k = 0; k < 2; ++k) dst[n][k] = *(const PG8_LAS bf16x8*)(lds + PG8_SB(b, h) + boff + n * 2048 + k * 1024); } while (0)
#define PG8_MMA(ai, bj, At, Bt) do { __builtin_amdgcn_s_setprio(1); _Pragma("unroll") for (int m = 0; m < 4; ++m) _Pragma("unroll") for (int n = 0; n < 2; ++n) _Pragma("unroll") for (int k = 0; k < 2; ++k) \
        acc[ai][bj][m][n] = __builtin_amdgcn_mfma_f32_16x16x32_bf16(Bt[n][k], At[m][k], acc[ai][bj][m][n], 0, 0, 0); __builtin_amdgcn_s_setprio(0); } while (0)
#define PG8_WAIT_V(n) asm volatile("s_waitcnt vmcnt(" #n ")" ::: "memory")
#define PG8_WAIT_L(n) asm volatile("s_waitcnt lgkmcnt(" #n ")" ::: "memory")
#define PG8_BAR __builtin_amdgcn_s_barrier()
#define PG8_SCHED __builtin_amdgcn_sched_barrier(0)
    Unit cur, nxt; int ui = 0;
    if (!S.next(0, cur)) return;
    f32x4 acc[2][2][4][2];
#pragma unroll
    for (int a = 0; a < 2; ++a)
#pragma unroll
        for (int b = 0; b < 2; ++b)
#pragma unroll
            for (int m = 0; m < 4; ++m)
#pragma unroll
                for (int n = 0; n < 2; ++n) acc[a][b][m][n] = (f32x4){0.f, 0.f, 0.f, 0.f};
    bf16x8 At[4][2], B0[2][2], B1[2][2];
    const char* cA = (const char*)g.A + (size_t)cur.pm * tstep; const char* cB = (const char*)g.Bt + (size_t)cur.pn * tstep;
    S.a_ready(cur);
    if constexpr (SP2) {
        PG8_STAGE(PG8_SB(0, 0), cB, voffB); PG8_STAGE(PG8_SB(0, 1), cB + hstep, voffB); PG8_STAGE(PG8_SA(0, 0), cA, voffA); PG8_STAGE(PG8_SA(0, 1), cA + hstep, voffA);
        if (wr == 1) PG8_BAR;
        PG8_WAIT_V(2); PG8_BAR;
        PG8_STAGE(PG8_SB(1, 0), cB + kstep, voffB); PG8_STAGE(PG8_SA(1, 0), cA + kstep, voffA); PG8_STAGE(PG8_SB(1, 1), cB + hstep + kstep, voffB);
        PG8_WAIT_V(6); PG8_BAR;
    } else {
        PG8_STAGE(PG8_SB(0, 0), cB, voffB); PG8_STAGE(PG8_SA(0, 0), cA, voffA); PG8_STAGE(PG8_SB(0, 1), cB + hstep, voffB); PG8_STAGE(PG8_SA(0, 1), cA + hstep, voffA);
        if (wr == 1) PG8_BAR;
        PG8_WAIT_V(4); PG8_BAR;
        PG8_STAGE(PG8_SB(1, 0), cB + kstep, voffB); PG8_STAGE(PG8_SA(1, 0), cA + kstep, voffA); PG8_STAGE(PG8_SB(1, 1), cB + hstep + kstep, voffB);
        PG8_WAIT_V(6); PG8_BAR;
    }
    for (;;) {
        const bool has_next = S.next(ui + 1, nxt);
        const char* nA = has_next ? (const char*)g.A + (size_t)nxt.pm * tstep : cA; const char* nB = has_next ? (const char*)g.Bt + (size_t)nxt.pn * tstep : cB;
        for (int t = 0; t < nt; t += 2) {
            const bool last = (t == nt - 2);
            const char* a1 = cA + (size_t)(t + 1) * kstep;
            const char* a2 = last ? nA : cA + (size_t)(t + 2) * kstep; const char* b2 = last ? nB : cB + (size_t)(t + 2) * kstep;
            const char* a3 = a2 + kstep; const char* b3 = b2 + kstep;
            if (last && has_next) S.a_ready(nxt);
            if constexpr (SP2) {
            PG8_LDB(B0, 0, 0); PG8_LDB(B1, 0, 1); PG8_SCHED; PG8_LDA(At, 0, 0); PG8_STAGE(PG8_SA(1, 1), a1 + hstep, voffA);
            PG8_WAIT_V(8); PG8_WAIT_L(0); PG8_BAR; PG8_MMA(0, 0, At, B0); PG8_MMA(0, 1, At, B1); PG8_BAR; PG8_SCHED;
            PG8_LDA(At, 0, 1); PG8_STAGE(PG8_SB(0, 0), b2, voffB); PG8_STAGE(PG8_SB(0, 1), b2 + hstep, voffB); PG8_STAGE(PG8_SA(0, 0), a2, voffA);
            PG8_WAIT_V(8); PG8_WAIT_L(0); PG8_BAR; PG8_MMA(1, 0, At, B0); PG8_MMA(1, 1, At, B1); PG8_BAR; PG8_SCHED;
            PG8_LDB(B0, 1, 0); PG8_LDB(B1, 1, 1); PG8_SCHED; PG8_LDA(At, 1, 0); PG8_STAGE(PG8_SA(0, 1), a2 + hstep, voffA);
            PG8_WAIT_V(8); PG8_WAIT_L(0); PG8_BAR; PG8_MMA(0, 0, At, B0); PG8_MMA(0, 1, At, B1); PG8_BAR; PG8_SCHED;
            PG8_LDA(At, 1, 1); PG8_STAGE(PG8_SB(1, 0), b3, voffB); PG8_STAGE(PG8_SB(1, 1), b3 + hstep, voffB); PG8_STAGE(PG8_SA(1, 0), a3, voffA);
            PG8_WAIT_V(8); PG8_WAIT_L(0); PG8_BAR; PG8_MMA(1, 0, At, B0); PG8_MMA(1, 1, At, B1); PG8_BAR; PG8_SCHED;
            } else {
            PG8_LDB(B0, 0, 0); PG8_SCHED; PG8_LDA(At, 0, 0); PG8_STAGE(PG8_SA(1, 1), a1 + hstep, voffA);
            PG8_WAIT_L(8); PG8_BAR; PG8_WAIT_L(0); PG8_MMA(0, 0, At, B0); PG8_BAR; PG8_SCHED;
            PG8_LDB(B1, 0, 1); PG8_STAGE(PG8_SB(0, 0), b2, voffB);
            PG8_BAR; PG8_WAIT_L(0); PG8_MMA(0, 1, At, B1); PG8_BAR;
            PG8_LDA(At, 0, 1); PG8_STAGE(PG8_SA(0, 0), a2, voffA);
            PG8_BAR; PG8_WAIT_L(0); PG8_MMA(1, 0, At, B0); PG8_BAR; PG8_SCHED;
            PG8_STAGE(PG8_SB(0, 1), b2 + hstep, voffB);
            PG8_WAIT_V(6); PG8_BAR; PG8_MMA(1, 1, At, B1); PG8_BAR;
            PG8_LDB(B0, 1, 0); PG8_SCHED; PG8_LDA(At, 1, 0); PG8_STAGE(PG8_SA(0, 1), a2 + hstep, voffA);
            PG8_WAIT_L(8); PG8_BAR; PG8_WAIT_L(0); PG8_MMA(0, 0, At, B0); PG8_BAR; PG8_SCHED;
            PG8_LDB(B1, 1, 1); PG8_STAGE(PG8_SB(1, 0), b3, voffB);
            PG8_BAR; PG8_WAIT_L(0); PG8_MMA(0, 1, At, B1); PG8_BAR;
            PG8_LDA(At, 1, 1); PG8_STAGE(PG8_SA(1, 0), a3, voffA);
            PG8_BAR; PG8_WAIT_L(0); PG8_MMA(1, 0, At, B0); PG8_BAR; PG8_SCHED;
            PG8_STAGE(PG8_SB(1, 1), b3 + hstep, voffB);
            PG8_WAIT_V(6); PG8_BAR; PG8_MMA(1, 1, At, B1); PG8_BAR;
            }
        }
        if constexpr (ALIGN_EPI) { if (wr == 0) PG8_BAR; }
        if constexpr (!Epi::AFTER_DRAIN) { E(acc, cur, wr, wc, fr, fq); S.done(cur); }
        if (!has_next) break;
#pragma unroll
        for (int a = 0; a < 2; ++a)
#pragma unroll
            for (int b = 0; b < 2; ++b)
#pragma unroll
                for (int m = 0; m < 4; ++m)
#pragma unroll
                    for (int n = 0; n < 2; ++n) acc[a][b][m][n] = (f32x4){0.f, 0.f, 0.f, 0.f};
        cur = nxt; cA = nA; cB = nB; ++ui;
        if constexpr (ALIGN_EPI) { if (wr == 1) PG8_BAR; }
    }
    PG8_WAIT_V(0);
    if constexpr (!ALIGN_EPI) { if (wr == 0) PG8_BAR; }
    PG8_BAR;
    if constexpr (Epi::AFTER_DRAIN) { E.fused(acc, cur, wr, wc, fr, fq, lds, wid, lane); S.done(cur); }
#undef PG8_SA
#undef PG8_SB
#undef PG8_STAGE
#undef PG8_LDA
#undef PG8_LDB
#undef PG8_MMA
#undef PG8_WAIT_V
#undef PG8_WAIT_L
#undef PG8_BAR
#undef PG8_SCHED
}
}

#define GAS __attribute__((address_space(1)))
#define LAS __attribute__((address_space(3)))
typedef unsigned short bf16;
typedef unsigned v4u __attribute__((ext_vector_type(4)));
typedef unsigned v2u __attribute__((ext_vector_type(2)));
typedef float f32x4 __attribute__((ext_vector_type(4)));
typedef float f32x2 __attribute__((ext_vector_type(2)));
typedef float f32x16 __attribute__((ext_vector_type(16)));
typedef short bf16x8 __attribute__((ext_vector_type(8)));
typedef short s16x4 __attribute__((ext_vector_type(4)));
typedef __bf16 bf16x2_t __attribute__((ext_vector_type(2)));

constexpr int NB = 16, LSEQ = 4096, DM = 1024, DEPTH = 4, CTXL = 256;
constexpr int TL = NB * LSEQ, TC = NB * CTXL, TT = TL + TC;
constexpr int NIN = 5664, FF = 2816, N1 = 2304, N2 = 3584, NU = 5632;
constexpr float LN_EPS = 1e-6f;
constexpr float ALPHA = 1.681792830507429f;
constexpr size_t MiB = (size_t)1 << 20;
constexpr size_t WS_POS = 0, WS_MOD = 1 * MiB, WS_W1T = 3 * MiB, WS_W2T = 21 * MiB, WS_WPT = 49 * MiB, WS_WGT = 53 * MiB, WS_WOT = 61 * MiB,
                 WS_WUT = 69 * MiB, WS_WDT = 113 * MiB, WS_XC = 135 * MiB, WS_UX = 151 * MiB, WS_R = 287 * MiB;
constexpr size_t SU = 68 * MiB;
static_assert((size_t)TT * 512 * 2 == SU, "SU");
constexpr size_t R_Q = 0, R_K = SU, R_V = 2 * SU, R_OF = 4 * SU, R_OB = 6 * SU, R_Z = 8 * SU;
constexpr size_t R_POOL = 0, R_GP = SU, R_GG = 578 * MiB, R_POOLED = 3 * SU;
constexpr size_t R_HID = 0;
constexpr size_t WS_STATS = WS_R + 561 * MiB;
constexpr size_t WS_END = WS_R + 716 * MiB;
static_assert(R_GG >= 8 * SU + 5 * MiB && WS_STATS + MiB <= WS_R + R_GG && R_GG + 2 * SU <= 716 * MiB, "R map");
constexpr int LDS_BYTES = 147456;
constexpr int NTHREADS = 512;

__device__ __forceinline__ unsigned cvtpk(float lo, float hi) { f32x2 v = {lo, hi}; bf16x2_t b = __builtin_convertvector(v, bf16x2_t); return __builtin_bit_cast(unsigned, b); }
__device__ __forceinline__ float bflo(unsigned u) { return __uint_as_float(u << 16); }
__device__ __forceinline__ float bfhi(unsigned u) { return __uint_as_float(u & 0xffff0000u); }
__device__ __forceinline__ float sigmoidf_(float x) { return __builtin_amdgcn_rcpf(1.0f + __expf(-x)); }
__device__ __forceinline__ int lane_id_v() { int l; asm volatile("v_mbcnt_lo_u32_b32 %0, -1, 0\n\tv_mbcnt_hi_u32_b32 %0, -1, %0" : "=v"(l)); return l; }
__device__ __forceinline__ float wave_sum(float v, int lane) {
#pragma unroll
    for (int o = 1; o < 64; o <<= 1) v += __int_as_float(__builtin_amdgcn_ds_bpermute((lane ^ o) << 2, __float_as_int(v)));
    return v;
}
__device__ __forceinline__ float half_sum(float v, int lane) {
#pragma unroll
    for (int o = 1; o < 32; o <<= 1) v += __int_as_float(__builtin_amdgcn_ds_bpermute((lane ^ o) << 2, __float_as_int(v)));
    return v;
}

struct RangeOrder {
    int nM, nN, nwg, G, c;
    __device__ void init(int nM_, int nN_, int G_, int c_) { nM = nM_; nN = nN_; nwg = nM * nN; G = G_; c = c_; }
    __device__ bool next(int i, pg8::Unit& u) const {
        const long L = (long)i * G + c; if (L >= nwg) return false;
        int wgid = (int)L; { const int q = nwg / pg8::NXCD, r = nwg % pg8::NXCD, xcd = wgid % pg8::NXCD, off = wgid / pg8::NXCD; wgid = (xcd < r ? xcd * (q + 1) : r * (q + 1) + (xcd - r) * q) + off; }
        const int nig = pg8::WGM * nN, gid = wgid / nig, fm = gid * pg8::WGM, gsz = (nM - fm) < pg8::WGM ? (nM - fm) : pg8::WGM;
        u.pm = fm + ((wgid % nig) % gsz); u.pn = (wgid % nig) / gsz; return true;
    }
    __device__ __forceinline__ void a_ready(const pg8::Unit&) const {}
    __device__ __forceinline__ void done(const pg8::Unit&) const {}
};

typedef pg8::f32x4 af4;
#define EPI_LOOP for (int ai = 0; ai < 2; ++ai) _Pragma("unroll") for (int m = 0; m < 4; ++m) _Pragma("unroll") for (int bj = 0; bj < 2; ++bj)
#define EPI_RR(base_) int RR = (base_) + ai * 128 + m * 16; asm volatile("" : "+v"(RR));

struct EpiA1 {
    static constexpr bool PERM = true, AFTER_DRAIN = false;
    bf16 *Q, *K, *V, *Z;
    __device__ __forceinline__ void operator()(const af4 (&acc)[2][2][4][2], const pg8::Unit& u, int wr, int wc, int fr_, int fq_) const {
        const int ln_ = lane_id_v(); const int fr = ln_ & 15, fq = ln_ >> 4;
        const int row0 = u.pm * 256 + wr * 64 + fr, pn = u.pn;
        if (pn < 8) {
            bf16* base; int ldc, colt; float sc = 1.f;
            if (pn < 2) { base = Q; ldc = 512; colt = pn * 256; sc = 0.08838834764831845f; }
            else if (pn < 4) { base = K; ldc = 512; colt = (pn - 2) * 256; }
            else { base = V; ldc = 1024; colt = (pn - 4) * 256; }
            const int col0 = colt + wc * 32 + 8 * fq;
#pragma unroll
            EPI_LOOP { EPI_RR(row0) const af4 v0 = acc[ai][bj][m][0] * sc, v1 = acc[ai][bj][m][1] * sc; v4u w; w.x = cvtpk(v0[0], v0[1]); w.y = cvtpk(v0[2], v0[3]); w.z = cvtpk(v1[0], v1[1]); w.w = cvtpk(v1[2], v1[3]);
                *(v4u*)(base + (size_t)RR * ldc + col0 + bj * 128) = w; }
        } else if (wc == 0) {
#pragma unroll
            for (int ai = 0; ai < 2; ++ai)
#pragma unroll
                for (int m = 0; m < 4; ++m) { const af4 v0 = acc[ai][0][m][0], v1 = acc[ai][0][m][1]; v4u w; w.x = cvtpk(v0[0], v0[1]); w.y = cvtpk(v0[2], v0[3]); w.z = cvtpk(v1[0], v1[1]); w.w = cvtpk(v1[2], v1[3]);
                    *(v4u*)(Z + (size_t)(row0 + ai * 128 + m * 16) * 32 + 8 * fq) = w; }
        }
    }
};
struct EpiA2 {
    static constexpr bool PERM = true, AFTER_DRAIN = false;
    bf16 *POOL, *ON, *GP, *GG; const bf16* OBp; const float* nw; LAS float* xch;
    __device__ __forceinline__ void operator()(const af4 (&acc)[2][2][4][2], const pg8::Unit& u, int wr, int wc, int fr_, int fq_) const {
        const int ln_ = lane_id_v(); const int fr = ln_ & 15, fq = ln_ >> 4;
        const int row0 = u.pm * 256 + wr * 64 + fr, pn = u.pn;
        if (pn < 2) {
            const int col0 = pn * 256 + wc * 32 + 8 * fq;
#pragma unroll
            EPI_LOOP { EPI_RR(row0) const af4 v0 = acc[ai][bj][m][0], v1 = acc[ai][bj][m][1]; v4u w; w.x = cvtpk(v0[0], v0[1]); w.y = cvtpk(v0[2], v0[3]); w.z = cvtpk(v1[0], v1[1]); w.w = cvtpk(v1[2], v1[3]);
                *(v4u*)(POOL + (size_t)RR * 512 + col0 + bj * 128) = w; }
        } else if (pn < 6) {
            const int col0 = (pn - 2) * 256 + wc * 32 + 8 * fq;
            float ssq[8];
#pragma unroll
            for (int b_ = 0; b_ < 4; ++b_) {
                const int ai = b_ >> 1, mp = b_ & 1;
                int RRb = row0 + ai * 128 + mp * 32; asm volatile("" : "+v"(RRb));
                const size_t ob = (size_t)RRb * 1024 + col0; v4u of_[2][2], ob_[2][2];
#pragma unroll
                for (int mi = 0; mi < 2; ++mi)
#pragma unroll
                    for (int bj = 0; bj < 2; ++bj) { of_[mi][bj] = *(const v4u*)(ON + ob + mi * 16 * 1024 + bj * 128); ob_[mi][bj] = *(const v4u*)(OBp + ob + mi * 16 * 1024 + bj * 128); }
#pragma unroll
                for (int mi = 0; mi < 2; ++mi) { float q = 0.f;
#pragma unroll
                    for (int bj = 0; bj < 2; ++bj) { const v4u a = of_[mi][bj], c = ob_[mi][bj];
                        const float o0 = bflo(a.x) + bflo(c.x), o1 = bfhi(a.x) + bfhi(c.x), o2 = bflo(a.y) + bflo(c.y), o3 = bfhi(a.y) + bfhi(c.y), o4 = bflo(a.z) + bflo(c.z), o5 = bfhi(a.z) + bfhi(c.z), o6 = bflo(a.w) + bflo(c.w), o7 = bfhi(a.w) + bfhi(c.w);
                        q += (o0 * o0 + o1 * o1) + (o2 * o2 + o3 * o3) + (o4 * o4 + o5 * o5) + (o6 * o6 + o7 * o7); }
                    ssq[ai * 4 + mp * 2 + mi] = q; }
                asm volatile("" ::: "memory");
            }
#pragma unroll
            for (int k = 0; k < 8; ++k) { float v = ssq[k];
                v += __int_as_float(__builtin_amdgcn_ds_bpermute((ln_ ^ 16) << 2, __float_as_int(v)));
                v += __int_as_float(__builtin_amdgcn_ds_bpermute((ln_ ^ 32) << 2, __float_as_int(v))); ssq[k] = v; }
            if (fq == 0) {
#pragma unroll
                for (int k = 0; k < 8; ++k) xch[((k >> 2) * 128 + wr * 64 + (k & 3) * 16 + fr) * 4 + wc] = ssq[k];
            }
            asm volatile("s_waitcnt lgkmcnt(0)" ::: "memory"); __builtin_amdgcn_s_barrier(); asm volatile("" ::: "memory");
            float rs[8];
#pragma unroll
            for (int k = 0; k < 8; ++k) { const f32x4 p4 = *(const LAS f32x4*)(xch + ((k >> 2) * 128 + wr * 64 + (k & 3) * 16 + fr) * 4);
                rs[k] = 1.0f / sqrtf(((p4[0] + p4[1]) + (p4[2] + p4[3])) * (1.f / 256.f) + LN_EPS); }
            f32x4 nwv[2][2];
#pragma unroll
            for (int bj = 0; bj < 2; ++bj) { nwv[bj][0] = *(const f32x4*)(nw + col0 + bj * 128); nwv[bj][1] = *(const f32x4*)(nw + col0 + bj * 128 + 4); }
#pragma unroll
            for (int b_ = 0; b_ < 4; ++b_) {
                const int ai = b_ >> 1, mp = b_ & 1;
                int RRb = row0 + ai * 128 + mp * 32; asm volatile("" : "+v"(RRb));
                const size_t ob = (size_t)RRb * 1024 + col0; v4u of_[2][2], ob_[2][2];
#pragma unroll
                for (int mi = 0; mi < 2; ++mi)
#pragma unroll
                    for (int bj = 0; bj < 2; ++bj) { of_[mi][bj] = *(const v4u*)(ON + ob + mi * 16 * 1024 + bj * 128); ob_[mi][bj] = *(const v4u*)(OBp + ob + mi * 16 * 1024 + bj * 128); }
#pragma unroll
                for (int mi = 0; mi < 2; ++mi) { const float rstd = rs[ai * 4 + mp * 2 + mi];
#pragma unroll
                    for (int bj = 0; bj < 2; ++bj) { af4 v0 = acc[ai][bj][mp * 2 + mi][0], v1 = acc[ai][bj][mp * 2 + mi][1]; asm volatile("" : "+v"(v0), "+v"(v1)); const v4u a = of_[mi][bj], c = ob_[mi][bj];
#pragma unroll
                        for (int e = 0; e < 4; ++e) { v0[e] = v0[e] * sigmoidf_(v0[e]) * (rstd * nwv[bj][0][e]); v1[e] = v1[e] * sigmoidf_(v1[e]) * (rstd * nwv[bj][1][e]); }
                        v4u w; w.x = cvtpk(v0[0] * (bflo(a.x) + bflo(c.x)), v0[1] * (bfhi(a.x) + bfhi(c.x))); w.y = cvtpk(v0[2] * (bflo(a.y) + bflo(c.y)), v0[3] * (bfhi(a.y) + bfhi(c.y)));
                        w.z = cvtpk(v1[0] * (bflo(a.z) + bflo(c.z)), v1[1] * (bfhi(a.z) + bfhi(c.z))); w.w = cvtpk(v1[2] * (bflo(a.w) + bflo(c.w)), v1[3] * (bfhi(a.w) + bfhi(c.w)));
                        *(v4u*)(ON + ob + mi * 16 * 1024 + bj * 128) = w; } }
                asm volatile("" ::: "memory");
            }
        } else {
            bf16* base = pn < 10 ? GP : GG; const int col0 = ((pn - 6) & 3) * 256 + wc * 32 + 8 * fq;
#pragma unroll
            EPI_LOOP { EPI_RR(row0) af4 v0 = acc[ai][bj][m][0], v1 = acc[ai][bj][m][1];
#pragma unroll
                for (int e = 0; e < 4; ++e) { v0[e] = sigmoidf_(v0[e]); v1[e] = sigmoidf_(v1[e]); }
                v4u w; w.x = cvtpk(v0[0], v0[1]); w.y = cvtpk(v0[2], v0[3]); w.z = cvtpk(v1[0], v1[1]); w.w = cvtpk(v1[2], v1[3]);
                *(v4u*)(base + (size_t)RR * 1024 + col0 + bj * 128) = w; asm volatile("" ::: "memory"); }
        }
    }
};
struct EpiMul {
    static constexpr bool PERM = true, AFTER_DRAIN = false;
    bf16* G;
    __device__ __forceinline__ void operator()(const af4 (&acc)[2][2][4][2], const pg8::Unit& u, int wr, int wc, int fr_, int fq_) const {
        const int ln_ = lane_id_v(); const int fr = ln_ & 15, fq = ln_ >> 4;
        const int row0 = u.pm * 256 + wr * 64 + fr, col0 = u.pn * 256 + wc * 32 + 8 * fq;
        v4u o[2][2][2];
#define MUL_LOAD(buf, b_) do { int RRl = row0 + ((b_) >> 1) * 128 + ((b_) & 1) * 32; asm volatile("" : "+v"(RRl)); const bf16* pl = G + (size_t)RRl * 1024 + col0; \
            _Pragma("unroll") for (int mi = 0; mi < 2; ++mi) _Pragma("unroll") for (int bj = 0; bj < 2; ++bj) o[buf][mi][bj] = *(const v4u*)(pl + mi * 16 * 1024 + bj * 128); } while (0)
        MUL_LOAD(0, 0);
#pragma unroll
        for (int b_ = 0; b_ < 4; ++b_) {
            const int ai = b_ >> 1, mp = b_ & 1, cur = b_ & 1;
            if (b_ + 1 < 4) { if (cur == 0) MUL_LOAD(1, b_ + 1); else MUL_LOAD(0, b_ + 1); }
            int RRb = row0 + ai * 128 + mp * 32; asm volatile("" : "+v"(RRb));
            bf16* pb = G + (size_t)RRb * 1024 + col0;
#pragma unroll
            for (int mi = 0; mi < 2; ++mi)
#pragma unroll
                for (int bj = 0; bj < 2; ++bj) { const af4 v0 = acc[ai][bj][mp * 2 + mi][0], v1 = acc[ai][bj][mp * 2 + mi][1]; const v4u oo = o[cur][mi][bj];
                    v4u w; w.x = cvtpk(v0[0] * bflo(oo.x), v0[1] * bfhi(oo.x)); w.y = cvtpk(v0[2] * bflo(oo.y), v0[3] * bfhi(oo.y)); w.z = cvtpk(v1[0] * bflo(oo.z), v1[1] * bfhi(oo.z)); w.w = cvtpk(v1[2] * bflo(oo.w), v1[3] * bfhi(oo.w));
                    *(v4u*)(pb + mi * 16 * 1024 + bj * 128) = w; }
            asm volatile("" ::: "memory");
        }
#undef MUL_LOAD
    }
};
struct EpiMulAdd {
    static constexpr bool PERM = true, AFTER_DRAIN = false;
    bf16* G; const bf16* Y;
    __device__ __forceinline__ void operator()(const af4 (&acc)[2][2][4][2], const pg8::Unit& u, int wr, int wc, int fr_, int fq_) const {
        const int ln_ = lane_id_v(); const int fr = ln_ & 15, fq = ln_ >> 4;
        const int row0 = u.pm * 256 + wr * 64 + fr, col0 = u.pn * 256 + wc * 32 + 8 * fq;
        v4u o[2][2][2], yv[2][2][2];
#define MA_LOAD(buf, b_) do { int RRl = row0 + ((b_) >> 1) * 128 + ((b_) & 1) * 32; asm volatile("" : "+v"(RRl)); const size_t ol = (size_t)RRl * 1024 + col0; \
            _Pragma("unroll") for (int mi = 0; mi < 2; ++mi) _Pragma("unroll") for (int bj = 0; bj < 2; ++bj) { o[buf][mi][bj] = *(const v4u*)(G + ol + mi * 16 * 1024 + bj * 128); yv[buf][mi][bj] = *(const v4u*)(Y + ol + mi * 16 * 1024 + bj * 128); } } while (0)
        MA_LOAD(0, 0);
#pragma unroll
        for (int b_ = 0; b_ < 4; ++b_) {
            const int ai = b_ >> 1, mp = b_ & 1, cur = b_ & 1;
            if (b_ + 1 < 4) { if (cur == 0) MA_LOAD(1, b_ + 1); else MA_LOAD(0, b_ + 1); }
            int RRb = row0 + ai * 128 + mp * 32; asm volatile("" : "+v"(RRb));
            const size_t ob = (size_t)RRb * 1024 + col0;
#pragma unroll
            for (int mi = 0; mi < 2; ++mi)
#pragma unroll
                for (int bj = 0; bj < 2; ++bj) { const af4 v0 = acc[ai][bj][mp * 2 + mi][0], v1 = acc[ai][bj][mp * 2 + mi][1]; const v4u oo = o[cur][mi][bj], y = yv[cur][mi][bj];
                    v4u w; w.x = cvtpk(bflo(y.x) + v0[0] * bflo(oo.x), bfhi(y.x) + v0[1] * bfhi(oo.x)); w.y = cvtpk(bflo(y.y) + v0[2] * bflo(oo.y), bfhi(y.y) + v0[3] * bfhi(oo.y));
                    w.z = cvtpk(bflo(y.z) + v1[0] * bflo(oo.z), bfhi(y.z) + v1[1] * bfhi(oo.z)); w.w = cvtpk(bflo(y.w) + v1[2] * bflo(oo.w), bfhi(y.w) + v1[3] * bfhi(oo.w));
                    *(v4u*)(G + ob + mi * 16 * 1024 + bj * 128) = w; }
            asm volatile("" ::: "memory");
        }
#undef MA_LOAD
    }
};
struct EpiRes {
    static constexpr bool PERM = true, AFTER_DRAIN = false;
    float* xl; float* xc; const float* gate; int rowbase; const float* stats; const float* lnw; const float* lnb;
    __device__ __forceinline__ void operator()(const af4 (&acc)[2][2][4][2], const pg8::Unit& u, int wr, int wc, int fr_, int fq_) const {
        const int ln_ = lane_id_v(); const int fr = ln_ & 15, fq = ln_ >> 4;
        const int grow = rowbase + u.pm * 256; const int bi = grow < TL ? grow / LSEQ : NB;
        float* xb = grow < TL ? xl + (size_t)grow * DM : xc + (size_t)(grow - TL) * DM;
        const float* stb = stats + 2 * (size_t)grow;
        const int col0 = u.pn * 256 + wc * 32 + 8 * fq; const float* gp = gate + (size_t)bi * 6144 + col0;
        f32x4 g[2][2], wa[2][2], ba[2][2];
#pragma unroll
        for (int bj = 0; bj < 2; ++bj)
#pragma unroll
            for (int hf = 0; hf < 2; ++hf) { g[bj][hf] = *(const f32x4*)(gp + bj * 128 + 4 * hf);
                if (lnw) { wa[bj][hf] = *(const f32x4*)(lnw + col0 + bj * 128 + 4 * hf) * ALPHA; ba[bj][hf] = *(const f32x4*)(lnb + col0 + bj * 128 + 4 * hf) * ALPHA; }
                else { wa[bj][hf] = (f32x4){ALPHA, ALPHA, ALPHA, ALPHA}; ba[bj][hf] = (f32x4){0.f, 0.f, 0.f, 0.f}; } }
        const int row0 = wr * 64 + fr;
#pragma unroll
        for (int b_ = 0; b_ < 4; ++b_) {
            const int ai = b_ >> 1, mp = b_ & 1;
            int RRb = row0 + ai * 128 + mp * 32; asm volatile("" : "+v"(RRb));
            float* pb = xb + (size_t)RRb * DM + col0;
            f32x4 xv[2][2][2]; f32x2 st[2];
#pragma unroll
            for (int mi = 0; mi < 2; ++mi) { st[mi] = *(const f32x2*)(stb + 2 * (RRb + mi * 16));
#pragma unroll
                for (int bj = 0; bj < 2; ++bj) { xv[mi][bj][0] = *(const f32x4*)(pb + mi * 16 * DM + bj * 128); xv[mi][bj][1] = *(const f32x4*)(pb + mi * 16 * DM + bj * 128 + 4); } }
#pragma unroll
            for (int mi = 0; mi < 2; ++mi)
#pragma unroll
                for (int bj = 0; bj < 2; ++bj) { f32x4 o0, o1; const float mean = st[mi].x, rstd = st[mi].y;
#pragma unroll
                    for (int e = 0; e < 4; ++e) {
                        o0[e] = (xv[mi][bj][0][e] - mean) * (wa[bj][0][e] * rstd) + (ba[bj][0][e] + g[bj][0][e] * acc[ai][bj][mp * 2 + mi][0][e]);
                        o1[e] = (xv[mi][bj][1][e] - mean) * (wa[bj][1][e] * rstd) + (ba[bj][1][e] + g[bj][1][e] * acc[ai][bj][mp * 2 + mi][1][e]); }
                    *(f32x4*)(pb + mi * 16 * DM + bj * 128) = o0; *(f32x4*)(pb + mi * 16 * DM + bj * 128 + 4) = o1; }
            asm volatile("" ::: "memory");
        }
    }
};
struct EpiUp {
    static constexpr bool PERM = true, AFTER_DRAIN = false;
    bf16* UP;
    __device__ __forceinline__ void operator()(const af4 (&acc)[2][2][4][2], const pg8::Unit& u, int wr, int wc, int fr_, int fq_) const {
        const int ln_ = lane_id_v(); const int fr = ln_ & 15, fq = ln_ >> 4;
        const int row0 = u.pm * 256 + wr * 64 + fr, col0 = u.pn * 256 + wc * 32 + 8 * fq;
#pragma unroll
        EPI_LOOP { EPI_RR(row0) const af4 v0 = acc[ai][bj][m][0], v1 = acc[ai][bj][m][1]; v4u w; w.x = cvtpk(v0[0], v0[1]); w.y = cvtpk(v0[2], v0[3]); w.z = cvtpk(v1[0], v1[1]); w.w = cvtpk(v1[2], v1[3]);
            *(v4u*)(UP + (size_t)RR * NU + col0 + bj * 128) = w; }
    }
};


__device__ __forceinline__ float gelu_erf(float v) {
    const float av = fabsf(v), t = __builtin_amdgcn_rcpf(av * 0.2316418882f + 1.0f);
    float q = t * 0.5307027145f + (-0.7265760135f); q = q * t + 0.7107068705f; q = q * t + (-0.142248368f); q = q * t + 0.127414796f; q = q * t;
    const float e = __builtin_amdgcn_exp2f((v * v) * (-0.72134752044f));
    const float mm = v * (q * e);
    return v < 0.f ? mm : v - mm;
}

__device__ __forceinline__ f32x2 gelu_pk(f32x2 v) {
    const f32x2 av = __builtin_elementwise_abs(v), d = av * 0.2316418882f + 1.0f;
    f32x2 t; t.x = __builtin_amdgcn_rcpf(d.x); t.y = __builtin_amdgcn_rcpf(d.y);
    f32x2 q = t * 0.5307027145f + (-0.7265760135f); q = q * t + 0.7107068705f; q = q * t + (-0.142248368f); q = q * t + 0.127414796f; q = q * t;
    const f32x2 sq = (v * v) * (-0.72134752044f);
    f32x2 e; e.x = __builtin_amdgcn_exp2f(sq.x); e.y = __builtin_amdgcn_exp2f(sq.y);
    const f32x2 mm = v * (q * e), rr = v - mm;
    f32x2 o; o.x = v.x < 0.f ? mm.x : rr.x; o.y = v.y < 0.f ? mm.y : rr.y; return o;
}
#define DPP_ROR1(x) __int_as_float(__builtin_amdgcn_update_dpp(0, __float_as_int(x), 0x121, 0xf, 0xf, false))
#define DPP_ROR15(x) __int_as_float(__builtin_amdgcn_update_dpp(0, __float_as_int(x), 0x12F, 0xf, 0xf, false))
struct EpiUpConv {
    static constexpr bool PERM = true, AFTER_DRAIN = false;
    bf16* HID; const float* cw; const float* cb; LAS float* xch;
    __device__ __forceinline__ void operator()(const af4 (&acc)[2][2][4][2], const pg8::Unit& u, int wr, int wc, int fr_, int fq_) const {
        const int ln_ = lane_id_v(); const int fr = ln_ & 15, fq = ln_ >> 4;
        const int row0 = u.pm * 256 + wr * 64 + fr, jl = 32 * wc + 8 * fq, j0 = 128 * u.pn + jl;
        const bool isctx = u.pm >= TL / 256;
        f32x4 cwv[2][4];
#pragma unroll
        for (int n = 0; n < 2; ++n) { cwv[n][0] = *(const f32x4*)(cw + j0 + 4 * n); cwv[n][1] = *(const f32x4*)(cw + FF + j0 + 4 * n); cwv[n][2] = *(const f32x4*)(cw + 2 * FF + j0 + 4 * n); cwv[n][3] = *(const f32x4*)(cb + j0 + 4 * n); }
        if (isctx) {
#pragma unroll
            for (int ai = 0; ai < 2; ++ai) { const int blk = 2 * ai + wr;
                if (fr == 0) { *(LAS f32x4*)(xch + (blk * 2 + 0) * 128 + jl) = acc[ai][0][0][0]; *(LAS f32x4*)(xch + (blk * 2 + 0) * 128 + jl + 4) = acc[ai][0][0][1]; }
                if (fr == 15) { *(LAS f32x4*)(xch + (blk * 2 + 1) * 128 + jl) = acc[ai][0][3][0]; *(LAS f32x4*)(xch + (blk * 2 + 1) * 128 + jl + 4) = acc[ai][0][3][1]; } }
            asm volatile("s_waitcnt lgkmcnt(0)" ::: "memory"); __builtin_amdgcn_s_barrier(); asm volatile("" ::: "memory");
        }
#pragma unroll
        for (int ai = 0; ai < 2; ++ai)
#pragma unroll
            for (int n = 0; n < 2; ++n) {
                const f32x4 w0 = cwv[n][0], w1 = cwv[n][1], w2 = cwv[n][2], bb = cwv[n][3];
                f32x4 bprev = {0.f, 0.f, 0.f, 0.f}, bnext = {0.f, 0.f, 0.f, 0.f};
                if (isctx) { const int blk = 2 * ai + wr;
                    if (blk > 0) bprev = *(const LAS f32x4*)(xch + ((blk - 1) * 2 + 1) * 128 + jl + 4 * n);
                    if (blk < 3) bnext = *(const LAS f32x4*)(xch + ((blk + 1) * 2 + 0) * 128 + jl + 4 * n); }
                f32x4 R[4], L[4];
#pragma unroll
                for (int m = 0; m < 4; ++m)
#pragma unroll
                    for (int e = 0; e < 4; ++e) { R[m][e] = DPP_ROR1(acc[ai][0][m][n][e]); L[m][e] = DPP_ROR15(acc[ai][0][m][n][e]); }
#pragma unroll
                for (int m = 0; m < 4; ++m) {
                    f32x2 o2[2];
#pragma unroll
                    for (int ep = 0; ep < 2; ++ep) {
                        f32x2 pv, nv;
#pragma unroll
                        for (int q = 0; q < 2; ++q) { const int e = 2 * ep + q;
                            pv[q] = (fr == 0) ? (m == 0 ? bprev[e] : R[m == 0 ? 0 : m - 1][e]) : R[m][e];
                            nv[q] = (fr == 15) ? (m == 3 ? bnext[e] : L[m == 3 ? 3 : m + 1][e]) : L[m][e]; }
                        const f32x2 a2 = {acc[ai][0][m][n][2 * ep], acc[ai][0][m][n][2 * ep + 1]}, g2 = {acc[ai][1][m][n][2 * ep], acc[ai][1][m][n][2 * ep + 1]};
                        const f32x2 w0p = {w0[2 * ep], w0[2 * ep + 1]}, w1p = {w1[2 * ep], w1[2 * ep + 1]}, w2p = {w2[2 * ep], w2[2 * ep + 1]}, bbp = {bb[2 * ep], bb[2 * ep + 1]};
                        const f32x2 c2 = w0p * pv + (w1p * a2 + (w2p * nv + bbp));
                        o2[ep] = gelu_pk(c2) * g2;
                    }
                    v2u w; w.x = cvtpk(o2[0].x, o2[0].y); w.y = cvtpk(o2[1].x, o2[1].y);
                    *(v2u*)(HID + (size_t)(row0 + ai * 128 + m * 16) * FF + j0 + 4 * n) = w;
                }
            }
    }
};
template <class Epi, bool ALIGN = false> __device__ __forceinline__ void run_gemm(LAS unsigned char* lds, const bf16* A, const bf16* Bt, int nM, int N, int K, const Epi& E, const int wave_s) {
    pg8::Gemm g{A, Bt, nM * 256, N, K}; RangeOrder S; S.init(nM, N / 256, (int)gridDim.x, (int)blockIdx.x);
    pg8::gemm_phase<Epi, RangeOrder, ALIGN, true>(lds, g, S, E, wave_s);
}

__device__ __forceinline__ void transpose_block(const float* W, int ldw, int src_n0, int k0, bf16* WT, int K, int dst_n0, LAS float* scr, int lane) {
    if (src_n0 >= 0) {
#pragma unroll
        for (int i = 0; i < 32; ++i) { const int kk = 2 * i + (lane >> 5); scr[kk * 33 + (lane & 31)] = W[(size_t)(k0 + kk) * ldw + src_n0 + (lane & 31)]; }
    } else {
#pragma unroll 8
        for (int i = 0; i < 32; ++i) { const int kk = 2 * i + (lane >> 5); scr[kk * 33 + (lane & 31)] = 0.f; }
    }
    asm volatile("s_waitcnt lgkmcnt(0)" ::: "memory");
    const int c = lane & 7;
#pragma unroll
    for (int j = 0; j < 4; ++j) { const int n = (lane >> 3) + 8 * j; const LAS float* s = scr + (8 * c) * 33 + n;
        v4u o; o.x = cvtpk(s[0 * 33], s[1 * 33]); o.y = cvtpk(s[2 * 33], s[3 * 33]); o.z = cvtpk(s[4 * 33], s[5 * 33]); o.w = cvtpk(s[6 * 33], s[7 * 33]);
        *(v4u*)(WT + (size_t)(dst_n0 + n) * K + k0 + 8 * c) = o; }
    asm volatile("s_waitcnt lgkmcnt(0)" ::: "memory");
}

struct P {
    const float* in[25]; float* out; unsigned char* ws;
};

__device__ __forceinline__ void ln_core(f32x4 (&v)[4], int lane) {
    float s = 0.f;
#pragma unroll
    for (int j = 0; j < 4; ++j) s += (v[j][0] + v[j][1]) + (v[j][2] + v[j][3]);
    const float mean = wave_sum(s, lane) * (1.f / DM); float s2 = 0.f;
#pragma unroll
    for (int j = 0; j < 4; ++j) { v[j] = v[j] - mean; s2 += (v[j][0] * v[j][0] + v[j][1] * v[j][1]) + (v[j][2] * v[j][2] + v[j][3] * v[j][3]); }
    const float rstd = 1.0f / sqrtf(wave_sum(s2, lane) * (1.f / DM) + LN_EPS);
#pragma unroll
    for (int j = 0; j < 4; ++j) v[j] = v[j] * rstd;
}
__device__ __forceinline__ void store_x_ux(const f32x4 (&v)[4], float* xrow, bf16* uxrow, const float* sh, const float* sc, int lane) {
#pragma unroll
    for (int j = 0; j < 4; ++j) {
        const int c = 4 * lane + 256 * j;
        *(f32x4*)(xrow + c) = v[j];
        if (uxrow) { const f32x4 a = *(const f32x4*)(sc + c), b = *(const f32x4*)(sh + c);
            v2u w; w.x = cvtpk(v[j][0] * (1.f + a[0]) + b[0], v[j][1] * (1.f + a[1]) + b[1]); w.y = cvtpk(v[j][2] * (1.f + a[2]) + b[2], v[j][3] * (1.f + a[3]) + b[3]);
            *(v2u*)(uxrow + c) = w; }
    }
}


__device__ __forceinline__ float dpp_row_total(float v) {
    v += __int_as_float(__builtin_amdgcn_update_dpp(0, __float_as_int(v), 0xB1, 0xf, 0xf, false));
    v += __int_as_float(__builtin_amdgcn_update_dpp(0, __float_as_int(v), 0x4E, 0xf, 0xf, false));
    v += __int_as_float(__builtin_amdgcn_update_dpp(0, __float_as_int(v), 0x141, 0xf, 0xf, false));
    v += __int_as_float(__builtin_amdgcn_update_dpp(0, __float_as_int(v), 0x140, 0xf, 0xf, false));
    return v;
}
__device__ __forceinline__ float wave_sum_dpp(float v) {
    v = dpp_row_total(v); const int i = __float_as_int(v);
    return (__int_as_float(__builtin_amdgcn_readlane(i, 0)) + __int_as_float(__builtin_amdgcn_readlane(i, 16))) + (__int_as_float(__builtin_amdgcn_readlane(i, 32)) + __int_as_float(__builtin_amdgcn_readlane(i, 48)));
}
__device__ __forceinline__ float half_sum_dpp(float v, int lane) {
    v = dpp_row_total(v); const int i = __float_as_int(v);
    const float t0 = __int_as_float(__builtin_amdgcn_readlane(i, 0)) + __int_as_float(__builtin_amdgcn_readlane(i, 16));
    const float t1 = __int_as_float(__builtin_amdgcn_readlane(i, 32)) + __int_as_float(__builtin_amdgcn_readlane(i, 48));
    return lane < 32 ? t0 : t1;
}
__device__ __forceinline__ void ln_phase(const int lane, const int gw, const int NGW, const int rows, float* xl, float* xcp, const float* lw, const float* lb,
                                         const float* modl, const int sh_off, const int sc_off, bf16* UXp, const float* x_init, const float* ctx_init, const float* POSp, float* stats, const bool final_x) {
    for (int row0 = gw * 4; row0 < rows; row0 += NGW * 4) {
        f32x4 v[4][4]; const bool lat = row0 < TL; const int bi = lat ? row0 / LSEQ : NB;
#pragma unroll
        for (int rr = 0; rr < 4; ++rr) { const int row = row0 + rr;
            const float* src = x_init ? (lat ? x_init + (size_t)row * DM : ctx_init + (size_t)(row - TL) * DM) : (lat ? xl + (size_t)row * DM : xcp + (size_t)(row - TL) * DM);
#pragma unroll
            for (int j = 0; j < 4; ++j) v[rr][j] = *(const f32x4*)(src + 4 * lane + 256 * j); }
        if (x_init && lat) {
#pragma unroll
            for (int rr = 0; rr < 4; ++rr) { const int t = (row0 + rr) % LSEQ; const float* e0 = POSp + (t >> 6) * 512; const float* e1 = POSp + (t & 63) * 512;
#pragma unroll
                for (int j = 0; j < 4; ++j) { const int c = 4 * lane + 256 * j; v[rr][j] += (j < 2) ? *(const f32x4*)(e0 + c) : *(const f32x4*)(e1 + c - 512); } }
        }
        if (x_init) {
#pragma unroll
            for (int rr = 0; rr < 4; ++rr) { const int row = row0 + rr; float* dst = lat ? xl + (size_t)row * DM : xcp + (size_t)(row - TL) * DM;
#pragma unroll
                for (int j = 0; j < 4; ++j) *(f32x4*)(dst + 4 * lane + 256 * j) = v[rr][j]; }
        }
        float mean[4], rstd[4];
#pragma unroll
        for (int rr = 0; rr < 4; ++rr) { float s = 0.f;
#pragma unroll
            for (int j = 0; j < 4; ++j) s += (v[rr][j][0] + v[rr][j][1]) + (v[rr][j][2] + v[rr][j][3]);
            mean[rr] = wave_sum_dpp(s) * (1.f / DM); }
#pragma unroll
        for (int rr = 0; rr < 4; ++rr) { float s2 = 0.f;
#pragma unroll
            for (int j = 0; j < 4; ++j) { v[rr][j] = v[rr][j] - mean[rr]; s2 += (v[rr][j][0] * v[rr][j][0] + v[rr][j][1] * v[rr][j][1]) + (v[rr][j][2] * v[rr][j][2] + v[rr][j][3] * v[rr][j][3]); }
            rstd[rr] = 1.0f / sqrtf(wave_sum_dpp(s2) * (1.f / DM) + LN_EPS); }
        if (lane == 0) {
#pragma unroll
            for (int rr = 0; rr < 4; ++rr) *(f32x2*)(stats + 2 * (size_t)(row0 + rr)) = (f32x2){mean[rr], rstd[rr]};
        }
        const float* md = modl + (size_t)bi * 6144;
#pragma unroll
        for (int j = 0; j < 4; ++j) { const int c = 4 * lane + 256 * j;
            f32x4 w4 = {1.f, 1.f, 1.f, 1.f}, b4 = {0.f, 0.f, 0.f, 0.f}; if (lw) { w4 = *(const f32x4*)(lw + c); b4 = *(const f32x4*)(lb + c); }
            f32x4 sc4 = {0.f, 0.f, 0.f, 0.f}, sh4 = {0.f, 0.f, 0.f, 0.f}; if (UXp) { sc4 = *(const f32x4*)(md + sc_off + c); sh4 = *(const f32x4*)(md + sh_off + c); }
#pragma unroll
            for (int rr = 0; rr < 4; ++rr) { const int row = row0 + rr; const f32x4 y = v[rr][j] * rstd[rr] * w4 + b4;
                if (final_x) { float* dst = lat ? xl + (size_t)row * DM : xcp + (size_t)(row - TL) * DM; *(f32x4*)(dst + c) = y; }
                if (UXp) { v2u w; w.x = cvtpk(y[0] * (1.f + sc4[0]) + sh4[0], y[1] * (1.f + sc4[1]) + sh4[1]); w.y = cvtpk(y[2] * (1.f + sc4[2]) + sh4[2], y[3] * (1.f + sc4[3]) + sh4[3]); *(v2u*)(UXp + (size_t)row * DM + c) = w; } }
        }
    }
}
#define MFMA32(a, b, c) __builtin_amdgcn_mfma_f32_32x32x16_bf16((a), (b), (c), 0, 0, 0)
__device__ __forceinline__ bf16x8 pack_step(const f32x16& x, int s) {
    v4u p; p.x = cvtpk(x[8 * s + 0], x[8 * s + 1]); p.y = cvtpk(x[8 * s + 2], x[8 * s + 3]); p.z = cvtpk(x[8 * s + 4], x[8 * s + 5]); p.w = cvtpk(x[8 * s + 6], x[8 * s + 7]);
    return __builtin_bit_cast(bf16x8, p);
}
constexpr int G_QE = 0, G_KE = 17408, G_KT = 34816, G_VT = 53248, G_BC = 71680, G_ZS = G_BC + 64 * 528, G_SEG = G_ZS + 4096, G_DEC = G_SEG + 2048, G_END = G_DEC + 512;
static_assert(G_END <= 131072, "gla lds");
constexpr int NCHUNK = 68;

__device__ __forceinline__ int gla_row(int n, int p, int b, int dir) {
    const bool isctx = n < 4; const int nn = isctx ? n : n - 4; const int Ls = isctx ? CTXL : LSEQ; const int Pp = 64 * nn + p;
    const int tok = dir ? (Ls - 1 - Pp) : Pp; return (isctx ? TL + b * CTXL : b * LSEQ) + tok;
}

__device__ __forceinline__ void gla_phase(LAS unsigned char* lds, const bf16* Q, const bf16* K, const bf16* V, const bf16* Z, bf16* OF, bf16* OB,
                                          const float* wgf, const float* bgf, const float* wgb, const float* bgb, const int wave_s) {
    const int lane = lane_id_v(), wid = wave_s, tid = wid * 64 + lane, r = lane & 31, h = lane >> 5, wv = wid & 3, wi = wid >> 2;
    LAS unsigned char* Qe = lds + G_QE; LAS unsigned char* Ke = lds + G_KE; LAS unsigned char* KT = lds + G_KT; LAS unsigned char* VT = lds + G_VT;
    LAS float* Bc = (LAS float*)(lds + G_BC); LAS unsigned char* Zs = lds + G_ZS; LAS float* Seg = (LAS float*)(lds + G_SEG); LAS float* Dec = (LAS float*)(lds + G_DEC);
    for (int w = blockIdx.x; w < 256; w += gridDim.x) {
        const int wm = ((((w & 7) << 4) + (w >> 4)) << 1) | ((w >> 3) & 1);
        const int b = wm >> 4, hh = (wm >> 2) & 3, dir = (wm >> 1) & 1, vh = wm & 1;
        const float* wg = dir ? wgb : wgf; const float* bg = dir ? bgb : bgf; bf16* O = dir ? OB : OF;
        const float bgl = bg[hh * 128 + 32 * wv + r];
        bf16x8 wghi;
        { float wf[8];
#pragma unroll
          for (int j = 0; j < 8; ++j) wf[j] = wg[(8 * h + j) * 512 + hh * 128 + 32 * wv + r];
          v4u ph; ph.x = cvtpk(wf[0], wf[1]); ph.y = cvtpk(wf[2], wf[3]); ph.z = cvtpk(wf[4], wf[5]); ph.w = cvtpk(wf[6], wf[7]);
          wghi = __builtin_bit_cast(bf16x8, ph); }
        f32x16 S[4];
#pragma unroll
        for (int t = 0; t < 4; ++t)
#pragma unroll
            for (int e = 0; e < 16; ++e) S[t][e] = 0.f;
        v4u rq[2], rk[2], rv[2], rz;
        rz = (v4u){0u, 0u, 0u, 0u};
#define GLA_LOAD(n) do { _Pragma("unroll") for (int i = 0; i < 2; ++i) { const int idx = tid + 512 * i, p = idx >> 4, c8 = idx & 15; const size_t row = (size_t)gla_row((n), p, b, dir); \
            rq[i] = *(const v4u*)(Q + row * 512 + hh * 128 + 8 * c8); rk[i] = *(const v4u*)(K + row * 512 + hh * 128 + 8 * c8); rv[i] = *(const v4u*)(V + row * 1024 + hh * 256 + vh * 128 + 8 * c8); } } while (0)
#define GLA_LOADZ(n) do { if (tid < 128) { const size_t row = (size_t)gla_row((n), tid >> 1, b, dir); rz = *(const v4u*)(Z + row * 32 + dir * 16 + 8 * (tid & 1)); } } while (0)
#define GLA_ZSTORE() do { if (tid < 128) *(LAS v4u*)(Zs + (tid >> 1) * 32 + 16 * (tid & 1)) = rz; } while (0)
#define GLA_GATEB() do { const bf16x8 za = *(const LAS bf16x8*)(Zs + (32 * wi + r) * 32 + 16 * h); f32x16 gt_; \
            _Pragma("unroll") for (int e = 0; e < 16; ++e) gt_[e] = 0.f; \
            gt_ = MFMA32(za, wghi, gt_); \
            float c_[16], s_[4], t_[4]; \
            _Pragma("unroll") for (int j = 0; j < 4; ++j) { float run = 0.f; \
                _Pragma("unroll") for (int i = 0; i < 4; ++i) { const float g = gt_[4 * j + i] + bgl; \
                    const float la = (fminf(g, 0.f) - __logf(1.0f + __expf(-fabsf(g)))) * (1.0f / 16.0f); run += la; c_[4 * j + i] = run; } \
                s_[j] = run; } \
            _Pragma("unroll") for (int j = 0; j < 4; ++j) t_[j] = __int_as_float(__builtin_amdgcn_ds_bpermute((lane ^ 32) << 2, __float_as_int(s_[j]))); \
            float offj = 0.f; \
            _Pragma("unroll") for (int j = 0; j < 4; ++j) { const float o_ = offj + (h ? t_[j] : 0.f); \
                _Pragma("unroll") for (int i = 0; i < 4; ++i) Bc[(32 * wi + 8 * j + 4 * h + i) * 132 + 32 * wv + r] = c_[4 * j + i] + o_; \
                offj += s_[j] + t_[j]; } \
            if (h == 0) Seg[wi * 128 + 32 * wv + r] = offj; } while (0)
        GLA_LOAD(0); GLA_LOADZ(0);
        __syncthreads();
        GLA_ZSTORE();
        GLA_LOADZ(1);
        __syncthreads();
        GLA_GATEB();
        for (int n = 0; n < NCHUNK; ++n) {
            __syncthreads();
#pragma unroll
            for (int i = 0; i < 2; ++i) { const int idx = tid + 512 * i, p = idx >> 4, c8 = idx & 15; const int pcol = ((((p >> 3) ^ (c8 & 7)) << 4) + ((p & 7) << 1));
                const f32x4 b0 = *(const LAS f32x4*)(Bc + p * 132 + 8 * c8), b1 = *(const LAS f32x4*)(Bc + p * 132 + 8 * c8 + 4);
                const f32x4 t00 = *(const LAS f32x4*)(Seg + 8 * c8), t01 = *(const LAS f32x4*)(Seg + 8 * c8 + 4), t10 = *(const LAS f32x4*)(Seg + 128 + 8 * c8), t11 = *(const LAS f32x4*)(Seg + 128 + 8 * c8 + 4);
                float qf[8], kf[8], bc[8], dc[8];
                qf[0] = bflo(rq[i].x); qf[1] = bfhi(rq[i].x); qf[2] = bflo(rq[i].y); qf[3] = bfhi(rq[i].y); qf[4] = bflo(rq[i].z); qf[5] = bfhi(rq[i].z); qf[6] = bflo(rq[i].w); qf[7] = bfhi(rq[i].w);
                kf[0] = bflo(rk[i].x); kf[1] = bfhi(rk[i].x); kf[2] = bflo(rk[i].y); kf[3] = bfhi(rk[i].y); kf[4] = bflo(rk[i].z); kf[5] = bfhi(rk[i].z); kf[6] = bflo(rk[i].w); kf[7] = bfhi(rk[i].w);
#pragma unroll
                for (int e = 0; e < 4; ++e) { bc[e] = b0[e] + (p >= 32 ? t00[e] : 0.f); bc[4 + e] = b1[e] + (p >= 32 ? t01[e] : 0.f); dc[e] = __expf(t00[e] + t10[e]); dc[4 + e] = __expf(t01[e] + t11[e]); }
                if (p == 0) { *(LAS f32x4*)(Dec + 8 * c8) = (f32x4){dc[0], dc[1], dc[2], dc[3]}; *(LAS f32x4*)(Dec + 8 * c8 + 4) = (f32x4){dc[4], dc[5], dc[6], dc[7]}; }
                float qe[8], ke[8], kn[8];
#pragma unroll
                for (int e = 0; e < 8; ++e) { const float ex = __expf(bc[e]); const float inv = __builtin_amdgcn_rcpf(ex); qe[e] = qf[e] * ex; ke[e] = kf[e] * inv; kn[e] = ke[e] * dc[e]; }
                v4u wq, wk; wq.x = cvtpk(qe[0], qe[1]); wq.y = cvtpk(qe[2], qe[3]); wq.z = cvtpk(qe[4], qe[5]); wq.w = cvtpk(qe[6], qe[7]);
                wk.x = cvtpk(ke[0], ke[1]); wk.y = cvtpk(ke[2], ke[3]); wk.z = cvtpk(ke[4], ke[5]); wk.w = cvtpk(ke[6], ke[7]);
                *(LAS v4u*)(Qe + p * 272 + 16 * c8) = wq; *(LAS v4u*)(Ke + p * 272 + 16 * c8) = wk;
#pragma unroll
                for (int e = 0; e < 8; e += 2) { const unsigned pk = cvtpk(kn[e], kn[e + 1]);
                    *(LAS unsigned short*)(KT + (8 * c8 + e) * 144 + pcol) = (unsigned short)(pk & 0xffffu); *(LAS unsigned short*)(KT + (8 * c8 + e + 1) * 144 + pcol) = (unsigned short)(pk >> 16); }
                const unsigned vv[4] = {rv[i].x, rv[i].y, rv[i].z, rv[i].w};
#pragma unroll
                for (int e = 0; e < 4; ++e) { *(LAS unsigned short*)(VT + (8 * c8 + 2 * e) * 144 + pcol) = (unsigned short)(vv[e] & 0xffffu); *(LAS unsigned short*)(VT + (8 * c8 + 2 * e + 1) * 144 + pcol) = (unsigned short)(vv[e] >> 16); }
                asm volatile("" ::: "memory");
            }
            GLA_ZSTORE();
            if (n + 2 < NCHUNK) GLA_LOADZ(n + 2);
            if (n + 1 < NCHUNK) GLA_LOAD(n + 1);
            __syncthreads();
            if (wi == 0 && n + 1 < NCHUNK) GLA_GATEB();
            f32x16 oT;
#pragma unroll
            for (int e = 0; e < 16; ++e) oT[e] = 0.f;
            const LAS unsigned char* qrow = Qe + (32 * wi + r) * 272;
            const LAS unsigned char* vrow = VT + (32 * wv + r) * 144;
            {
                f32x16 at0;
#pragma unroll
                for (int e = 0; e < 16; ++e) at0[e] = 0.f;
#pragma unroll
                for (int hb = 0; hb < 2; ++hb) {
                    bf16x8 bq[4], ka[4];
#pragma unroll
                    for (int t = 0; t < 4; ++t) { bq[t] = *(const LAS bf16x8*)(qrow + 32 * (4 * hb + t) + 16 * h); ka[t] = *(const LAS bf16x8*)(Ke + r * 272 + 32 * (4 * hb + t) + 16 * h); }
                    asm volatile("" ::: "memory");
#pragma unroll
                    for (int t = 0; t < 4; ++t) at0 = MFMA32(ka[t], bq[t], at0);
                }
#pragma unroll
                for (int dkt = 0; dkt < 4; ++dkt) {
                    v4u qq[2];
#pragma unroll
                    for (int s2 = 0; s2 < 2; ++s2) { const v2u q0 = *(const LAS v2u*)(qrow + 64 * dkt + 32 * s2 + 8 * h), q1 = *(const LAS v2u*)(qrow + 64 * dkt + 32 * s2 + 8 * h + 16); qq[s2] = (v4u){q0.x, q0.y, q1.x, q1.y}; }
                    asm volatile("" ::: "memory");
#pragma unroll
                    for (int s2 = 0; s2 < 2; ++s2) oT = MFMA32(pack_step(S[dkt], s2), __builtin_bit_cast(bf16x8, qq[s2]), oT);
                }
                const int lim = 32 * wi + r - 4 * h;
                {
                    v4u va[2];
#pragma unroll
                    for (int t = 0; t < 2; ++t) { const v2u v0 = *(const LAS v2u*)(vrow + (((2 * t) ^ ((4 * wv + (r >> 3)) & 7)) << 4) + 8 * h), v1 = *(const LAS v2u*)(vrow + (((2 * t + 1) ^ ((4 * wv + (r >> 3)) & 7)) << 4) + 8 * h); va[t] = (v4u){v0.x, v0.y, v1.x, v1.y}; }
#pragma unroll
                    for (int e = 0; e < 16; ++e) at0[e] = (((e & 3) + 8 * (e >> 2)) > lim) ? 0.f : at0[e];
#pragma unroll
                    for (int s2 = 0; s2 < 2; ++s2) oT = MFMA32(__builtin_bit_cast(bf16x8, va[s2]), pack_step(at0, s2), oT);
                }
                if (wi) {
                    f32x16 at1;
#pragma unroll
                    for (int e = 0; e < 16; ++e) at1[e] = 0.f;
#pragma unroll
                    for (int hb = 0; hb < 2; ++hb) {
                        bf16x8 bq[4], ka[4];
#pragma unroll
                        for (int t = 0; t < 4; ++t) { bq[t] = *(const LAS bf16x8*)(qrow + 32 * (4 * hb + t) + 16 * h); ka[t] = *(const LAS bf16x8*)(Ke + (32 + r) * 272 + 32 * (4 * hb + t) + 16 * h); }
                        asm volatile("" ::: "memory");
#pragma unroll
                        for (int t = 0; t < 4; ++t) at1 = MFMA32(ka[t], bq[t], at1);
                    }
                    v4u va[2];
#pragma unroll
                    for (int t = 0; t < 2; ++t) { const v2u v0 = *(const LAS v2u*)(vrow + (((4 + 2 * t) ^ ((4 * wv + (r >> 3)) & 7)) << 4) + 8 * h), v1 = *(const LAS v2u*)(vrow + (((4 + 2 * t + 1) ^ ((4 * wv + (r >> 3)) & 7)) << 4) + 8 * h); va[t] = (v4u){v0.x, v0.y, v1.x, v1.y}; }
#pragma unroll
                    for (int e = 0; e < 16; ++e) at1[e] = ((32 + (e & 3) + 8 * (e >> 2)) > lim) ? 0.f : at1[e];
#pragma unroll
                    for (int s2 = 0; s2 < 2; ++s2) oT = MFMA32(__builtin_bit_cast(bf16x8, va[s2]), pack_step(at1, s2), oT);
                }
            }
            {
                bf16x8 vt[4];
#pragma unroll
                for (int t = 0; t < 4; ++t) vt[t] = *(const LAS bf16x8*)(vrow + (((2 * t + h) ^ ((4 * wv + (r >> 3)) & 7)) << 4));
#pragma unroll
                for (int dkt = 0; dkt < 4; ++dkt) {
                    bf16x8 kt[4]; f32x4 dd[4];
#pragma unroll
                    for (int t = 0; t < 4; ++t) { kt[t] = *(const LAS bf16x8*)(KT + (32 * dkt + r) * 144 + (((2 * t + h) ^ ((4 * dkt + (r >> 3)) & 7)) << 4)); dd[t] = *(const LAS f32x4*)(Dec + 32 * dkt + 8 * t + 4 * h); }
                    asm volatile("" ::: "memory");
#pragma unroll
                    for (int g4 = 0; g4 < 4; ++g4)
#pragma unroll
                        for (int e = 0; e < 4; ++e) S[dkt][4 * g4 + e] *= dd[g4][e];
#pragma unroll
                    for (int t = 0; t < 4; ++t) S[dkt] = MFMA32(kt[t], vt[t], S[dkt]);
                }
            }
            if (wi == 1 && n + 1 < NCHUNK) GLA_GATEB();
            { const size_t row = (size_t)gla_row(n, 32 * wi + r, b, dir); bf16* op = O + row * 1024 + hh * 256 + vh * 128 + 32 * wv + 4 * h;
#pragma unroll
              for (int g4 = 0; g4 < 4; ++g4) { v2u w2; w2.x = cvtpk(oT[4 * g4], oT[4 * g4 + 1]); w2.y = cvtpk(oT[4 * g4 + 2], oT[4 * g4 + 3]); *(v2u*)(op + 8 * g4) = w2; } }
        }
#undef GLA_LOAD
#undef GLA_LOADZ
#undef GLA_ZSTORE
#undef GLA_GATEB
    }
}

#define KA() const P __attribute__((address_space(4)))* ka_ = (const P __attribute__((address_space(4)))*)__builtin_amdgcn_kernarg_segment_ptr(); asm volatile("" : "+s"(ka_)); unsigned char* ws = ka_->ws; float* xl = ka_->out; (void)xl; (void)ws;
constexpr size_t WS_BAR = 512 * 1024;
constexpr int LDS_ST = 131072;
constexpr int LDS_XCH = 131072 + 1024;
#define XB_TMO      128
#define XB_XCNT(j)  (256  + 64 * (j))
#define XB_XSUB(j)  (1280 + 64 * (j))
#define XB_XGEN(j)  (2304 + 64 * (j))
#define XB_TOP      3328
#define XB_TOPGEN   3392
#define XCD_BAR_WORDS 3456
#define XB_SPIN_CAP (1u << 22)
__device__ __forceinline__ unsigned xb_ld(unsigned* p)              { return __hip_atomic_load(p, __ATOMIC_RELAXED, __HIP_MEMORY_SCOPE_AGENT); }
__device__ __forceinline__ unsigned xb_add(unsigned* p, unsigned v) { return __hip_atomic_fetch_add(p, v, __ATOMIC_RELAXED, __HIP_MEMORY_SCOPE_AGENT); }
__device__ __forceinline__ unsigned xb_xcc_id() { return (unsigned)__builtin_amdgcn_s_getreg((3 << 11) | 20) & 0xFu; }
#define XB_SPIN(cond, bar) do { unsigned _sp = 0; while (cond) { __builtin_amdgcn_s_sleep(1); \
    if ((++_sp & 255u) == 0u) { if (xb_ld(&(bar)[XB_TMO])) break; if (_sp > XB_SPIN_CAP) { atomicAdd(&(bar)[XB_TMO], 1u); break; } } } } while (0)
__device__ __forceinline__ void xcd_barrier_complete(unsigned* bar, unsigned x, unsigned& nloc, unsigned& nx) {
    const unsigned G = gridDim.x * gridDim.y * gridDim.z;
    unsigned sum, cnt, mine, sp = 0u;
    for (;;) {
        sum = 0u; cnt = 0u; mine = 0u;
#pragma unroll
        for (unsigned j = 0; j < 16; ++j) { const unsigned c = xb_ld(&bar[XB_XCNT(j)]); sum += c; cnt += (c > 0u) ? 1u : 0u; mine = (j == x) ? c : mine; }
        if (sum == G) break;
        __builtin_amdgcn_s_sleep(1);
        if ((++sp & 255u) == 0u) { if (xb_ld(&bar[XB_TMO])) break; if (sp > XB_SPIN_CAP) { atomicAdd(&bar[XB_TMO], 1u); break; } }
    }
    nloc = mine > 0u ? mine : 1u; nx = cnt > 0u ? cnt : 1u;
}
__device__ __forceinline__ void grid_barrier(unsigned char* wsb, LAS unsigned char* lds, const int wave_s) {
    asm volatile("s_waitcnt vmcnt(0)" ::: "memory");
    __syncthreads();
    if (wave_s == 0 && lane_id_v() == 0) {
        unsigned* bar = (unsigned*)(wsb + WS_BAR);
        volatile LAS unsigned* st = (volatile LAS unsigned*)(lds + LDS_ST);
        const unsigned x = xb_xcc_id();
        __builtin_amdgcn_s_waitcnt(0);
        unsigned nloc = st[0], nx = st[1];
        if (nloc == 0u) { xcd_barrier_complete(bar, x, nloc, nx); st[0] = nloc; st[1] = nx; }
        const unsigned old = xb_add(&bar[XB_XSUB(x)], 1u);
        const unsigned gen = old / nloc;
        if (old + 1u == (gen + 1u) * nloc) {
            __builtin_amdgcn_fence(__ATOMIC_RELEASE, "agent");
            asm volatile("s_waitcnt vmcnt(0)" ::: "memory");
            const unsigned og = xb_add(&bar[XB_TOP], 1u);
            const unsigned tg = og / nx;
            if (og + 1u == (tg + 1u) * nx) xb_add(&bar[XB_TOPGEN], 1u);
            else XB_SPIN(xb_ld(&bar[XB_TOPGEN]) == tg, bar);
            __builtin_amdgcn_fence(__ATOMIC_ACQUIRE, "agent");
            xb_add(&bar[XB_XGEN(x)], 1u);
            asm volatile("s_waitcnt vmcnt(0)" ::: "memory");
        } else {
            XB_SPIN(xb_ld(&bar[XB_XGEN(x)]) == gen, bar);
            __builtin_amdgcn_fence(__ATOMIC_ACQUIRE, "agent");
            asm volatile("s_waitcnt vmcnt(0)" ::: "memory");
        }
    }
    __syncthreads();
}
#define GSYNC() do { KA(); grid_barrier(ws, lds, wave_s); } while (0)
#define x_in (ka_->in[0])
#define c_in (ka_->in[1])
#define ctx_in (ka_->in[2])
#define cctx_in (ka_->in[3])
#define w_mod (ka_->in[4])
#define b_mod (ka_->in[5])
#define w_in (ka_->in[6])
#define w_gate_f (ka_->in[7])
#define b_gate_f (ka_->in[8])
#define w_gate_b (ka_->in[9])
#define b_gate_b (ka_->in[10])
#define gla_norm_w (ka_->in[11])
#define w_pool (ka_->in[12])
#define pool_scale (ka_->in[13])
#define w_br_pool (ka_->in[14])
#define w_br_gla (ka_->in[15])
#define w_out (ka_->in[16])
#define ln1_w (ka_->in[17])
#define ln1_b (ka_->in[18])
#define w_up (ka_->in[19])
#define conv_w (ka_->in[20])
#define conv_b (ka_->in[21])
#define w_down (ka_->in[22])
#define ln2_w (ka_->in[23])
#define ln2_b (ka_->in[24])
#define POS ((float*)(ws + WS_POS))
#define MOD ((float*)(ws + WS_MOD))
#define W1T ((bf16*)(ws + WS_W1T))
#define W2T ((bf16*)(ws + WS_W2T))
#define WPT ((bf16*)(ws + WS_WPT))
#define WGT ((bf16*)(ws + WS_WGT))
#define WOT ((bf16*)(ws + WS_WOT))
#define WUT ((bf16*)(ws + WS_WUT))
#define WDT ((bf16*)(ws + WS_WDT))
#define xc ((float*)(ws + WS_XC))
#define UX ((bf16*)(ws + WS_UX))
#define Qb ((bf16*)(ws + WS_R + R_Q))
#define Kb ((bf16*)(ws + WS_R + R_K))
#define Vb ((bf16*)(ws + WS_R + R_V))
#define OFb ((bf16*)(ws + WS_R + R_OF))
#define OBb ((bf16*)(ws + WS_R + R_OB))
#define Zb ((bf16*)(ws + WS_R + R_Z))
#define POOLb ((bf16*)(ws + WS_R + R_POOL))
#define GPb ((bf16*)(ws + WS_R + R_GP))
#define GGb ((bf16*)(ws + WS_R + R_GG))
#define POOLEDb ((bf16*)(ws + WS_R + R_POOLED))
#define HIDb ((bf16*)(ws + WS_R + R_HID))
#define STATS ((float*)(ws + WS_STATS))
#define FRESH() KA(); const int lane = lane_id_v(), wave = wave_s, tid = wave * 64 + lane, gw = blockIdx.x * 8 + wave, gt = blockIdx.x * NTHREADS + tid; (void)lane; (void)gw; (void)gt; (void)wave;
template <int l> __device__ __forceinline__ void layer_body(LAS unsigned char* lds, const int wave_s) {
    const int G = gridDim.x, NGW = G * 8, NGT = G * NTHREADS; (void)NGW; (void)NGT;
        const bool last = (l == DEPTH - 1);
        const int nMall = TT / 256, nMpost = last ? TL / 256 : TT / 256, rows_post = nMpost * 256;
        { KA(); EpiA1 E{Qb, Kb, Vb, Zb}; run_gemm(lds, UX, W1T + (size_t)l * N1 * 1024, nMall, N1, 1024, E, wave_s); }
        GSYNC();
        { KA(); gla_phase(lds, Qb, Kb, Vb, Zb, OFb, OBb, w_gate_f + (size_t)l * 16 * 512, b_gate_f + l * 512, w_gate_b + (size_t)l * 16 * 512, b_gate_b + l * 512, wave_s); }
        GSYNC();
        { KA(); EpiA2 E{POOLb, OFb, GPb, GGb, OBb, gla_norm_w + l * 1024, (LAS float*)(lds + LDS_XCH)}; run_gemm<EpiA2, true>(lds, UX, W2T + (size_t)l * N2 * 1024, nMpost, N2, 1024, E, wave_s); }
        GSYNC();
        { FRESH();
        for (int row = gw; row < rows_post; row += NGW) {
            int pos, Ls; if (row < TL) { pos = row & 63; Ls = 64; } else { pos = (row - TL) & 255; Ls = 256; }
            const int hw = 1 << (lane >> 4);
            const int lo = max(pos - hw, 0), hi = min(pos + hw, Ls);
            const bf16* base = POOLb + (size_t)(row - pos) * 512 + 8 * lane;
            float s[8];
#pragma unroll
            for (int e = 0; e < 8; ++e) s[e] = 0.f;
            v4u av[16];
#pragma unroll
            for (int k = 0; k < 16; ++k) { const int p = lo + k; const int pc = p < hi ? p : pos; av[k] = *(const v4u*)(base + (size_t)pc * 512); }
#pragma unroll
            for (int k = 0; k < 16; ++k) { const float vm = (lo + k < hi) ? 1.f : 0.f; const v4u a = av[k];
                s[0] += vm * bflo(a.x); s[1] += vm * bfhi(a.x); s[2] += vm * bflo(a.y); s[3] += vm * bfhi(a.y); s[4] += vm * bflo(a.z); s[5] += vm * bfhi(a.z); s[6] += vm * bflo(a.w); s[7] += vm * bfhi(a.w); }
            const v4u me = *(const v4u*)(base + (size_t)pos * 512); const float inv = 1.0f / (float)(hi - lo);
            v4u w; w.x = cvtpk(s[0] * inv - bflo(me.x), s[1] * inv - bfhi(me.x)); w.y = cvtpk(s[2] * inv - bflo(me.y), s[3] * inv - bfhi(me.y));
            w.z = cvtpk(s[4] * inv - bflo(me.z), s[5] * inv - bfhi(me.z)); w.w = cvtpk(s[6] * inv - bflo(me.w), s[7] * inv - bfhi(me.w));
            *(v4u*)(POOLEDb + (size_t)row * 512 + 8 * lane) = w;
        } }
        GSYNC();
        { KA(); EpiMul E{GPb}; run_gemm(lds, POOLEDb, WPT + (size_t)l * 1024 * 512, nMpost, 1024, 512, E, wave_s); }
        GSYNC();
        { KA(); EpiMulAdd E{GGb, GPb}; run_gemm(lds, OFb, WGT + (size_t)l * 1024 * 1024, nMpost, 1024, 1024, E, wave_s); }
        GSYNC();
        { KA(); EpiRes E{xl, xc, MOD + (size_t)l * 17 * 6144 + 2048, 0, STATS, l > 0 ? ln2_w + (l - 1) * 1024 : (const float*)nullptr, l > 0 ? ln2_b + (l - 1) * 1024 : (const float*)nullptr}; run_gemm(lds, GGb, WOT + (size_t)l * 1024 * 1024, nMpost, 1024, 1024, E, wave_s); }
        GSYNC();
        { FRESH(); ln_phase(lane, gw, NGW, rows_post, xl, xc, ln1_w + l * 1024, ln1_b + l * 1024, MOD + (size_t)l * 17 * 6144, 3072, 4096, UX, nullptr, nullptr, nullptr, STATS, false); }
        GSYNC();
        { KA(); EpiUpConv E{HIDb, conv_w + (size_t)l * 3 * FF, conv_b + (size_t)l * FF, (LAS float*)(lds + LDS_XCH)}; run_gemm<EpiUpConv, true>(lds, UX, WUT + (size_t)l * NU * 1024, nMpost, NU, 1024, E, wave_s); }
        GSYNC();
        { KA(); EpiRes E{xl, xc, MOD + (size_t)l * 17 * 6144 + 5120, 0, STATS, ln1_w + l * 1024, ln1_b + l * 1024}; run_gemm(lds, HIDb, WDT + (size_t)l * 1024 * FF, nMpost, 1024, FF, E, wave_s); }
        GSYNC();
        { FRESH(); ln_phase(lane, gw, NGW, rows_post, xl, xc, ln2_w + l * 1024, ln2_b + l * 1024, MOD + (size_t)(last ? l : l + 1) * 17 * 6144, 0, 1024, last ? (bf16*)nullptr : UX, nullptr, nullptr, nullptr, STATS, last); }
        if (!last) GSYNC();
}

__global__ void __launch_bounds__(NTHREADS, 2) fwd_mega(P prm) {
    extern __shared__ __attribute__((aligned(16))) unsigned char lds_raw[];
    LAS unsigned char* lds = (LAS unsigned char*)lds_raw;
    cg::grid_group grid = cg::this_grid();
    const int G = gridDim.x, NGW = G * 8, NGT = G * NTHREADS;
    const int wave_s = __builtin_amdgcn_readfirstlane(threadIdx.x >> 6);
    if (threadIdx.x < 64) ((LAS unsigned*)(lds + LDS_ST))[threadIdx.x] = 0u;
    __syncthreads();
    if (threadIdx.x == 0) (void)xb_add((unsigned*)(prm.ws + WS_BAR) + XB_XCNT(xb_xcc_id()), 1u);
    {
        FRESH();
        LAS float* sc = (LAS float*)lds;
        LAS float* part = (LAS float*)(lds + 69632);
        for (int i = tid; i < 17 * 1024; i += NTHREADS) { const float v = i < 16 * 1024 ? c_in[i] : cctx_in[i - 16 * 1024]; sc[i] = v * sigmoidf_(v); }
        __syncthreads();
        for (int it = blockIdx.x; it < 4 * 96; it += G) {
            const int l = it / 96, j0 = (it % 96) * 64, jl = tid & 63, kp = tid >> 6;
            float acc[17];
#pragma unroll
            for (int bi = 0; bi < 17; ++bi) acc[bi] = 0.f;
            const float* wp = w_mod + (size_t)l * 1024 * 6144 + (size_t)(kp * 128) * 6144 + j0 + jl;
            for (int k0 = 0; k0 < 128; k0 += 16) { float wv_[16];
#pragma unroll
                for (int k = 0; k < 16; ++k) wv_[k] = wp[(size_t)(k0 + k) * 6144];
#pragma unroll
                for (int k = 0; k < 16; ++k) { const int kk = kp * 128 + k0 + k;
#pragma unroll
                    for (int bi = 0; bi < 17; ++bi) acc[bi] += sc[bi * 1024 + kk] * wv_[k]; } }
#pragma unroll
            for (int bi = 0; bi < 17; ++bi) part[(kp * 17 + bi) * 64 + jl] = acc[bi];
            __syncthreads();
            for (int o = tid; o < 17 * 64; o += NTHREADS) { const int bi = o >> 6, j = o & 63; float s = b_mod[l * 6144 + j0 + j];
#pragma unroll
                for (int q = 0; q < 8; ++q) s += part[(q * 17 + bi) * 64 + j];
                MOD[((size_t)l * 17 + bi) * 6144 + j0 + j] = s; }
            __syncthreads();
        }
        for (int i = gt; i < 64 * 512; i += NGT) { const int p = i >> 9, q = i & 511, fi = q & 255;
            const double om = exp(-9.210340371976184 * (double)fi / 256.0); double rev = (double)p * om * 0.15915494309189535; rev -= floor(rev);
            POS[i] = (q < 256) ? __builtin_amdgcn_sinf((float)rev) : __builtin_amdgcn_cosf((float)rev); }
        for (int i = gt; i < 4 * 64 * 1024; i += NGT) { const int n = i & 1023, kg = (i >> 10) & 63, l = i >> 16, g = kg >> 4, c0 = (kg & 15) * 8;
            float acc[8];
#pragma unroll
            for (int e = 0; e < 8; ++e) acc[e] = 0.f;
            const float* wpl = w_pool + ((size_t)(l * 4 + g) * 128 + c0) * 128; const float* ps = pool_scale + l * 512 + g * 128; const float* wb = w_br_pool + ((size_t)l * 512 + g * 128) * 1024 + n;
            for (int d0 = 0; d0 < 128; d0 += 16) { float t[16];
#pragma unroll
                for (int d = 0; d < 16; ++d) t[d] = wb[(size_t)(d0 + d) * 1024];
#pragma unroll
                for (int d = 0; d < 16; ++d) { const float tt = t[d] * ps[d0 + d];
#pragma unroll
                    for (int e = 0; e < 8; ++e) acc[e] += wpl[e * 128 + d0 + d] * tt; } }
            v4u o; o.x = cvtpk(acc[0], acc[1]); o.y = cvtpk(acc[2], acc[3]); o.z = cvtpk(acc[4], acc[5]); o.w = cvtpk(acc[6], acc[7]);
            *(v4u*)(WPT + ((size_t)l * 1024 + n) * 512 + g * 128 + c0) = o; }
        LAS float* scr = (LAS float*)(lds + wave * 16384);
        for (int it = gw; it < 4 * 8192; it += NGW) {
            const int l = it >> 13; int rr = it & 8191;
            if (rr < 1152) { const int kb = rr / 72, nb = rr % 72, d0 = nb * 32; const int s0 = d0 < 2048 ? 512 + d0 : (d0 < 2080 ? 3584 + (d0 - 2048) : -1);
                transpose_block(w_in + (size_t)l * 1024 * NIN, NIN, s0, kb * 64, W1T + (size_t)l * N1 * 1024, 1024, d0, scr, lane); continue; } rr -= 1152;
            if (rr < 1792) { const int kb = rr / 112, nb = rr % 112, d0 = nb * 32; const int s0 = d0 < 512 ? d0 : (d0 < 1536 ? 2560 + (d0 - 512) : 3616 + (d0 - 1536));
                transpose_block(w_in + (size_t)l * 1024 * NIN, NIN, s0, kb * 64, W2T + (size_t)l * N2 * 1024, 1024, d0, scr, lane); continue; } rr -= 1792;
            if (rr < 512) { const int kb = rr / 32, nb = rr % 32; transpose_block(w_br_gla + (size_t)l * 1024 * 1024, 1024, nb * 32, kb * 64, WGT + (size_t)l * 1024 * 1024, 1024, nb * 32, scr, lane); continue; } rr -= 512;
            if (rr < 512) { const int kb = rr / 32, nb = rr % 32; transpose_block(w_out + (size_t)l * 1024 * 1024, 1024, nb * 32, kb * 64, WOT + (size_t)l * 1024 * 1024, 1024, nb * 32, scr, lane); continue; } rr -= 512;
            if (rr < 2816) { const int kb = rr / 176, nb = rr % 176, d0 = nb * 32, pn = d0 >> 8, wq = d0 & 255; const int s0 = wq < 128 ? 128 * pn + wq : FF + 128 * pn + (wq - 128);
                transpose_block(w_up + (size_t)l * 1024 * NU, NU, s0, kb * 64, WUT + (size_t)l * NU * 1024, 1024, d0, scr, lane); continue; } rr -= 2816;
            { const int kb = rr / 32, nb = rr % 32; transpose_block(w_down + (size_t)l * FF * 1024, 1024, nb * 32, kb * 64, WDT + (size_t)l * 1024 * FF, FF, nb * 32, scr, lane); }
        }
    }
    grid.sync();
    { FRESH(); ln_phase(lane, gw, NGW, TT, xl, xc, nullptr, nullptr, MOD, 0, 1024, UX, x_in, ctx_in, POS, STATS, false); }
    GSYNC();

    layer_body<0>(lds, wave_s); layer_body<1>(lds, wave_s); layer_body<2>(lds, wave_s); layer_body<3>(lds, wave_s);
}

extern "C" void kernel_launch(void* const* d_in, const int* in_sizes, int n_in, void* d_out, int out_size, void* d_ws, size_t ws_size, hipStream_t stream) {
    static int grid = 0;
    if (grid == 0) {
        if (n_in != 25 || out_size != TL * DM || ws_size < WS_END) { fprintf(stderr, "kernel_launch: unexpected shapes (n_in %d out %d ws %zu need %zu)\n", n_in, out_size, ws_size, (size_t)WS_END); grid = -1; return; }
        int dev = 0, cus = 0, per_cu = 0;
        if (hipGetDevice(&dev) != hipSuccess || hipDeviceGetAttribute(&cus, hipDeviceAttributeMultiprocessorCount, dev) != hipSuccess) { grid = -1; return; }
        if (hipFuncSetAttribute((const void*)fwd_mega, hipFuncAttributeMaxDynamicSharedMemorySize, LDS_BYTES) != hipSuccess) { fprintf(stderr, "hipFuncSetAttribute failed\n"); grid = -1; return; }
        if (hipOccupancyMaxActiveBlocksPerMultiprocessor(&per_cu, (const void*)fwd_mega, NTHREADS, LDS_BYTES) != hipSuccess || per_cu < 1) { fprintf(stderr, "occupancy query: %d\n", per_cu); per_cu = 1; }
        (void)hipGetLastError();
        grid = cus;
    }
    if (grid < 0) return;
    if (hipMemsetAsync((char*)d_ws + WS_BAR, 0, 16384, stream) != hipSuccess) { fprintf(stderr, "memset failed\n"); return; }
    P prm{};
    for (int i = 0; i < 25; ++i) prm.in[i] = (const float*)d_in[i];
    prm.out = (float*)d_out; prm.ws = (unsigned char*)d_ws;
    void* args[] = {&prm};
    hipError_t e = hipLaunchCooperativeKernel((const void*)fwd_mega, dim3(grid), dim3(NTHREADS), args, LDS_BYTES, stream);
    if (e != hipSuccess) fprintf(stderr, "cooperative launch failed: %s\n", hipGetErrorString(e));
}
```

```cpp
#include <hip/hip_runtime.h>
#include <hip/hip_cooperative_groups.h>
#include <cstdio>
#include <cstdint>
namespace cg = cooperative_groups;
namespace pg8 {
#define PG8_LAS __attribute__((address_space(3)))
typedef unsigned short bf16_t;
typedef short bf16x8 __attribute__((ext_vector_type(8)));
typedef float f32x4 __attribute__((ext_vector_type(4)));
typedef unsigned u32x4 __attribute__((ext_vector_type(4)));
constexpr int BM = 256, BK = 64, HALF = 128, HTB = HALF * BK * 2  , STAGE_BYTES = 8 * HTB, NXCD = 8, WGM = 4;

__host__ __device__ __forceinline__ int lds_byte(int r, int c) { const int st = (r >> 4) * 2 + (c >> 5), rr = r & 15, cc = c & 31, ob = rr * 64 + cc * 2; return st * 1024 + (ob ^ (((ob >> 9) & 1) << 5)); }
__host__ __device__ __forceinline__ void stage_rc(int b, int& R, int& C) { const int st = b / 1024, sb = b % 1024, swz = sb ^ (((sb >> 9) & 1) << 5); R = (st >> 1) * 16 + swz / 64; C = (st & 1) * 32 + (swz % 64) / 2; }
__host__ __device__ __forceinline__ int perm32(int rho) { const int n = rho >> 4, i = rho & 15; return 8 * (i >> 2) + 4 * n + (i & 3); }

struct Unit { int pm, pn; };
struct Gemm { const bf16_t* A; const bf16_t* Bt; int M, N, K; };

struct StaticOrder {
    int nM, nN, nwg, G, c;
    __host__ __device__ void init(int M, int N, int G_, int c_) { nM = M / BM; nN = N / BM; nwg = nM * nN; G = G_; c = c_; }
    __host__ __device__ bool next(int i, Unit& u) const {
        const long L = (long)i * G + c; if (L >= nwg) return false;
        int wgid = (int)L; { const int q = nwg / NXCD, r = nwg % NXCD, xcd = wgid % NXCD, off = wgid / NXCD; wgid = (xcd < r ? xcd * (q + 1) : r * (q + 1) + (xcd - r) * q) + off; }
        const int nig = WGM * nN, gid = wgid / nig, fm = gid * WGM, gsz = (nM - fm) < WGM ? (nM - fm) : WGM;
        u.pm = fm + ((wgid % nig) % gsz); u.pn = (wgid % nig) / gsz; return true;
    }
    __device__ __forceinline__ void a_ready(const Unit&) const {}
    __device__ __forceinline__ void done(const Unit&) const {}
};

template <class Epi, class Sched, bool ALIGN_EPI = false, bool SP2 = false>
__device__ __forceinline__ void gemm_phase(PG8_LAS unsigned char* lds, const Gemm g, const Sched& S, const Epi& E, const int wave_s) {
    int lane_; asm volatile("v_mbcnt_lo_u32_b32 %0, -1, 0\n\tv_mbcnt_hi_u32_b32 %0, -1, %0" : "=v"(lane_)); const int lane = lane_, wid = wave_s, tid = wid * 64 + lane, wr = wid >> 2, wc = wid & 3, fr = lane & 15, fq = lane >> 4;
    const int K = g.K, nt = K / BK;
    unsigned voffA[2], voffB[2];
#pragma unroll
    for (int i = 0; i < 2; ++i) { int R, C; stage_rc(tid * 16 + i * 8192, R, C); const int Rb = Epi::PERM ? ((R & ~31) + perm32(R & 31)) : R;
        voffA[i] = (unsigned)(R * K + C) * 2u; voffB[i] = (unsigned)(Rb * K + C) * 2u; }
    const size_t kstep = (size_t)(BK * 2);
    const size_t hstep = (size_t)HALF * K * 2;
    const size_t tstep = 2 * hstep;
    const unsigned ldsw = (unsigned)wid * 1024u;
    const int aoff = lds_byte(wr * 64 + fr, fq * 8), boff = lds_byte(wc * 32 + fr, fq * 8);
#define PG8_SA(b, h) (((b) * 2 + (h)) * HTB)
#define PG8_SB(b, h) ((4 + (b) * 2 + (h)) * HTB)
#define PG8_STAGE(bufoff, gbase, voff) do { _Pragma("unroll") for (int _i = 0; _i < 2; ++_i) \
        __builtin_amdgcn_global_load_lds((const unsigned*)((const char*)(gbase) + (voff)[_i]), (PG8_LAS unsigned*)(lds + (bufoff) + ldsw + _i * 8192), 16, 0, 0); } while (0)
#define PG8_LDA(dst, b, h) do { _Pragma("unroll") for (int m = 0; m < 4; ++m) _Pragma("unroll") for (int k = 0; k < 2; ++k) dst[m][k] = *(const PG8_LAS bf16x8*)(lds + PG8_SA(b, h) + aoff + m * 2048 + k * 1024); } while (0)
#define PG8_LDB(dst, b, h) do { _Pragma("unroll") for (int n = 0; n < 2; ++n) _Pragma("unroll") for (int k = 0; k < 2; ++k) dst[n][k] = *(const PG8_LAS bf16x8*)(lds + PG8_SB(b, h) + boff + n * 2048 + k * 1024); } while (0)
#define PG8_MMA(ai, bj, At, Bt) do { __builtin_amdgcn_s_setprio(1); _Pragma("unroll") for (int m = 0; m < 4; ++m) _Pragma("unroll") for (int n = 0; n < 2; ++n) _Pragma("unroll") for (int k = 0; k < 2; ++k) \
        acc[ai][bj][m][n] = __builtin_amdgcn_mfma_f32_16x16x32_bf16(Bt[n][k], At[m][k], acc[ai][bj][m][n], 0, 0, 0); __builtin_amdgcn_s_setprio(0); } while (0)
#define PG8_WAIT_V(n) asm volatile("s_waitcnt vmcnt(" #n ")" ::: "memory")
#define PG8_WAIT_L(n) asm volatile("s_waitcnt lgkmcnt(" #n ")" ::: "memory")
#define PG8_BAR __builtin_amdgcn_s_barrier()
#define PG8_SCHED __builtin_amdgcn_sched_barrier(0)
    Unit cur, nxt; int ui = 0;
    if (!S.next(0, cur)) return;
    f32x4 acc[2][2][4][2];
#pragma unroll
    for (int a = 0; a < 2; ++a)
#pragma unroll
        for (int b = 0; b < 2; ++b)
#pragma unroll
            for (int m = 0; m < 4; ++m)
#pragma unroll
                for (int n = 0; n < 2; ++n) acc[a][b][m][n] = (f32x4){0.f, 0.f, 0.f, 0.f};
    bf16x8 At[4][2], B0[2][2], B1[2][2];
    const char* cA = (const char*)g.A + (size_t)cur.pm * tstep; const char* cB = (const char*)g.Bt + (size_t)cur.pn * tstep;
    S.a_ready(cur);
    if constexpr (SP2) {
        PG8_STAGE(PG8_SB(0, 0), cB, voffB); PG8_STAGE(PG8_SB(0, 1), cB + hstep, voffB); PG8_STAGE(PG8_SA(0, 0), cA, voffA); PG8_STAGE(PG8_SA(0, 1), cA + hstep, voffA);
        if (wr == 1) PG8_BAR;
        PG8_WAIT_V(2); PG8_BAR;
        PG8_STAGE(PG8_SB(1, 0), cB + kstep, voffB); PG8_STAGE(PG8_SA(1, 0), cA + kstep, voffA); PG8_STAGE(PG8_SB(1, 1), cB + hstep + kstep, voffB);
        PG8_WAIT_V(6); PG8_BAR;
    } else {
        PG8_STAGE(PG8_SB(0, 0), cB, voffB); PG8_STAGE(PG8_SA(0, 0), cA, voffA); PG8_STAGE(PG8_SB(0, 1), cB + hstep, voffB); PG8_STAGE(PG8_SA(0, 1), cA + hstep, voffA);
        if (wr == 1) PG8_BAR;
        PG8_WAIT_V(4); PG8_BAR;
        PG8_STAGE(PG8_SB(1, 0), cB + kstep, voffB); PG8_STAGE(PG8_SA(1, 0), cA + kstep, voffA); PG8_STAGE(PG8_SB(1, 1), cB + hstep + kstep, voffB);
        PG8_WAIT_V(6); PG8_BAR;
    }
    for (;;) {
        const bool has_next = S.next(ui + 1, nxt);
        const char* nA = has_next ? (const char*)g.A + (size_t)nxt.pm * tstep : cA; const char* nB = has_next ? (const char*)g.Bt + (size_t)nxt.pn * tstep : cB;
        for (int t = 0; t < nt; t += 2) {
            const bool last = (t == nt - 2);
            const char* a1 = cA + (size_t)(t + 1) * kstep;
            const char* a2 = last ? nA : cA + (size_t)(t + 2) * kstep; const char* b2 = last ? nB : cB + (size_t)(t + 2) * kstep;
            const char* a3 = a2 + kstep; const char* b3 = b2 + kstep;
            if (last && has_next) S.a_ready(nxt);
            if constexpr (SP2) {
            PG8_LDB(B0, 0, 0); PG8_LDB(B1, 0, 1); PG8_SCHED; PG8_LDA(At, 0, 0); PG8_STAGE(PG8_SA(1, 1), a1 + hstep, voffA);
            PG8_WAIT_V(8); PG8_WAIT_L(0); PG8_BAR; PG8_MMA(0, 0, At, B0); PG8_MMA(0, 1, At, B1); PG8_BAR; PG8_SCHED;
            PG8_LDA(At, 0, 1); PG8_STAGE(PG8_SB(0, 0), b2, voffB); PG8_STAGE(PG8_SB(0, 1), b2 + hstep, voffB); PG8_STAGE(PG8_SA(0, 0), a2, voffA);
            PG8_WAIT_V(8); PG8_WAIT_L(0); PG8_BAR; PG8_MMA(1, 0, At, B0); PG8_MMA(1, 1, At, B1); PG8_BAR; PG8_SCHED;
            PG8_LDB(B0, 1, 0); PG8_LDB(B1, 1, 1); PG8_SCHED; PG8_LDA(At, 1, 0); PG8_STAGE(PG8_SA(0, 1), a2 + hstep, voffA);
            PG8_WAIT_V(8); PG8_WAIT_L(0); PG8_BAR; PG8_MMA(0, 0, At, B0); PG8_MMA(0, 1, At, B1); PG8_BAR; PG8_SCHED;
            PG8_LDA(At, 1, 1); PG8_STAGE(PG8_SB(1, 0), b3, voffB); PG8_STAGE(PG8_SB(1, 1), b3 + hstep, voffB); PG8_STAGE(PG8_SA(1, 0), a3, voffA);
            PG8_WAIT_V(8); PG8_WAIT_L(0); PG8_BAR; PG8_MMA(1, 0, At, B0); PG8_MMA(1, 1, At, B1); PG8_BAR; PG8_SCHED;
            } else {
            PG8_LDB(B0, 0, 0); PG8_SCHED; PG8_LDA(At, 0, 0); PG8_STAGE(PG8_SA(1, 1), a1 + hstep, voffA);
            PG8_WAIT_L(8); PG8_BAR; PG8_WAIT_L(0); PG8_MMA(0, 0, At, B0); PG8_BAR; PG8_SCHED;
            PG8_LDB(B1, 0, 1); PG8_STAGE(PG8_SB(0, 0), b2, voffB);
            PG8_BAR; PG8_WAIT_L(0); PG8_MMA(0, 1, At, B1); PG8_BAR;
            PG8_LDA(At, 0, 1); PG8_STAGE(PG8_SA(0, 0), a2, voffA);
            PG8_BAR; PG8_WAIT_L(0); PG8_MMA(1, 0, At, B0); PG8_BAR; PG8_SCHED;
            PG8_STAGE(PG8_SB(0, 1), b2 + hstep, voffB);
            PG8_WAIT_V(6); PG8_BAR; PG8_MMA(1, 1, At, B1); PG8_BAR;
            PG8_LDB(B0, 1, 0); PG8_SCHED; PG8_LDA(At, 1, 0); PG8_STAGE(PG8_SA(0, 1), a2 + hstep, voffA);
            PG8_WAIT_L(8); PG8_BAR; PG8_WAIT_L(0); PG8_MMA(0, 0, At, B0); PG8_BAR; PG8_SCHED;
            PG8_LDB(B1, 1, 1); PG8_STAGE(PG8_SB(1, 0), b3, voffB);
            PG8_BAR; PG8_WAIT_L(0); PG8_MMA(0, 1, At, B1); PG8_BAR;
            PG8_LDA(At, 1, 1); PG8_STAGE(PG8_SA(1, 0), a3, voffA);
            PG8_BAR; PG8_WAIT_L(0); PG8_MMA(1, 0, At, B0); PG8_BAR; PG8_SCHED;
            PG8_STAGE(PG8_SB(1, 1), b3 + hstep, voffB);
            PG8_WAIT_V(6); PG8_BAR; PG8_MMA(1, 1, At, B1); PG8_BAR;
            }
        }
        if constexpr (ALIGN_EPI) { if (wr == 0) PG8_BAR; }
        if constexpr (!Epi::AFTER_DRAIN) { E(acc, cur, wr, wc, fr, fq); S.done(cur); }
        if (!has_next) break;
#pragma unroll
        for (int a = 0; a < 2; ++a)
#pragma unroll
            for (int b = 0; b < 2; ++b)
#pragma unroll
                for (int m = 0; m < 4; ++m)
#pragma unroll
                    for (int n = 0; n < 2; ++n) acc[a][b][m][n] = (f32x4){0.f, 0.f, 0.f, 0.f};
        cur = nxt; cA = nA; cB = nB; ++ui;
        if constexpr (ALIGN_EPI) { if (wr == 1) PG8_BAR; }
    }
    PG8_WAIT_V(0);
    if constexpr (!ALIGN_EPI) { if (wr == 0) PG8_BAR; }
    PG8_BAR;
    if constexpr (Epi::AFTER_DRAIN) { E.fused(acc, cur, wr, wc, fr, fq, lds, wid, lane); S.done(cur); }
#undef PG8_SA
#undef PG8_SB
#undef PG8_STAGE
#undef PG8_LDA
#undef PG8_LDB
#undef PG8_MMA
#undef PG8_WAIT_V
#undef PG8_WAIT_L
#undef PG8_BAR
#undef PG8_SCHED
}
}

#define GAS __attribute__((address_space(1)))
#define LAS __attribute__((address_space(3)))
typedef unsigned short bf16;
typedef unsigned v4u __attribute__((ext_vector_type(4)));
typedef unsigned v2u __attribute__((ext_vector_type(2)));
typedef float f32x4 __attribute__((ext_vector_type(4)));
typedef float f32x2 __attribute__((ext_vector_type(2)));
typedef float f32x16 __attribute__((ext_vector_type(16)));
typedef short bf16x8 __attribute__((ext_vector_type(8)));
typedef short s16x4 __attribute__((ext_vector_type(4)));
typedef __bf16 bf16x2_t __attribute__((ext_vector_type(2)));

constexpr int NB = 16, LSEQ = 4096, DM = 1024, DEPTH = 4, CTXL = 256;
constexpr int TL = NB * LSEQ, TC = NB * CTXL, TT = TL + TC;
constexpr int NIN = 5664, FF = 2816, N1 = 2304, N2 = 3584, NU = 5632;
constexpr float LN_EPS = 1e-6f;
constexpr float ALPHA = 1.681792830507429f;
constexpr size_t MiB = (size_t)1 << 20;
constexpr size_t WS_POS = 0, WS_MOD = 1 * MiB, WS_W1T = 3 * MiB, WS_W2T = 21 * MiB, WS_WPT = 49 * MiB, WS_WGT = 53 * MiB, WS_WOT = 61 * MiB,
                 WS_WUT = 69 * MiB, WS_WDT = 113 * MiB, WS_XC = 135 * MiB, WS_UX = 151 * MiB, WS_R = 287 * MiB;
constexpr size_t SU = 68 * MiB;
static_assert((size_t)TT * 512 * 2 == SU, "SU");
constexpr size_t R_Q = 0, R_K = SU, R_V = 2 * SU, R_OF = 4 * SU, R_OB = 6 * SU, R_Z = 8 * SU;
constexpr size_t R_POOL = 0, R_GP = SU, R_GG = 578 * MiB, R_POOLED = 3 * SU;
constexpr size_t R_HID = 0;
constexpr size_t WS_STATS = WS_R + 561 * MiB;
constexpr size_t WS_END = WS_R + 716 * MiB;
static_assert(R_GG >= 8 * SU + 5 * MiB && WS_STATS + MiB <= WS_R + R_GG && R_GG + 2 * SU <= 716 * MiB, "R map");
constexpr int LDS_BYTES = 147456;
constexpr int NTHREADS = 512;

__device__ __forceinline__ unsigned cvtpk(float lo, float hi) { f32x2 v = {lo, hi}; bf16x2_t b = __builtin_convertvector(v, bf16x2_t); return __builtin_bit_cast(unsigned, b); }
__device__ __forceinline__ float bflo(unsigned u) { return __uint_as_float(u << 16); }
__device__ __forceinline__ float bfhi(unsigned u) { return __uint_as_float(u & 0xffff0000u); }
__device__ __forceinline__ float sigmoidf_(float x) { return __builtin_amdgcn_rcpf(1.0f + __expf(-x)); }
__device__ __forceinline__ int lane_id_v() { int l; asm volatile("v_mbcnt_lo_u32_b32 %0, -1, 0\n\tv_mbcnt_hi_u32_b32 %0, -1, %0" : "=v"(l)); return l; }
__device__ __forceinline__ float wave_sum(float v, int lane) {
#pragma unroll
    for (int o = 1; o < 64; o <<= 1) v += __int_as_float(__builtin_amdgcn_ds_bpermute((lane ^ o) << 2, __float_as_int(v)));
    return v;
}
__device__ __forceinline__ float half_sum(float v, int lane) {
#pragma unroll
    for (int o = 1; o < 32; o <<= 1) v += __int_as_float(__builtin_amdgcn_ds_bpermute((lane ^ o) << 2, __float_as_int(v)));
    return v;
}

struct RangeOrder {
    int nM, nN, nwg, G, c;
    __device__ void init(int nM_, int nN_, int G_, int c_) { nM = nM_; nN = nN_; nwg = nM * nN; G = G_; c = c_; }
    __device__ bool next(int i, pg8::Unit& u) const {
        const long L = (long)i * G + c; if (L >= nwg) return false;
        int wgid = (int)L; { const int q = nwg / pg8::NXCD, r = nwg % pg8::NXCD, xcd = wgid % pg8::NXCD, off = wgid / pg8::NXCD; wgid = (xcd < r ? xcd * (q + 1) : r * (q + 1) + (xcd - r) * q) + off; }
        const int nig = pg8::WGM * nN, gid = wgid / nig, fm = gid * pg8::WGM, gsz = (nM - fm) < pg8::WGM ? (nM - fm) : pg8::WGM;
        u.pm = fm + ((wgid % nig) % gsz); u.pn = (wgid % nig) / gsz; return true;
    }
    __device__ __forceinline__ void a_ready(const pg8::Unit&) const {}
    __device__ __forceinline__ void done(const pg8::Unit&) const {}
};

typedef pg8::f32x4 af4;
#define EPI_LOOP for (int ai = 0; ai < 2; ++ai) _Pragma("unroll") for (int m = 0; m < 4; ++m) _Pragma("unroll") for (int bj = 0; bj < 2; ++bj)
#define EPI_RR(base_) int RR = (base_) + ai * 128 + m * 16; asm volatile("" : "+v"(RR));

struct EpiA1 {
    static constexpr bool PERM = true, AFTER_DRAIN = false;
    bf16 *Q, *K, *V, *Z;
    __device__ __forceinline__ void operator()(const af4 (&acc)[2][2][4][2], const pg8::Unit& u, int wr, int wc, int fr_, int fq_) const {
        const int ln_ = lane_id_v(); const int fr = ln_ & 15, fq = ln_ >> 4;
        const int row0 = u.pm * 256 + wr * 64 + fr, pn = u.pn;
        if (pn < 8) {
            bf16* base; int ldc, colt; float sc = 1.f;
            if (pn < 2) { base = Q; ldc = 512; colt = pn * 256; sc = 0.08838834764831845f; }
            else if (pn < 4) { base = K; ldc = 512; colt = (pn - 2) * 256; }
            else { base = V; ldc = 1024; colt = (pn - 4) * 256; }
            const int col0 = colt + wc * 32 + 8 * fq;
#pragma unroll
            EPI_LOOP { EPI_RR(row0) const af4 v0 = acc[ai][bj][m][0] * sc, v1 = acc[ai][bj][m][1] * sc; v4u w; w.x = cvtpk(v0[0], v0[1]); w.y = cvtpk(v0[2], v0[3]); w.z = cvtpk(v1[0], v1[1]); w.w = cvtpk(v1[2], v1[3]);
                *(v4u*)(base + (size_t)RR * ldc + col0 + bj * 128) = w; }
        } else if (wc == 0) {
#pragma unroll
            for (int ai = 0; ai < 2; ++ai)
#pragma unroll
                for (int m = 0; m < 4; ++m) { const af4 v0 = acc[ai][0][m][0], v1 = acc[ai][0][m][1]; v4u w; w.x = cvtpk(v0[0], v0[1]); w.y = cvtpk(v0[2], v0[3]); w.z = cvtpk(v1[0], v1[1]); w.w = cvtpk(v1[2], v1[3]);
                    *(v4u*)(Z + (size_t)(row0 + ai * 128 + m * 16) * 32 + 8 * fq) = w; }
        }
    }
};
struct EpiA2 {
    static constexpr bool PERM = true, AFTER_DRAIN = false;
    bf16 *POOL, *ON, *GP, *GG; const bf16* OBp; const float* nw; LAS float* xch;
    __device__ __forceinline__ void operator()(const af4 (&acc)[2][2][4][2], const pg8::Unit& u, int wr, int wc, int fr_, int fq_) const {
        const int ln_ = lane_id_v(); const int fr = ln_ & 15, fq = ln_ >> 4;
        const int row0 = u.pm * 256 + wr * 64 + fr, pn = u.pn;
        if (pn < 2) {
            const int col0 = pn * 256 + wc * 32 + 8 * fq;
#pragma unroll
            EPI_LOOP { EPI_RR(row0) const af4 v0 = acc[ai][bj][m][0], v1 = acc[ai][bj][m][1]; v4u w; w.x = cvtpk(v0[0], v0[1]); w.y = cvtpk(v0[2], v0[3]); w.z = cvtpk(v1[0], v1[1]); w.w = cvtpk(v1[2], v1[3]);
                *(v4u*)(POOL + (size_t)RR * 512 + col0 + bj * 128) = w; }
        } else if (pn < 6) {
            const int col0 = (pn - 2) * 256 + wc * 32 + 8 * fq;
            float ssq[8];
#pragma unroll
            for (int b_ = 0; b_ < 4; ++b_) {
                const int ai = b_ >> 1, mp = b_ & 1;
                int RRb = row0 + ai * 128 + mp * 32; asm volatile("" : "+v"(RRb));
                const size_t ob = (size_t)RRb * 1024 + col0; v4u of_[2][2], ob_[2][2];
#pragma unroll
                for (int mi = 0; mi < 2; ++mi)
#pragma unroll
                    for (int bj = 0; bj < 2; ++bj) { of_[mi][bj] = *(const v4u*)(ON + ob + mi * 16 * 1024 + bj * 128); ob_[mi][bj] = *(const v4u*)(OBp + ob + mi * 16 * 1024 + bj * 128); }
#pragma unroll
                for (int mi = 0; mi < 2; ++mi) { float q = 0.f;
#pragma unroll
                    for (int bj = 0; bj < 2; ++bj) { const v4u a = of_[mi][bj], c = ob_[mi][bj];
                        const float o0 = bflo(a.x) + bflo(c.x), o1 = bfhi(a.x) + bfhi(c.x), o2 = bflo(a.y) + bflo(c.y), o3 = bfhi(a.y) + bfhi(c.y), o4 = bflo(a.z) + bflo(c.z), o5 = bfhi(a.z) + bfhi(c.z), o6 = bflo(a.w) + bflo(c.w), o7 = bfhi(a.w) + bfhi(c.w);
                        q += (o0 * o0 + o1 * o1) + (o2 * o2 + o3 * o3) + (o4 * o4 + o5 * o5) + (o6 * o6 + o7 * o7); }
                    ssq[ai * 4 + mp * 2 + mi] = q; }
                asm volatile("" ::: "memory");
            }
#pragma unroll
            for (int k = 0; k < 8; ++k) { float v = ssq[k];
                v += __int_as_float(__builtin_amdgcn_ds_bpermute((ln_ ^ 16) << 2, __float_as_int(v)));
                v += __int_as_float(__builtin_amdgcn_ds_bpermute((ln_ ^ 32) << 2, __float_as_int(v))); ssq[k] = v; }
            if (fq == 0) {
#pragma unroll
                for (int k = 0; k < 8; ++k) xch[((k >> 2) * 128 + wr * 64 + (k & 3) * 16 + fr) * 4 + wc] = ssq[k];
            }
            asm volatile("s_waitcnt lgkmcnt(0)" ::: "memory"); __builtin_amdgcn_s_barrier(); asm volatile("" ::: "memory");
            float rs[8];
#pragma unroll
            for (int k = 0; k < 8; ++k) { const f32x4 p4 = *(const LAS f32x4*)(xch + ((k >> 2) * 128 + wr * 64 + (k & 3) * 16 + fr) * 4);
                rs[k] = 1.0f / sqrtf(((p4[0] + p4[1]) + (p4[2] + p4[3])) * (1.f / 256.f) + LN_EPS); }
            f32x4 nwv[2][2];
#pragma unroll
            for (int bj = 0; bj < 2; ++bj) { nwv[bj][0] = *(const f32x4*)(nw + col0 + bj * 128); nwv[bj][1] = *(const f32x4*)(nw + col0 + bj * 128 + 4); }
#pragma unroll
            for (int b_ = 0; b_ < 4; ++b_) {
                const int ai = b_ >> 1, mp = b_ & 1;
                int RRb = row0 + ai * 128 + mp * 32; asm volatile("" : "+v"(RRb));
                const size_t ob = (size_t)RRb * 1024 + col0; v4u of_[2][2], ob_[2][2];
#pragma unroll
                for (int mi = 0; mi < 2; ++mi)
#pragma unroll
                    for (int bj = 0; bj < 2; ++bj) { of_[mi][bj] = *(const v4u*)(ON + ob + mi * 16 * 1024 + bj * 128); ob_[mi][bj] = *(const v4u*)(OBp + ob + mi * 16 * 1024 + bj * 128); }
#pragma unroll
                for (int mi = 0; mi < 2; ++mi) { const float rstd = rs[ai * 4 + mp * 2 + mi];
#pragma unroll
                    for (int bj = 0; bj < 2; ++bj) { af4 v0 = acc[ai][bj][mp * 2 + mi][0], v1 = acc[ai][bj][mp * 2 + mi][1]; asm volatile("" : "+v"(v0), "+v"(v1)); const v4u a = of_[mi][bj], c = ob_[mi][bj];
#pragma unroll
                        for (int e = 0; e < 4; ++e) { v0[e] = v0[e] * sigmoidf_(v0[e]) * (rstd * nwv[bj][0][e]); v1[e] = v1[e] * sigmoidf_(v1[e]) * (rstd * nwv[bj][1][e]); }
                        v4u w; w.x = cvtpk(v0[0] * (bflo(a.x) + bflo(c.x)), v0[1] * (bfhi(a.x) + bfhi(c.x))); w.y = cvtpk(v0[2] * (bflo(a.y) + bflo(c.y)), v0[3] * (bfhi(a.y) + bfhi(c.y)));
                        w.z = cvtpk(v1[0] * (bflo(a.z) + bflo(c.z)), v1[1] * (bfhi(a.z) + bfhi(c.z))); w.w = cvtpk(v1[2] * (bflo(a.w) + bflo(c.w)), v1[3] * (bfhi(a.w) + bfhi(c.w)));
                        *(v4u*)(ON + ob + mi * 16 * 1024 + bj * 128) = w; } }
                asm volatile("" ::: "memory");
            }
        } else {
            bf16* base = pn < 10 ? GP : GG; const int col0 = ((pn - 6) & 3) * 256 + wc * 32 + 8 * fq;
#pragma unroll
            EPI_LOOP { EPI_RR(row0) af4 v0 = acc[ai][bj][m][0], v1 = acc[ai][bj][m][1];
#pragma unroll
                for (int e = 0; e < 4; ++e) { v0[e] = sigmoidf_(v0[e]); v1[e] = sigmoidf_(v1[e]); }
                v4u w; w.x = cvtpk(v0[0], v0[1]); w.y = cvtpk(v0[2], v0[3]); w.z = cvtpk(v1[0], v1[1]); w.w = cvtpk(v1[2], v1[3]);
                *(v4u*)(base + (size_t)RR * 1024 + col0 + bj * 128) = w; asm volatile("" ::: "memory"); }
        }
    }
};
struct EpiMul {
    static constexpr bool PERM = true, AFTER_DRAIN = false;
    bf16* G;
    __device__ __forceinline__ void operator()(const af4 (&acc)[2][2][4][2], const pg8::Unit& u, int wr, int wc, int fr_, int fq_) const {
        const int ln_ = lane_id_v(); const int fr = ln_ & 15, fq = ln_ >> 4;
        const int row0 = u.pm * 256 + wr * 64 + fr, col0 = u.pn * 256 + wc * 32 + 8 * fq;
        v4u o[2][2][2];
#define MUL_LOAD(buf, b_) do { int RRl = row0 + ((b_) >> 1) * 128 + ((b_) & 1) * 32; asm volatile("" : "+v"(RRl)); const bf16* pl = G + (size_t)RRl * 1024 + col0; \
            _Pragma("unroll") for (int mi = 0; mi < 2; ++mi) _Pragma("unroll") for (int bj = 0; bj < 2; ++bj) o[buf][mi][bj] = *(const v4u*)(pl + mi * 16 * 1024 + bj * 128); } while (0)
        MUL_LOAD(0, 0);
#pragma unroll
        for (int b_ = 0; b_ < 4; ++b_) {
            const int ai = b_ >> 1, mp = b_ & 1, cur = b_ & 1;
            if (b_ + 1 < 4) { if (cur == 0) MUL_LOAD(1, b_ + 1); else MUL_LOAD(0, b_ + 1); }
            int RRb = row0 + ai * 128 + mp * 32; asm volatile("" : "+v"(RRb));
            bf16* pb = G + (size_t)RRb * 1024 + col0;
#pragma unroll
            for (int mi = 0; mi < 2; ++mi)
#pragma unroll
                for (int bj = 0; bj < 2; ++bj) { const af4 v0 = acc[ai][bj][mp * 2 + mi][0], v1 = acc[ai][bj][mp * 2 + mi][1]; const v4u oo = o[cur][mi][bj];
                    v4u w; w.x = cvtpk(v0[0] * bflo(oo.x), v0[1] * bfhi(oo.x)); w.y = cvtpk(v0[2] * bflo(oo.y), v0[3] * bfhi(oo.y)); w.z = cvtpk(v1[0] * bflo(oo.z), v1[1] * bfhi(oo.z)); w.w = cvtpk(v1[2] * bflo(oo.w), v1[3] * bfhi(oo.w));
                    *(v4u*)(pb + mi * 16 * 1024 + bj * 128) = w; }
            asm volatile("" ::: "memory");
        }
#undef MUL_LOAD
    }
};
struct EpiMulAdd {
    static constexpr bool PERM = true, AFTER_DRAIN = false;
    bf16* G; const bf16* Y;
    __device__ __forceinline__ void operator()(const af4 (&acc)[2][2][4][2], const pg8::Unit& u, int wr, int wc, int fr_, int fq_) const {
        const int ln_ = lane_id_v(); const int fr = ln_ & 15, fq = ln_ >> 4;
        const int row0 = u.pm * 256 + wr * 64 + fr, col0 = u.pn * 256 + wc * 32 + 8 * fq;
        v4u o[2][2][2], yv[2][2][2];
#define MA_LOAD(buf, b_) do { int RRl = row0 + ((b_) >> 1) * 128 + ((b_) & 1) * 32; asm volatile("" : "+v"(RRl)); const size_t ol = (size_t)RRl * 1024 + col0; \
            _Pragma("unroll") for (int mi = 0; mi < 2; ++mi) _Pragma("unroll") for (int bj = 0; bj < 2; ++bj) { o[buf][mi][bj] = *(const v4u*)(G + ol + mi * 16 * 1024 + bj * 128); yv[buf][mi][bj] = *(const v4u*)(Y + ol + mi * 16 * 1024 + bj * 128); } } while (0)
        MA_LOAD(0, 0);
#pragma unroll
        for (int b_ = 0; b_ < 4; ++b_) {
            const int ai = b_ >> 1, mp = b_ & 1, cur = b_ & 1;
            if (b_ + 1 < 4) { if (cur == 0) MA_LOAD(1, b_ + 1); else MA_LOAD(0, b_ + 1); }
            int RRb = row0 + ai * 128 + mp * 32; asm volatile("" : "+v"(RRb));
            const size_t ob = (size_t)RRb * 1024 + col0;
#pragma unroll
            for (int mi = 0; mi < 2; ++mi)
#pragma unroll
                for (int bj = 0; bj < 2; ++bj) { const af4 v0 = acc[ai][bj][mp * 2 + mi][0], v1 = acc[ai][bj][mp * 2 + mi][1]; const v4u oo = o[cur][mi][bj], y = yv[cur][mi][bj];
                    v4u w; w.x = cvtpk(bflo(y.x) + v0[0] * bflo(oo.x), bfhi(y.x) + v0[1] * bfhi(oo.x)); w.y = cvtpk(bflo(y.y) + v0[2] * bflo(oo.y), bfhi(y.y) + v0[3] * bfhi(oo.y));
                    w.z = cvtpk(bflo(y.z) + v1[0] * bflo(oo.z), bfhi(y.z) + v1[1] * bfhi(oo.z)); w.w = cvtpk(bflo(y.w) + v1[2] * bflo(oo.w), bfhi(y.w) + v1[3] * bfhi(oo.w));
                    *(v4u*)(G + ob + mi * 16 * 1024 + bj * 128) = w; }
            asm volatile("" ::: "memory");
        }
#undef MA_LOAD
    }
};
struct EpiRes {
    static constexpr bool PERM = true, AFTER_DRAIN = false;
    float* xl; float* xc; const float* gate; int rowbase; const float* stats; const float* lnw; const float* lnb;
    __device__ __forceinline__ void operator()(const af4 (&acc)[2][2][4][2], const pg8::Unit& u, int wr, int wc, int fr_, int fq_) const {
        const int ln_ = lane_id_v(); const int fr = ln_ & 15, fq = ln_ >> 4;
        const int grow = rowbase + u.pm * 256; const int bi = grow < TL ? grow / LSEQ : NB;
        float* xb = grow < TL ? xl + (size_t)grow * DM : xc + (size_t)(grow - TL) * DM;
        const float* stb = stats + 2 * (size_t)grow;
        const int col0 = u.pn * 256 + wc * 32 + 8 * fq; const float* gp = gate + (size_t)bi * 6144 + col0;
        f32x4 g[2][2], wa[2][2], ba[2][2];
#pragma unroll
        for (int bj = 0; bj < 2; ++bj)
#pragma unroll
            for (int hf = 0; hf < 2; ++hf) { g[bj][hf] = *(const f32x4*)(gp + bj * 128 + 4 * hf);
                if (lnw) { wa[bj][hf] = *(const f32x4*)(lnw + col0 + bj * 128 + 4 * hf) * ALPHA; ba[bj][hf] = *(const f32x4*)(lnb + col0 + bj * 128 + 4 * hf) * ALPHA; }
                else { wa[bj][hf] = (f32x4){ALPHA, ALPHA, ALPHA, ALPHA}; ba[bj][hf] = (f32x4){0.f, 0.f, 0.f, 0.f}; } }
        const int row0 = wr * 64 + fr;
#pragma unroll
        for (int b_ = 0; b_ < 4; ++b_) {
            const int ai = b_ >> 1, mp = b_ & 1;
            int RRb = row0 + ai * 128 + mp * 32; asm volatile("" : "+v"(RRb));
            float* pb = xb + (size_t)RRb * DM + col0;
            f32x4 xv[2][2][2]; f32x2 st[2];
#pragma unroll
            for (int mi = 0; mi < 2; ++mi) { st[mi] = *(const f32x2*)(stb + 2 * (RRb + mi * 16));
#pragma unroll
                for (int bj = 0; bj < 2; ++bj) { xv[mi][bj][0] = *(const f32x4*)(pb + mi * 16 * DM + bj * 128); xv[mi][bj][1] = *(const f32x4*)(pb + mi * 16 * DM + bj * 128 + 4); } }
#pragma unroll
            for (int mi = 0; mi < 2; ++mi)
#pragma unroll
                for (int bj = 0; bj < 2; ++bj) { f32x4 o0, o1; const float mean = st[mi].x, rstd = st[mi].y;
#pragma unroll
                    for (int e = 0; e < 4; ++e) {
                        o0[e] = (xv[mi][bj][0][e] - mean) * (wa[bj][0][e] * rstd) + (ba[bj][0][e] + g[bj][0][e] * acc[ai][bj][mp * 2 + mi][0][e]);
                        o1[e] = (xv[mi][bj][1][e] - mean) * (wa[bj][1][e] * rstd) + (ba[bj][1][e] + g[bj][1][e] * acc[ai][bj][mp * 2 + mi][1][e]); }
                    *(f32x4*)(pb + mi * 16 * DM + bj * 128) = o0; *(f32x4*)(pb + mi * 16 * DM + bj * 128 + 4) = o1; }
            asm volatile("" ::: "memory");
        }
    }
};
struct EpiUp {
    static constexpr bool PERM = true, AFTER_DRAIN = false;
    bf16* UP;
    __device__ __forceinline__ void operator()(const af4 (&acc)[2][2][4][2], const pg8::Unit& u, int wr, int wc, int fr_, int fq_) const {
        const int ln_ = lane_id_v(); const int fr = ln_ & 15, fq = ln_ >> 4;
        const int row0 = u.pm * 256 + wr * 64 + fr, col0 = u.pn * 256 + wc * 32 + 8 * fq;
#pragma unroll
        EPI_LOOP { EPI_RR(row0) const af4 v0 = acc[ai][bj][m][0], v1 = acc[ai][bj][m][1]; v4u w; w.x = cvtpk(v0[0], v0[1]); w.y = cvtpk(v0[2], v0[3]); w.z = cvtpk(v1[0], v1[1]); w.w = cvtpk(v1[2], v1[3]);
            *(v4u*)(UP + (size_t)RR * NU + col0 + bj * 128) = w; }
    }
};


__device__ __forceinline__ float gelu_erf(float v) {
    const float av = fabsf(v), t = __builtin_amdgcn_rcpf(av * 0.2316418882f + 1.0f);
    float q = t * 0.5307027145f + (-0.7265760135f); q = q * t + 0.7107068705f; q = q * t + (-0.142248368f); q = q * t + 0.127414796f; q = q * t;
    const float e = __builtin_amdgcn_exp2f((v * v) * (-0.72134752044f));
    const float mm = v * (q * e);
    return v < 0.f ? mm : v - mm;
}

__device__ __forceinline__ f32x2 gelu_pk(f32x2 v) {
    const f32x2 av = __builtin_elementwise_abs(v), d = av * 0.2316418882f + 1.0f;
    f32x2 t; t.x = __builtin_amdgcn_rcpf(d.x); t.y = __builtin_amdgcn_rcpf(d.y);
    f32x2 q = t * 0.5307027145f + (-0.7265760135f); q = q * t + 0.7107068705f; q = q * t + (-0.142248368f); q = q * t + 0.127414796f; q = q * t;
    const f32x2 sq = (v * v) * (-0.72134752044f);
    f32x2 e; e.x = __builtin_amdgcn_exp2f(sq.x); e.y = __builtin_amdgcn_exp2f(sq.y);
    const f32x2 mm = v * (q * e), rr = v - mm;
    f32x2 o; o.x = v.x < 0.f ? mm.x : rr.x; o.y = v.y < 0.f ? mm.y : rr.y; return o;
}
#define DPP_ROR1(x) __int_as_float(__builtin_amdgcn_update_dpp(0, __float_as_int(x), 0x121, 0xf, 0xf, false))
#define DPP_ROR15(x) __int_as_float(__builtin_amdgcn_update_dpp(0, __float_as_int(x), 0x12F, 0xf, 0xf, false))
struct EpiUpConv {
    static constexpr bool PERM = true, AFTER_DRAIN = false;
    bf16* HID; const float* cw; const float* cb; LAS float* xch;
    __device__ __forceinline__ void operator()(const af4 (&acc)[2][2][4][2], const pg8::Unit& u, int wr, int wc, int fr_, int fq_) const {
        const int ln_ = lane_id_v(); const int fr = ln_ & 15, fq = ln_ >> 4;
        const int row0 = u.pm * 256 + wr * 64 + fr, jl = 32 * wc + 8 * fq, j0 = 128 * u.pn + jl;
        const bool isctx = u.pm >= TL / 256;
        f32x4 cwv[2][4];
#pragma unroll
        for (int n = 0; n < 2; ++n) { cwv[n][0] = *(const f32x4*)(cw + j0 + 4 * n); cwv[n][1] = *(const f32x4*)(cw + FF + j0 + 4 * n); cwv[n][2] = *(const f32x4*)(cw + 2 * FF + j0 + 4 * n); cwv[n][3] = *(const f32x4*)(cb + j0 + 4 * n); }
        if (isctx) {
#pragma unroll
            for (int ai = 0; ai < 2; ++ai) { const int blk = 2 * ai + wr;
                if (fr == 0) { *(LAS f32x4*)(xch + (blk * 2 + 0) * 128 + jl) = acc[ai][0][0][0]; *(LAS f32x4*)(xch + (blk * 2 + 0) * 128 + jl + 4) = acc[ai][0][0][1]; }
                if (fr == 15) { *(LAS f32x4*)(xch + (blk * 2 + 1) * 128 + jl) = acc[ai][0][3][0]; *(LAS f32x4*)(xch + (blk * 2 + 1) * 128 + jl + 4) = acc[ai][0][3][1]; } }
            asm volatile("s_waitcnt lgkmcnt(0)" ::: "memory"); __builtin_amdgcn_s_barrier(); asm volatile("" ::: "memory");
        }
#pragma unroll
        for (int ai = 0; ai < 2; ++ai)
#pragma unroll
            for (int n = 0; n < 2; ++n) {
                const f32x4 w0 = cwv[n][0], w1 = cwv[n][1], w2 = cwv[n][2], bb = cwv[n][3];
                f32x4 bprev = {0.f, 0.f, 0.f, 0.f}, bnext = {0.f, 0.f, 0.f, 0.f};
                if (isctx) { const int blk = 2 * ai + wr;
                    if (blk > 0) bprev = *(const LAS f32x4*)(xch + ((blk - 1) * 2 + 1) * 128 + jl + 4 * n);
                    if (blk < 3) bnext = *(const LAS f32x4*)(xch + ((blk + 1) * 2 + 0) * 128 + jl + 4 * n); }
                f32x4 R[4], L[4];
#pragma unroll
                for (int m = 0; m < 4; ++m)
#pragma unroll
                    for (int e = 0; e < 4; ++e) { R[m][e] = DPP_ROR1(acc[ai][0][m][n][e]); L[m][e] = DPP_ROR15(acc[ai][0][m][n][e]); }
#pragma unroll
                for (int m = 0; m < 4; ++m) {
                    f32x2 o2[2];
#pragma unroll
                    for (int ep = 0; ep < 2; ++ep) {
                        f32x2 pv, nv;
#pragma unroll
                        for (int q = 0; q < 2; ++q) { const int e = 2 * ep + q;
                            pv[q] = (fr == 0) ? (m == 0 ? bprev[e] : R[m == 0 ? 0 : m - 1][e]) : R[m][e];
                            nv[q] = (fr == 15) ? (m == 3 ? bnext[e] : L[m == 3 ? 3 : m + 1][e]) : L[m][e]; }
                        const f32x2 a2 = {acc[ai][0][m][n][2 * ep], acc[ai][0][m][n][2 * ep + 1]}, g2 = {acc[ai][1][m][n][2 * ep], acc[ai][1][m][n][2 * ep + 1]};
                        const f32x2 w0p = {w0[2 * ep], w0[2 * ep + 1]}, w1p = {w1[2 * ep], w1[2 * ep + 1]}, w2p = {w2[2 * ep], w2[2 * ep + 1]}, bbp = {bb[2 * ep], bb[2 * ep + 1]};
                        const f32x2 c2 = w0p * pv + (w1p * a2 + (w2p * nv + bbp));
                        o2[ep] = gelu_pk(c2) * g2;
                    }
                    v2u w; w.x = cvtpk(o2[0].x, o2[0].y); w.y = cvtpk(o2[1].x, o2[1].y);
                    *(v2u*)(HID + (size_t)(row0 + ai * 128 + m * 16) * FF + j0 + 4 * n) = w;
                }
            }
    }
};
template <class Epi, bool ALIGN = false> __device__ __forceinline__ void run_gemm(LAS unsigned char* lds, const bf16* A, const bf16* Bt, int nM, int N, int K, const Epi& E, const int wave_s) {
    pg8::Gemm g{A, Bt, nM * 256, N, K}; RangeOrder S; S.init(nM, N / 256, (int)gridDim.x, (int)blockIdx.x);
    pg8::gemm_phase<Epi, RangeOrder, ALIGN, true>(lds, g, S, E, wave_s);
}

__device__ __forceinline__ void transpose_block(const float* W, int ldw, int src_n0, int k0, bf16* WT, int K, int dst_n0, LAS float* scr, int lane) {
    if (src_n0 >= 0) {
#pragma unroll
        for (int i = 0; i < 32; ++i) { const int kk = 2 * i + (lane >> 5); scr[kk * 33 + (lane & 31)] = W[(size_t)(k0 + kk) * ldw + src_n0 + (lane & 31)]; }
    } else {
#pragma unroll 8
        for (int i = 0; i < 32; ++i) { const int kk = 2 * i + (lane >> 5); scr[kk * 33 + (lane & 31)] = 0.f; }
    }
    asm volatile("s_waitcnt lgkmcnt(0)" ::: "memory");
    const int c = lane & 7;
#pragma unroll
    for (int j = 0; j < 4; ++j) { const int n = (lane >> 3) + 8 * j; const LAS float* s = scr + (8 * c) * 33 + n;
        v4u o; o.x = cvtpk(s[0 * 33], s[1 * 33]); o.y = cvtpk(s[2 * 33], s[3 * 33]); o.z = cvtpk(s[4 * 33], s[5 * 33]); o.w = cvtpk(s[6 * 33], s[7 * 33]);
        *(v4u*)(WT + (size_t)(dst_n0 + n) * K + k0 + 8 * c) = o; }
    asm volatile("s_waitcnt lgkmcnt(0)" ::: "memory");
}

struct P {
    const float* in[25]; float* out; unsigned char* ws;
};

__device__ __forceinline__ void ln_core(f32x4 (&v)[4], int lane) {
    float s = 0.f;
#pragma unroll
    for (int j = 0; j < 4; ++j) s += (v[j][0] + v[j][1]) + (v[j][2] + v[j][3]);
    const float mean = wave_sum(s, lane) * (1.f / DM); float s2 = 0.f;
#pragma unroll
    for (int j = 0; j < 4; ++j) { v[j] = v[j] - mean; s2 += (v[j][0] * v[j][0] + v[j][1] * v[j][1]) + (v[j][2] * v[j][2] + v[j][3] * v[j][3]); }
    const float rstd = 1.0f / sqrtf(wave_sum(s2, lane) * (1.f / DM) + LN_EPS);
#pragma unroll
    for (int j = 0; j < 4; ++j) v[j] = v[j] * rstd;
}
__device__ __forceinline__ void store_x_ux(const f32x4 (&v)[4], float* xrow, bf16* uxrow, const float* sh, const float* sc, int lane) {
#pragma unroll
    for (int j = 0; j < 4; ++j) {
        const int c = 4 * lane + 256 * j;
        *(f32x4*)(xrow + c) = v[j];
        if (uxrow) { const f32x4 a = *(const f32x4*)(sc + c), b = *(const f32x4*)(sh + c);
            v2u w; w.x = cvtpk(v[j][0] * (1.f + a[0]) + b[0], v[j][1] * (1.f + a[1]) + b[1]); w.y = cvtpk(v[j][2] * (1.f + a[2]) + b[2], v[j][3] * (1.f + a[3]) + b[3]);
            *(v2u*)(uxrow + c) = w; }
    }
}


__device__ __forceinline__ float dpp_row_total(float v) {
    v += __int_as_float(__builtin_amdgcn_update_dpp(0, __float_as_int(v), 0xB1, 0xf, 0xf, false));
    v += __int_as_float(__builtin_amdgcn_update_dpp(0, __float_as_int(v), 0x4E, 0xf, 0xf, false));
    v += __int_as_float(__builtin_amdgcn_update_dpp(0, __float_as_int(v), 0x141, 0xf, 0xf, false));
    v += __int_as_float(__builtin_amdgcn_update_dpp(0, __float_as_int(v), 0x140, 0xf, 0xf, false));
    return v;
}
__device__ __forceinline__ float wave_sum_dpp(float v) {
    v = dpp_row_total(v); const int i = __float_as_int(v);
    return (__int_as_float(__builtin_amdgcn_readlane(i, 0)) + __int_as_float(__builtin_amdgcn_readlane(i, 16))) + (__int_as_float(__builtin_amdgcn_readlane(i, 32)) + __int_as_float(__builtin_amdgcn_readlane(i, 48)));
}
__device__ __forceinline__ float half_sum_dpp(float v, int lane) {
    v = dpp_row_total(v); const int i = __float_as_int(v);
    const float t0 = __int_as_float(__builtin_amdgcn_readlane(i, 0)) + __int_as_float(__builtin_amdgcn_readlane(i, 16));
    const float t1 = __int_as_float(__builtin_amdgcn_readlane(i, 32)) + __int_as_float(__builtin_amdgcn_readlane(i, 48));
    return lane < 32 ? t0 : t1;
}
__device__ __forceinline__ void ln_phase(const int lane, const int gw, const int NGW, const int rows, float* xl, float* xcp, const float* lw, const float* lb,
                                         const float* modl, const int sh_off, const int sc_off, bf16* UXp, const float* x_init, const float* ctx_init, const float* POSp, float* stats, const bool final_x) {
    for (int row0 = gw * 4; row0 < rows; row0 += NGW * 4) {
        f32x4 v[4][4]; const bool lat = row0 < TL; const int bi = lat ? row0 / LSEQ : NB;
#pragma unroll
        for (int rr = 0; rr < 4; ++rr) { const int row = row0 + rr;
            const float* src = x_init ? (lat ? x_init + (size_t)row * DM : ctx_init + (size_t)(row - TL) * DM) : (lat ? xl + (size_t)row * DM : xcp + (size_t)(row - TL) * DM);
#pragma unroll
            for (int j = 0; j < 4; ++j) v[rr][j] = __builtin_nontemporal_load((const f32x4*)(src + 4 * lane + 256 * j)); }
        if (x_init && lat) {
#pragma unroll
            for (int rr = 0; rr < 4; ++rr) { const int t = (row0 + rr) % LSEQ; const float* e0 = POSp + (t >> 6) * 512; const float* e1 = POSp + (t & 63) * 512;
#pragma unroll
                for (int j = 0; j < 4; ++j) { const int c = 4 * lane + 256 * j; v[rr][j] += (j < 2) ? *(const f32x4*)(e0 + c) : *(const f32x4*)(e1 + c - 512); } }
        }
        if (x_init) {
#pragma unroll
            for (int rr = 0; rr < 4; ++rr) { const int row = row0 + rr; float* dst = lat ? xl + (size_t)row * DM : xcp + (size_t)(row - TL) * DM;
#pragma unroll
                for (int j = 0; j < 4; ++j) *(f32x4*)(dst + 4 * lane + 256 * j) = v[rr][j]; }
        }
        float mean[4], rstd[4];
#pragma unroll
        for (int rr = 0; rr < 4; ++rr) { float s = 0.f;
#pragma unroll
            for (int j = 0; j < 4; ++j) s += (v[rr][j][0] + v[rr][j][1]) + (v[rr][j][2] + v[rr][j][3]);
            mean[rr] = wave_sum_dpp(s) * (1.f / DM); }
#pragma unroll
        for (int rr = 0; rr < 4; ++rr) { float s2 = 0.f;
#pragma unroll
            for (int j = 0; j < 4; ++j) { v[rr][j] = v[rr][j] - mean[rr]; s2 += (v[rr][j][0] * v[rr][j][0] + v[rr][j][1] * v[rr][j][1]) + (v[rr][j][2] * v[rr][j][2] + v[rr][j][3] * v[rr][j][3]); }
            rstd[rr] = 1.0f / sqrtf(wave_sum_dpp(s2) * (1.f / DM) + LN_EPS); }
        if (lane == 0) {
#pragma unroll
            for (int rr = 0; rr < 4; ++rr) *(f32x2*)(stats + 2 * (size_t)(row0 + rr)) = (f32x2){mean[rr], rstd[rr]};
        }
        const float* md = modl + (size_t)bi * 6144;
#pragma unroll
        for (int j = 0; j < 4; ++j) { const int c = 4 * lane + 256 * j;
            f32x4 w4 = {1.f, 1.f, 1.f, 1.f}, b4 = {0.f, 0.f, 0.f, 0.f}; if (lw) { w4 = *(const f32x4*)(lw + c); b4 = *(const f32x4*)(lb + c); }
            f32x4 sc4 = {0.f, 0.f, 0.f, 0.f}, sh4 = {0.f, 0.f, 0.f, 0.f}; if (UXp) { sc4 = *(const f32x4*)(md + sc_off + c); sh4 = *(const f32x4*)(md + sh_off + c); }
#pragma unroll
            for (int rr = 0; rr < 4; ++rr) { const int row = row0 + rr; const f32x4 y = v[rr][j] * rstd[rr] * w4 + b4;
                if (final_x) { float* dst = lat ? xl + (size_t)row * DM : xcp + (size_t)(row - TL) * DM; *(f32x4*)(dst + c) = y; }
                if (UXp) { v2u w; w.x = cvtpk(y[0] * (1.f + sc4[0]) + sh4[0], y[1] * (1.f + sc4[1]) + sh4[1]); w.y = cvtpk(y[2] * (1.f + sc4[2]) + sh4[2], y[3] * (1.f + sc4[3]) + sh4[3]); __builtin_nontemporal_store(w, (v2u*)(UXp + (size_t)row * DM + c)); } }
        }
    }
}
#define MFMA32(a, b, c) __builtin_amdgcn_mfma_f32_32x32x16_bf16((a), (b), (c), 0, 0, 0)
__device__ __forceinline__ bf16x8 pack_step(const f32x16& x, int s) {
    v4u p; p.x = cvtpk(x[8 * s + 0], x[8 * s + 1]); p.y = cvtpk(x[8 * s + 2], x[8 * s + 3]); p.z = cvtpk(x[8 * s + 4], x[8 * s + 5]); p.w = cvtpk(x[8 * s + 6], x[8 * s + 7]);
    return __builtin_bit_cast(bf16x8, p);
}
constexpr int G_QE = 0, G_KE = 17408, G_KT = 34816, G_VT = 53248, G_BC = 71680, G_ZS = G_BC + 64 * 528, G_SEG = G_ZS + 4096, G_DEC = G_SEG + 2048, G_END = G_DEC + 512;
static_assert(G_END <= 131072, "gla lds");
constexpr int NCHUNK = 68;

__device__ __forceinline__ int gla_row(int n, int p, int b, int dir) {
    const bool isctx = n < 4; const int nn = isctx ? n : n - 4; const int Ls = isctx ? CTXL : LSEQ; const int Pp = 64 * nn + p;
    const int tok = dir ? (Ls - 1 - Pp) : Pp; return (isctx ? TL + b * CTXL : b * LSEQ) + tok;
}

__device__ __forceinline__ void gla_phase(LAS unsigned char* lds, const bf16* Q, const bf16* K, const bf16* V, const bf16* Z, bf16* OF, bf16* OB,
                                          const float* wgf, const float* bgf, const float* wgb, const float* bgb, const int wave_s) {
    const int lane = lane_id_v(), wid = wave_s, tid = wid * 64 + lane, r = lane & 31, h = lane >> 5, wv = wid & 3, wi = wid >> 2;
    LAS unsigned char* Qe = lds + G_QE; LAS unsigned char* Ke = lds + G_KE; LAS unsigned char* KT = lds + G_KT; LAS unsigned char* VT = lds + G_VT;
    LAS float* Bc = (LAS float*)(lds + G_BC); LAS unsigned char* Zs = lds + G_ZS; LAS float* Seg = (LAS float*)(lds + G_SEG); LAS float* Dec = (LAS float*)(lds + G_DEC);
    for (int w = blockIdx.x; w < 256; w += gridDim.x) {
        const int b = w >> 4, hh = (w >> 2) & 3, dir = (w >> 1) & 1, vh = w & 1;
        const float* wg = dir ? wgb : wgf; const float* bg = dir ? bgb : bgf; bf16* O = dir ? OB : OF;
        const float bgl = bg[hh * 128 + 32 * wv + r];
        bf16x8 wghi;
        { float wf[8];
#pragma unroll
          for (int j = 0; j < 8; ++j) wf[j] = wg[(8 * h + j) * 512 + hh * 128 + 32 * wv + r];
          v4u ph; ph.x = cvtpk(wf[0], wf[1]); ph.y = cvtpk(wf[2], wf[3]); ph.z = cvtpk(wf[4], wf[5]); ph.w = cvtpk(wf[6], wf[7]);
          wghi = __builtin_bit_cast(bf16x8, ph); }
        f32x16 S[4];
#pragma unroll
        for (int t = 0; t < 4; ++t)
#pragma unroll
            for (int e = 0; e < 16; ++e) S[t][e] = 0.f;
        v4u rq[2], rk[2], rv[2], rz;
        rz = (v4u){0u, 0u, 0u, 0u};
#define GLA_LOAD(n) do { _Pragma("unroll") for (int i = 0; i < 2; ++i) { const int idx = tid + 512 * i, p = idx >> 4, c8 = idx & 15; const size_t row = (size_t)gla_row((n), p, b, dir); \
            rq[i] = *(const v4u*)(Q + row * 512 + hh * 128 + 8 * c8); rk[i] = *(const v4u*)(K + row * 512 + hh * 128 + 8 * c8); rv[i] = *(const v4u*)(V + row * 1024 + hh * 256 + vh * 128 + 8 * c8); } } while (0)
#define GLA_LOADZ(n) do { if (tid < 128) { const size_t row = (size_t)gla_row((n), tid >> 1, b, dir); rz = *(const v4u*)(Z + row * 32 + dir * 16 + 8 * (tid & 1)); } } while (0)
#define GLA_ZSTORE() do { if (tid < 128) *(LAS v4u*)(Zs + (tid >> 1) * 32 + 16 * (tid & 1)) = rz; } while (0)
#define GLA_GATEB() do { const bf16x8 za = *(const LAS bf16x8*)(Zs + (32 * wi + r) * 32 + 16 * h); f32x16 gt_; \
            _Pragma("unroll") for (int e = 0; e < 16; ++e) gt_[e] = 0.f; \
            gt_ = MFMA32(za, wghi, gt_); \
            float c_[16], s_[4], t_[4]; \
            _Pragma("unroll") for (int j = 0; j < 4; ++j) { float run = 0.f; \
                _Pragma("unroll") for (int i = 0; i < 4; ++i) { const float g = gt_[4 * j + i] + bgl; \
                    const float la = (fminf(g, 0.f) - __logf(1.0f + __expf(-fabsf(g)))) * (1.0f / 16.0f); run += la; c_[4 * j + i] = run; } \
                s_[j] = run; } \
            _Pragma("unroll") for (int j = 0; j < 4; ++j) t_[j] = __int_as_float(__builtin_amdgcn_ds_bpermute((lane ^ 32) << 2, __float_as_int(s_[j]))); \
            float offj = 0.f; \
            _Pragma("unroll") for (int j = 0; j < 4; ++j) { const float o_ = offj + (h ? t_[j] : 0.f); \
                _Pragma("unroll") for (int i = 0; i < 4; ++i) Bc[(32 * wi + 8 * j + 4 * h + i) * 132 + 32 * wv + r] = c_[4 * j + i] + o_; \
                offj += s_[j] + t_[j]; } \
            if (h == 0) Seg[wi * 128 + 32 * wv + r] = offj; } while (0)
        GLA_LOAD(0); GLA_LOADZ(0);
        __syncthreads();
        GLA_ZSTORE();
        GLA_LOADZ(1);
        __syncthreads();
        GLA_GATEB();
        for (int n = 0; n < NCHUNK; ++n) {
            __syncthreads();
#pragma unroll
            for (int i = 0; i < 2; ++i) { const int idx = tid + 512 * i, p = idx >> 4, c8 = idx & 15; const int pcol = ((((p >> 3) ^ (c8 & 7)) << 4) + ((p & 7) << 1));
                const f32x4 b0 = *(const LAS f32x4*)(Bc + p * 132 + 8 * c8), b1 = *(const LAS f32x4*)(Bc + p * 132 + 8 * c8 + 4);
                const f32x4 t00 = *(const LAS f32x4*)(Seg + 8 * c8), t01 = *(const LAS f32x4*)(Seg + 8 * c8 + 4), t10 = *(const LAS f32x4*)(Seg + 128 + 8 * c8), t11 = *(const LAS f32x4*)(Seg + 128 + 8 * c8 + 4);
                float qf[8], kf[8], bc[8], dc[8];
                qf[0] = bflo(rq[i].x); qf[1] = bfhi(rq[i].x); qf[2] = bflo(rq[i].y); qf[3] = bfhi(rq[i].y); qf[4] = bflo(rq[i].z); qf[5] = bfhi(rq[i].z); qf[6] = bflo(rq[i].w); qf[7] = bfhi(rq[i].w);
                kf[0] = bflo(rk[i].x); kf[1] = bfhi(rk[i].x); kf[2] = bflo(rk[i].y); kf[3] = bfhi(rk[i].y); kf[4] = bflo(rk[i].z); kf[5] = bfhi(rk[i].z); kf[6] = bflo(rk[i].w); kf[7] = bfhi(rk[i].w);
#pragma unroll
                for (int e = 0; e < 4; ++e) { bc[e] = b0[e] + (p >= 32 ? t00[e] : 0.f); bc[4 + e] = b1[e] + (p >= 32 ? t01[e] : 0.f); dc[e] = __expf(t00[e] + t10[e]); dc[4 + e] = __expf(t01[e] + t11[e]); }
                if (p == 0) { *(LAS f32x4*)(Dec + 8 * c8) = (f32x4){dc[0], dc[1], dc[2], dc[3]}; *(LAS f32x4*)(Dec + 8 * c8 + 4) = (f32x4){dc[4], dc[5], dc[6], dc[7]}; }
                float qe[8], ke[8], kn[8];
#pragma unroll
                for (int e = 0; e < 8; ++e) { const float ex = __expf(bc[e]); const float inv = __builtin_amdgcn_rcpf(ex); qe[e] = qf[e] * ex; ke[e] = kf[e] * inv; kn[e] = ke[e] * dc[e]; }
                v4u wq, wk; wq.x = cvtpk(qe[0], qe[1]); wq.y = cvtpk(qe[2], qe[3]); wq.z = cvtpk(qe[4], qe[5]); wq.w = cvtpk(qe[6], qe[7]);
                wk.x = cvtpk(ke[0], ke[1]); wk.y = cvtpk(ke[2], ke[3]); wk.z = cvtpk(ke[4], ke[5]); wk.w = cvtpk(ke[6], ke[7]);
                *(LAS v4u*)(Qe + p * 272 + 16 * c8) = wq; *(LAS v4u*)(Ke + p * 272 + 16 * c8) = wk;
#pragma unroll
                for (int e = 0; e < 8; e += 2) { const unsigned pk = cvtpk(kn[e], kn[e + 1]);
                    *(LAS unsigned short*)(KT + (8 * c8 + e) * 144 + pcol) = (unsigned short)(pk & 0xffffu); *(LAS unsigned short*)(KT + (8 * c8 + e + 1) * 144 + pcol) = (unsigned short)(pk >> 16); }
                const unsigned vv[4] = {rv[i].x, rv[i].y, rv[i].z, rv[i].w};
#pragma unroll
                for (int e = 0; e < 4; ++e) { *(LAS unsigned short*)(VT + (8 * c8 + 2 * e) * 144 + pcol) = (unsigned short)(vv[e] & 0xffffu); *(LAS unsigned short*)(VT + (8 * c8 + 2 * e + 1) * 144 + pcol) = (unsigned short)(vv[e] >> 16); }
                asm volatile("" ::: "memory");
            }
            GLA_ZSTORE();
            if (n + 2 < NCHUNK) GLA_LOADZ(n + 2);
            if (n + 1 < NCHUNK) GLA_LOAD(n + 1);
            __syncthreads();
            if (wi == 0 && n + 1 < NCHUNK) GLA_GATEB();
            f32x16 oT;
#pragma unroll
            for (int e = 0; e < 16; ++e) oT[e] = 0.f;
            const LAS unsigned char* qrow = Qe + (32 * wi + r) * 272;
            const LAS unsigned char* vrow = VT + (32 * wv + r) * 144;
            {
                f32x16 at0;
#pragma unroll
                for (int e = 0; e < 16; ++e) at0[e] = 0.f;
#pragma unroll
                for (int hb = 0; hb < 2; ++hb) {
                    bf16x8 bq[4], ka[4];
#pragma unroll
                    for (int t = 0; t < 4; ++t) { bq[t] = *(const LAS bf16x8*)(qrow + 32 * (4 * hb + t) + 16 * h); ka[t] = *(const LAS bf16x8*)(Ke + r * 272 + 32 * (4 * hb + t) + 16 * h); }
                    asm volatile("" ::: "memory");
#pragma unroll
                    for (int t = 0; t < 4; ++t) at0 = MFMA32(ka[t], bq[t], at0);
                }
#pragma unroll
                for (int dkt = 0; dkt < 4; ++dkt) {
                    v4u qq[2];
#pragma unroll
                    for (int s2 = 0; s2 < 2; ++s2) { const v2u q0 = *(const LAS v2u*)(qrow + 64 * dkt + 32 * s2 + 8 * h), q1 = *(const LAS v2u*)(qrow + 64 * dkt + 32 * s2 + 8 * h + 16); qq[s2] = (v4u){q0.x, q0.y, q1.x, q1.y}; }
                    asm volatile("" ::: "memory");
#pragma unroll
                    for (int s2 = 0; s2 < 2; ++s2) oT = MFMA32(pack_step(S[dkt], s2), __builtin_bit_cast(bf16x8, qq[s2]), oT);
                }
                const int lim = 32 * wi + r - 4 * h;
                {
                    v4u va[2];
#pragma unroll
                    for (int t = 0; t < 2; ++t) { const v2u v0 = *(const LAS v2u*)(vrow + (((2 * t) ^ ((4 * wv + (r >> 3)) & 7)) << 4) + 8 * h), v1 = *(const LAS v2u*)(vrow + (((2 * t + 1) ^ ((4 * wv + (r >> 3)) & 7)) << 4) + 8 * h); va[t] = (v4u){v0.x, v0.y, v1.x, v1.y}; }
#pragma unroll
                    for (int e = 0; e < 16; ++e) at0[e] = (((e & 3) + 8 * (e >> 2)) > lim) ? 0.f : at0[e];
#pragma unroll
                    for (int s2 = 0; s2 < 2; ++s2) oT = MFMA32(__builtin_bit_cast(bf16x8, va[s2]), pack_step(at0, s2), oT);
                }
                if (wi) {
                    f32x16 at1;
#pragma unroll
                    for (int e = 0; e < 16; ++e) at1[e] = 0.f;
#pragma unroll
                    for (int hb = 0; hb < 2; ++hb) {
                        bf16x8 bq[4], ka[4];
#pragma unroll
                        for (int t = 0; t < 4; ++t) { bq[t] = *(const LAS bf16x8*)(qrow + 32 * (4 * hb + t) + 16 * h); ka[t] = *(const LAS bf16x8*)(Ke + (32 + r) * 272 + 32 * (4 * hb + t) + 16 * h); }
                        asm volatile("" ::: "memory");
#pragma unroll
                        for (int t = 0; t < 4; ++t) at1 = MFMA32(ka[t], bq[t], at1);
                    }
                    v4u va[2];
#pragma unroll
                    for (int t = 0; t < 2; ++t) { const v2u v0 = *(const LAS v2u*)(vrow + (((4 + 2 * t) ^ ((4 * wv + (r >> 3)) & 7)) << 4) + 8 * h), v1 = *(const LAS v2u*)(vrow + (((4 + 2 * t + 1) ^ ((4 * wv + (r >> 3)) & 7)) << 4) + 8 * h); va[t] = (v4u){v0.x, v0.y, v1.x, v1.y}; }
#pragma unroll
                    for (int e = 0; e < 16; ++e) at1[e] = ((32 + (e & 3) + 8 * (e >> 2)) > lim) ? 0.f : at1[e];
#pragma unroll
                    for (int s2 = 0; s2 < 2; ++s2) oT = MFMA32(__builtin_bit_cast(bf16x8, va[s2]), pack_step(at1, s2), oT);
                }
            }
            {
                bf16x8 vt[4];
#pragma unroll
                for (int t = 0; t < 4; ++t) vt[t] = *(const LAS bf16x8*)(vrow + (((2 * t + h) ^ ((4 * wv + (r >> 3)) & 7)) << 4));
#pragma unroll
                for (int dkt = 0; dkt < 4; ++dkt) {
                    bf16x8 kt[4]; f32x4 dd[4];
#pragma unroll
                    for (int t = 0; t < 4; ++t) { kt[t] = *(const LAS bf16x8*)(KT + (32 * dkt + r) * 144 + (((2 * t + h) ^ ((4 * dkt + (r >> 3)) & 7)) << 4)); dd[t] = *(const LAS f32x4*)(Dec + 32 * dkt + 8 * t + 4 * h); }
                    asm volatile("" ::: "memory");
#pragma unroll
                    for (int g4 = 0; g4 < 4; ++g4)
#pragma unroll
                        for (int e = 0; e < 4; ++e) S[dkt][4 * g4 + e] *= dd[g4][e];
#pragma unroll
                    for (int t = 0; t < 4; ++t) S[dkt] = MFMA32(kt[t], vt[t], S[dkt]);
                }
            }
            if (wi == 1 && n + 1 < NCHUNK) GLA_GATEB();
            { const size_t row = (size_t)gla_row(n, 32 * wi + r, b, dir); bf16* op = O + row * 1024 + hh * 256 + vh * 128 + 32 * wv + 4 * h;
#pragma unroll
              for (int g4 = 0; g4 < 4; ++g4) { v2u w2; w2.x = cvtpk(oT[4 * g4], oT[4 * g4 + 1]); w2.y = cvtpk(oT[4 * g4 + 2], oT[4 * g4 + 3]); *(v2u*)(op + 8 * g4) = w2; } }
        }
#undef GLA_LOAD
#undef GLA_LOADZ
#undef GLA_ZSTORE
#undef GLA_GATEB
    }
}

#define KA() const P __attribute__((address_space(4)))* ka_ = (const P __attribute__((address_space(4)))*)__builtin_amdgcn_kernarg_segment_ptr(); asm volatile("" : "+s"(ka_)); unsigned char* ws = ka_->ws; float* xl = ka_->out; (void)xl; (void)ws;
constexpr size_t WS_BAR = 512 * 1024;
constexpr int LDS_ST = 131072;
constexpr int LDS_XCH = 131072 + 1024;
#define XB_TMO      128
#define XB_XCNT(j)  (256  + 64 * (j))
#define XB_XSUB(j)  (1280 + 64 * (j))
#define XB_XGEN(j)  (2304 + 64 * (j))
#define XB_TOP      3328
#define XB_TOPGEN   3392
#define XCD_BAR_WORDS 3456
#define XB_SPIN_CAP (1u << 22)
__device__ __forceinline__ unsigned xb_ld(unsigned* p)              { return __hip_atomic_load(p, __ATOMIC_RELAXED, __HIP_MEMORY_SCOPE_AGENT); }
__device__ __forceinline__ unsigned xb_add(unsigned* p, unsigned v) { return __hip_atomic_fetch_add(p, v, __ATOMIC_RELAXED, __HIP_MEMORY_SCOPE_AGENT); }
__device__ __forceinline__ unsigned xb_xcc_id() { return (unsigned)__builtin_amdgcn_s_getreg((3 << 11) | 20) & 0xFu; }
#define XB_SPIN(cond, bar) do { unsigned _sp = 0; while (cond) { __builtin_amdgcn_s_sleep(1); \
    if ((++_sp & 255u) == 0u) { if (xb_ld(&(bar)[XB_TMO])) break; if (_sp > XB_SPIN_CAP) { atomicAdd(&(bar)[XB_TMO], 1u); break; } } } } while (0)
__device__ __forceinline__ void xcd_barrier_complete(unsigned* bar, unsigned x, unsigned& nloc, unsigned& nx) {
    const unsigned G = gridDim.x * gridDim.y * gridDim.z;
    unsigned sum, cnt, mine, sp = 0u;
    for (;;) {
        sum = 0u; cnt = 0u; mine = 0u;
#pragma unroll
        for (unsigned j = 0; j < 16; ++j) { const unsigned c = xb_ld(&bar[XB_XCNT(j)]); sum += c; cnt += (c > 0u) ? 1u : 0u; mine = (j == x) ? c : mine; }
        if (sum == G) break;
        __builtin_amdgcn_s_sleep(1);
        if ((++sp & 255u) == 0u) { if (xb_ld(&bar[XB_TMO])) break; if (sp > XB_SPIN_CAP) { atomicAdd(&bar[XB_TMO], 1u); break; } }
    }
    nloc = mine > 0u ? mine : 1u; nx = cnt > 0u ? cnt : 1u;
}
__device__ __forceinline__ void grid_barrier(unsigned char* wsb, LAS unsigned char* lds, const int wave_s) {
    asm volatile("s_waitcnt vmcnt(0)" ::: "memory");
    __syncthreads();
    if (wave_s == 0 && lane_id_v() == 0) {
        unsigned* bar = (unsigned*)(wsb + WS_BAR);
        volatile LAS unsigned* st = (volatile LAS unsigned*)(lds + LDS_ST);
        const unsigned x = xb_xcc_id();
        __builtin_amdgcn_s_waitcnt(0);
        unsigned nloc = st[0], nx = st[1];
        if (nloc == 0u) { xcd_barrier_complete(bar, x, nloc, nx); st[0] = nloc; st[1] = nx; }
        const unsigned old = xb_add(&bar[XB_XSUB(x)], 1u);
        const unsigned gen = old / nloc;
        if (old + 1u == (gen + 1u) * nloc) {
            __builtin_amdgcn_fence(__ATOMIC_RELEASE, "agent");
            asm volatile("s_waitcnt vmcnt(0)" ::: "memory");
            const unsigned og = xb_add(&bar[XB_TOP], 1u);
            const unsigned tg = og / nx;
            if (og + 1u == (tg + 1u) * nx) xb_add(&bar[XB_TOPGEN], 1u);
            else XB_SPIN(xb_ld(&bar[XB_TOPGEN]) == tg, bar);
            __builtin_amdgcn_fence(__ATOMIC_ACQUIRE, "agent");
            xb_add(&bar[XB_XGEN(x)], 1u);
            asm volatile("s_waitcnt vmcnt(0)" ::: "memory");
        } else {
            XB_SPIN(xb_ld(&bar[XB_XGEN(x)]) == gen, bar);
            __builtin_amdgcn_fence(__ATOMIC_ACQUIRE, "agent");
            asm volatile("s_waitcnt vmcnt(0)" ::: "memory");
        }
    }
    __syncthreads();
}
#define GSYNC() do { KA(); grid_barrier(ws, lds, wave_s); } while (0)
#define x_in (ka_->in[0])
#define c_in (ka_->in[1])
#define ctx_in (ka_->in[2])
#define cctx_in (ka_->in[3])
#define w_mod (ka_->in[4])
#define b_mod (ka_->in[5])
#define w_in (ka_->in[6])
#define w_gate_f (ka_->in[7])
#define b_gate_f (ka_->in[8])
#define w_gate_b (ka_->in[9])
#define b_gate_b (ka_->in[10])
#define gla_norm_w (ka_->in[11])
#define w_pool (ka_->in[12])
#define pool_scale (ka_->in[13])
#define w_br_pool (ka_->in[14])
#define w_br_gla (ka_->in[15])
#define w_out (ka_->in[16])
#define ln1_w (ka_->in[17])
#define ln1_b (ka_->in[18])
#define w_up (ka_->in[19])
#define conv_w (ka_->in[20])
#define conv_b (ka_->in[21])
#define w_down (ka_->in[22])
#define ln2_w (ka_->in[23])
#define ln2_b (ka_->in[24])
#define POS ((float*)(ws + WS_POS))
#define MOD ((float*)(ws + WS_MOD))
#define W1T ((bf16*)(ws + WS_W1T))
#define W2T ((bf16*)(ws + WS_W2T))
#define WPT ((bf16*)(ws + WS_WPT))
#define WGT ((bf16*)(ws + WS_WGT))
#define WOT ((bf16*)(ws + WS_WOT))
#define WUT ((bf16*)(ws + WS_WUT))
#define WDT ((bf16*)(ws + WS_WDT))
#define xc ((float*)(ws + WS_XC))
#define UX ((bf16*)(ws + WS_UX))
#define Qb ((bf16*)(ws + WS_R + R_Q))
#define Kb ((bf16*)(ws + WS_R + R_K))
#define Vb ((bf16*)(ws + WS_R + R_V))
#define OFb ((bf16*)(ws + WS_R + R_OF))
#define OBb ((bf16*)(ws + WS_R + R_OB))
#define Zb ((bf16*)(ws + WS_R + R_Z))
#define POOLb ((bf16*)(ws + WS_R + R_POOL))
#define GPb ((bf16*)(ws + WS_R + R_GP))
#define GGb ((bf16*)(ws + WS_R + R_GG))
#define POOLEDb ((bf16*)(ws + WS_R + R_POOLED))
#define HIDb ((bf16*)(ws + WS_R + R_HID))
#define STATS ((float*)(ws + WS_STATS))
#define FRESH() KA(); const int lane = lane_id_v(), wave = wave_s, tid = wave * 64 + lane, gw = blockIdx.x * 8 + wave, gt = blockIdx.x * NTHREADS + tid; (void)lane; (void)gw; (void)gt; (void)wave;
template <int l> __device__ __forceinline__ void layer_body(LAS unsigned char* lds, const int wave_s) {
    const int G = gridDim.x, NGW = G * 8, NGT = G * NTHREADS; (void)NGW; (void)NGT;
        const bool last = (l == DEPTH - 1);
        const int nMall = TT / 256, nMpost = last ? TL / 256 : TT / 256, rows_post = nMpost * 256;
        { KA(); EpiA1 E{Qb, Kb, Vb, Zb}; run_gemm(lds, UX, W1T + (size_t)l * N1 * 1024, nMall, N1, 1024, E, wave_s); }
        GSYNC();
        { KA(); gla_phase(lds, Qb, Kb, Vb, Zb, OFb, OBb, w_gate_f + (size_t)l * 16 * 512, b_gate_f + l * 512, w_gate_b + (size_t)l * 16 * 512, b_gate_b + l * 512, wave_s); }
        GSYNC();
        { KA(); EpiA2 E{POOLb, OFb, GPb, GGb, OBb, gla_norm_w + l * 1024, (LAS float*)(lds + LDS_XCH)}; run_gemm<EpiA2, true>(lds, UX, W2T + (size_t)l * N2 * 1024, nMpost, N2, 1024, E, wave_s); }
        GSYNC();
        { FRESH();
        for (int row = gw; row < rows_post; row += NGW) {
            int pos, Ls; if (row < TL) { pos = row & 63; Ls = 64; } else { pos = (row - TL) & 255; Ls = 256; }
            const int hw = 1 << (lane >> 4);
            const int lo = max(pos - hw, 0), hi = min(pos + hw, Ls);
            const bf16* base = POOLb + (size_t)(row - pos) * 512 + 8 * lane;
            float s[8];
#pragma unroll
            for (int e = 0; e < 8; ++e) s[e] = 0.f;
            v4u av[16];
#pragma unroll
            for (int k = 0; k < 16; ++k) { const int p = lo + k; const int pc = p < hi ? p : pos; av[k] = *(const v4u*)(base + (size_t)pc * 512); }
#pragma unroll
            for (int k = 0; k < 16; ++k) { const float vm = (lo + k < hi) ? 1.f : 0.f; const v4u a = av[k];
                s[0] += vm * bflo(a.x); s[1] += vm * bfhi(a.x); s[2] += vm * bflo(a.y); s[3] += vm * bfhi(a.y); s[4] += vm * bflo(a.z); s[5] += vm * bfhi(a.z); s[6] += vm * bflo(a.w); s[7] += vm * bfhi(a.w); }
            const v4u me = *(const v4u*)(base + (size_t)pos * 512); const float inv = 1.0f / (float)(hi - lo);
            v4u w; w.x = cvtpk(s[0] * inv - bflo(me.x), s[1] * inv - bfhi(me.x)); w.y = cvtpk(s[2] * inv - bflo(me.y), s[3] * inv - bfhi(me.y));
            w.z = cvtpk(s[4] * inv - bflo(me.z), s[5] * inv - bfhi(me.z)); w.w = cvtpk(s[6] * inv - bflo(me.w), s[7] * inv - bfhi(me.w));
            *(v4u*)(POOLEDb + (size_t)row * 512 + 8 * lane) = w;
        } }
        GSYNC();
        { KA(); EpiMul E{GPb}; run_gemm(lds, POOLEDb, WPT + (size_t)l * 1024 * 512, nMpost, 1024, 512, E, wave_s); }
        GSYNC();
        { KA(); EpiMulAdd E{GGb, GPb}; run_gemm(lds, OFb, WGT + (size_t)l * 1024 * 1024, nMpost, 1024, 1024, E, wave_s); }
        GSYNC();
        { KA(); EpiRes E{xl, xc, MOD + (size_t)l * 17 * 6144 + 2048, 0, STATS, l > 0 ? ln2_w + (l - 1) * 1024 : (const float*)nullptr, l > 0 ? ln2_b + (l - 1) * 1024 : (const float*)nullptr}; run_gemm(lds, GGb, WOT + (size_t)l * 1024 * 1024, nMpost, 1024, 1024, E, wave_s); }
        GSYNC();
        { FRESH(); ln_phase(lane, gw, NGW, rows_post, xl, xc, ln1_w + l * 1024, ln1_b + l * 1024, MOD + (size_t)l * 17 * 6144, 3072, 4096, UX, nullptr, nullptr, nullptr, STATS, false); }
        GSYNC();
        { KA(); EpiUpConv E{HIDb, conv_w + (size_t)l * 3 * FF, conv_b + (size_t)l * FF, (LAS float*)(lds + LDS_XCH)}; run_gemm<EpiUpConv, true>(lds, UX, WUT + (size_t)l * NU * 1024, nMpost, NU, 1024, E, wave_s); }
        GSYNC();
        { KA(); EpiRes E{xl, xc, MOD + (size_t)l * 17 * 6144 + 5120, 0, STATS, ln1_w + l * 1024, ln1_b + l * 1024}; run_gemm(lds, HIDb, WDT + (size_t)l * 1024 * FF, nMpost, 1024, FF, E, wave_s); }
        GSYNC();
        { FRESH(); ln_phase(lane, gw, NGW, rows_post, xl, xc, ln2_w + l * 1024, ln2_b + l * 1024, MOD + (size_t)(last ? l : l + 1) * 17 * 6144, 0, 1024, last ? (bf16*)nullptr : UX, nullptr, nullptr, nullptr, STATS, last); }
        if (!last) GSYNC();
}

__global__ void __launch_bounds__(NTHREADS, 2) fwd_mega(P prm) {
    extern __shared__ __attribute__((aligned(16))) unsigned char lds_raw[];
    LAS unsigned char* lds = (LAS unsigned char*)lds_raw;
    cg::grid_group grid = cg::this_grid();
    const int G = gridDim.x, NGW = G * 8, NGT = G * NTHREADS;
    const int wave_s = __builtin_amdgcn_readfirstlane(threadIdx.x >> 6);
    if (threadIdx.x < 64) ((LAS unsigned*)(lds + LDS_ST))[threadIdx.x] = 0u;
    __syncthreads();
    if (threadIdx.x == 0) (void)xb_add((unsigned*)(prm.ws + WS_BAR) + XB_XCNT(xb_xcc_id()), 1u);
    {
        FRESH();
        LAS float* sc = (LAS float*)lds;
        LAS float* part = (LAS float*)(lds + 69632);
        for (int i = tid; i < 17 * 1024; i += NTHREADS) { const float v = i < 16 * 1024 ? c_in[i] : cctx_in[i - 16 * 1024]; sc[i] = v * sigmoidf_(v); }
        __syncthreads();
        for (int it = blockIdx.x; it < 4 * 96; it += G) {
            const int l = it / 96, j0 = (it % 96) * 64, jl = tid & 63, kp = tid >> 6;
            float acc[17];
#pragma unroll
            for (int bi = 0; bi < 17; ++bi) acc[bi] = 0.f;
            const float* wp = w_mod + (size_t)l * 1024 * 6144 + (size_t)(kp * 128) * 6144 + j0 + jl;
            for (int k0 = 0; k0 < 128; k0 += 16) { float wv_[16];
#pragma unroll
                for (int k = 0; k < 16; ++k) wv_[k] = wp[(size_t)(k0 + k) * 6144];
#pragma unroll
                for (int k = 0; k < 16; ++k) { const int kk = kp * 128 + k0 + k;
#pragma unroll
                    for (int bi = 0; bi < 17; ++bi) acc[bi] += sc[bi * 1024 + kk] * wv_[k]; } }
#pragma unroll
            for (int bi = 0; bi < 17; ++bi) part[(kp * 17 + bi) * 64 + jl] = acc[bi];
            __syncthreads();
            for (int o = tid; o < 17 * 64; o += NTHREADS) { const int bi = o >> 6, j = o & 63; float s = b_mod[l * 6144 + j0 + j];
#pragma unroll
                for (int q = 0; q < 8; ++q) s += part[(q * 17 + bi) * 64 + j];
                MOD[((size_t)l * 17 + bi) * 6144 + j0 + j] = s; }
            __syncthreads();
        }
        for (int i = gt; i < 64 * 512; i += NGT) { const int p = i >> 9, q = i & 511, fi = q & 255;
            const double om = exp(-9.210340371976184 * (double)fi / 256.0); double rev = (double)p * om * 0.15915494309189535; rev -= floor(rev);
            POS[i] = (q < 256) ? __builtin_amdgcn_sinf((float)rev) : __builtin_amdgcn_cosf((float)rev); }
        for (int i = gt; i < 4 * 64 * 1024; i += NGT) { const int n = i & 1023, kg = (i >> 10) & 63, l = i >> 16, g = kg >> 4, c0 = (kg & 15) * 8;
            float acc[8];
#pragma unroll
            for (int e = 0; e < 8; ++e) acc[e] = 0.f;
            const float* wpl = w_pool + ((size_t)(l * 4 + g) * 128 + c0) * 128; const float* ps = pool_scale + l * 512 + g * 128; const float* wb = w_br_pool + ((size_t)l * 512 + g * 128) * 1024 + n;
            for (int d0 = 0; d0 < 128; d0 += 16) { float t[16];
#pragma unroll
                for (int d = 0; d < 16; ++d) t[d] = wb[(size_t)(d0 + d) * 1024];
#pragma unroll
                for (int d = 0; d < 16; ++d) { const float tt = t[d] * ps[d0 + d];
#pragma unroll
                    for (int e = 0; e < 8; ++e) acc[e] += wpl[e * 128 + d0 + d] * tt; } }
            v4u o; o.x = cvtpk(acc[0], acc[1]); o.y = cvtpk(acc[2], acc[3]); o.z = cvtpk(acc[4], acc[5]); o.w = cvtpk(acc[6], acc[7]);
            *(v4u*)(WPT + ((size_t)l * 1024 + n) * 512 + g * 128 + c0) = o; }
        LAS float* scr = (LAS float*)(lds + wave * 16384);
        for (int it = gw; it < 4 * 8192; it += NGW) {
            const int l = it >> 13; int rr = it & 8191;
            if (rr < 1152) { const int kb = rr / 72, nb = rr % 72, d0 = nb * 32; const int s0 = d0 < 2048 ? 512 + d0 : (d0 < 2080 ? 3584 + (d0 - 2048) : -1);
                transpose_block(w_in + (size_t)l * 1024 * NIN, NIN, s0, kb * 64, W1T + (size_t)l * N1 * 1024, 1024, d0, scr, lane); continue; } rr -= 1152;
            if (rr < 1792) { const int kb = rr / 112, nb = rr % 112, d0 = nb * 32; const int s0 = d0 < 512 ? d0 : (d0 < 1536 ? 2560 + (d0 - 512) : 3616 + (d0 - 1536));
                transpose_block(w_in + (size_t)l * 1024 * NIN, NIN, s0, kb * 64, W2T + (size_t)l * N2 * 1024, 1024, d0, scr, lane); continue; } rr -= 1792;
            if (rr < 512) { const int kb = rr / 32, nb = rr % 32; transpose_block(w_br_gla + (size_t)l * 1024 * 1024, 1024, nb * 32, kb * 64, WGT + (size_t)l * 1024 * 1024, 1024, nb * 32, scr, lane); continue; } rr -= 512;
            if (rr < 512) { const int kb = rr / 32, nb = rr % 32; transpose_block(w_out + (size_t)l * 1024 * 1024, 1024, nb * 32, kb * 64, WOT + (size_t)l * 1024 * 1024, 1024, nb * 32, scr, lane); continue; } rr -= 512;
            if (rr < 2816) { const int kb = rr / 176, nb = rr % 176, d0 = nb * 32, pn = d0 >> 8, wq = d0 & 255; const int s0 = wq < 128 ? 128 * pn + wq : FF + 128 * pn + (wq - 128);
                transpose_block(w_up + (size_t)l * 1024 * NU, NU, s0, kb * 64, WUT + (size_t)l * NU * 1024, 1024, d0, scr, lane); continue; } rr -= 2816;
            { const int kb = rr / 32, nb = rr % 32; transpose_block(w_down + (size_t)l * FF * 1024, 1024, nb * 32, kb * 64, WDT + (size_t)l * 1024 * FF, FF, nb * 32, scr, lane); }
        }
    }
    grid.sync();
    { FRESH(); ln_phase(lane, gw, NGW, TT, xl, xc, nullptr, nullptr, MOD, 0, 1024, UX, x_in, ctx_in, POS, STATS, false); }
    GSYNC();

    layer_body<0>(lds, wave_s); layer_body<1>(lds, wave_s); layer_body<2>(lds, wave_s); layer_body<3>(lds, wave_s);
}

extern "C" void kernel_launch(void* const* d_in, const int* in_sizes, int n_in, void* d_out, int out_size, void* d_ws, size_t ws_size, hipStream_t stream) {
    static int grid = 0;
    if (grid == 0) {
        if (n_in != 25 || out_size != TL * DM || ws_size < WS_END) { fprintf(stderr, "kernel_launch: unexpected shapes (n_in %d out %d ws %zu need %zu)\n", n_in, out_size, ws_size, (size_t)WS_END); grid = -1; return; }
        int dev = 0, cus = 0, per_cu = 0;
        if (hipGetDevice(&dev) != hipSuccess || hipDeviceGetAttribute(&cus, hipDeviceAttributeMultiprocessorCount, dev) != hipSuccess) { grid = -1; return; }
        if (hipFuncSetAttribute((const void*)fwd_mega, hipFuncAttributeMaxDynamicSharedMemorySize, LDS_BYTES) != hipSuccess) { fprintf(stderr, "hipFuncSetAttribute failed\n"); grid = -1; return; }
        if (hipOccupancyMaxActiveBlocksPerMultiprocessor(&per_cu, (const void*)fwd_mega, NTHREADS, LDS_BYTES) != hipSuccess || per_cu < 1) { fprintf(stderr, "occupancy query: %d\n", per_cu); per_cu = 1; }
        (void)hipGetLastError();
        grid = cus;
    }
    if (grid < 0) return;
    if (hipMemsetAsync((char*)d_ws + WS_BAR, 0, 16384, stream) != hipSuccess) { fprintf(stderr, "memset failed\n"); return; }
    P prm{};
    for (int i = 0; i < 25; ++i) prm.in[i] = (const float*)d_in[i];
    prm.out = (float*)d_out; prm.ws = (unsigned char*)d_ws;
    void* args[] = {&prm};
    hipError_t e = hipLaunchCooperativeKernel((const void*)fwd_mega, dim3(grid), dim3(NTHREADS), args, LDS_BYTES, stream);
    if (e != hipSuccess) fprintf(stderr, "cooperative launch failed: %s\n", hipGetErrorString(e));
}
```

```cpp
#include <hip/hip_runtime.h>
#include <hip/hip_cooperative_groups.h>
#include <cstdio>
#include <cstdint>
namespace cg = cooperative_groups;
namespace pg8 {
#define PG8_LAS __attribute__((address_space(3)))
typedef unsigned short bf16_t;
typedef short bf16x8 __attribute__((ext_vector_type(8)));
typedef float f32x4 __attribute__((ext_vector_type(4)));
typedef unsigned u32x4 __attribute__((ext_vector_type(4)));
constexpr int BM = 256, BK = 64, HALF = 128, HTB = HALF * BK * 2  , STAGE_BYTES = 8 * HTB, NXCD = 8, WGM = 4;

__host__ __device__ __forceinline__ int lds_byte(int r, int c) { const int st = (r >> 4) * 2 + (c >> 5), rr = r & 15, cc = c & 31, ob = rr * 64 + cc * 2; return st * 1024 + (ob ^ (((ob >> 9) & 1) << 5)); }
__host__ __device__ __forceinline__ void stage_rc(int b, int& R, int& C) { const int st = b / 1024, sb = b % 1024, swz = sb ^ (((sb >> 9) & 1) << 5); R = (st >> 1) * 16 + swz / 64; C = (st & 1) * 32 + (swz % 64) / 2; }
__host__ __device__ __forceinline__ int perm32(int rho) { const int n = rho >> 4, i = rho & 15; return 8 * (i >> 2) + 4 * n + (i & 3); }

struct Unit { int pm, pn; };
struct Gemm { const bf16_t* A; const bf16_t* Bt; int M, N, K; };

struct StaticOrder {
    int nM, nN, nwg, G, c;
    __host__ __device__ void init(int M, int N, int G_, int c_) { nM = M / BM; nN = N / BM; nwg = nM * nN; G = G_; c = c_; }
    __host__ __device__ bool next(int i, Unit& u) const {
        const long L = (long)i * G + c; if (L >= nwg) return false;
        int wgid = (int)L; { const int q = nwg / NXCD, r = nwg % NXCD, xcd = wgid % NXCD, off = wgid / NXCD; wgid = (xcd < r ? xcd * (q + 1) : r * (q + 1) + (xcd - r) * q) + off; }
        const int nig = WGM * nN, gid = wgid / nig, fm = gid * WGM, gsz = (nM - fm) < WGM ? (nM - fm) : WGM;
        u.pm = fm + ((wgid % nig) % gsz); u.pn = (wgid % nig) / gsz; return true;
    }
    __device__ __forceinline__ void a_ready(const Unit&) const {}
    __device__ __forceinline__ void done(const Unit&) const {}
};

template <class Epi, class Sched, bool ALIGN_EPI = false, bool SP2 = false>
__device__ __forceinline__ void gemm_phase(PG8_LAS unsigned char* lds, const Gemm g, const Sched& S, const Epi& E, const int wave_s) {
    int lane_; asm volatile("v_mbcnt_lo_u32_b32 %0, -1, 0\n\tv_mbcnt_hi_u32_b32 %0, -1, %0" : "=v"(lane_)); const int lane = lane_, wid = wave_s, tid = wid * 64 + lane, wr = wid >> 2, wc = wid & 3, fr = lane & 15, fq = lane >> 4;
    const int K = g.K, nt = K / BK;
    unsigned voffA[2], voffB[2];
#pragma unroll
    for (int i = 0; i < 2; ++i) { int R, C; stage_rc(tid * 16 + i * 8192, R, C); const int Rb = Epi::PERM ? ((R & ~31) + perm32(R & 31)) : R;
        voffA[i] = (unsigned)(R * K + C) * 2u; voffB[i] = (unsigned)(Rb * K + C) * 2u; }
    const size_t kstep = (size_t)(BK * 2);
    const size_t hstep = (size_t)HALF * K * 2;
    const size_t tstep = 2 * hstep;
    const unsigned ldsw = (unsigned)wid * 1024u;
    const int aoff = lds_byte(wr * 64 + fr, fq * 8), boff = lds_byte(wc * 32 + fr, fq * 8);
#define PG8_SA(b, h) (((b) * 2 + (h)) * HTB)
#define PG8_SB(b, h) ((4 + (b) * 2 + (h)) * HTB)
#define PG8_STAGE(bufoff, gbase, voff) do { _Pragma("unroll") for (int _i = 0; _i < 2; ++_i) \
        __builtin_amdgcn_global_load_lds((const unsigned*)((const char*)(gbase) + (voff)[_i]), (PG8_LAS unsigned*)(lds + (bufoff) + ldsw + _i * 8192), 16, 0, 0); } while (0)
#define PG8_LDA(dst, b, h) do { _Pragma("unroll") for (int m = 0; m < 4; ++m) _Pragma("unroll") for (int k = 0; k < 2; ++k) dst[m][k] = *(const PG8_LAS bf16x8*)(lds + PG8_SA(b, h) + aoff + m * 2048 + k * 1024); } while (0)
#define PG8_LDB(dst, b, h) do { _Pragma("unroll") for (int n = 0; n < 2; ++n) _Pragma("unroll") for (int k = 0; k < 2; ++k) dst[n][k] = *(const PG8_LAS bf16x8*)(lds + PG8_SB(b, h) + boff + n * 2048 + k * 1024); } while (0)
#define PG8_MMA(ai, bj, At, Bt) do { __builtin_amdgcn_s_setprio(1); _Pragma("unroll") for (int m = 0; m < 4; ++m) _Pragma("unroll") for (int n = 0; n < 2; ++n) _Pragma("unroll") for (int k = 0; k < 2; ++k) \
        acc[ai][bj][m][n] = __builtin_amdgcn_mfma_f32_16x16x32_bf16(Bt[n][k], At[m][k], acc[ai][bj][m][n], 0, 0, 0); __builtin_amdgcn_s_setprio(0); } while (0)
#define PG8_WAIT_V(n) asm volatile("s_waitcnt vmcnt(" #n ")" ::: "memory")
#define PG8_WAIT_L(n) asm volatile("s_waitcnt lgkmcnt(" #n ")" ::: "memory")
#define PG8_BAR __builtin_amdgcn_s_barrier()
#define PG8_SCHED __builtin_amdgcn_sched_barrier(0)
    Unit cur, nxt; int ui = 0;
    if (!S.next(0, cur)) return;
    f32x4 acc[2][2][4][2];
#pragma unroll
    for (int a = 0; a < 2; ++a)
#pragma unroll
        for (int b = 0; b < 2; ++b)
#pragma unroll
            for (int m = 0; m < 4; ++m)
#pragma unroll
                for (int n = 0; n < 2; ++n) acc[a][b][m][n] = (f32x4){0.f, 0.f, 0.f, 0.f};
    bf16x8 At[4][2], B0[2][2], B1[2][2];
    const char* cA = (const char*)g.A + (size_t)cur.pm * tstep; const char* cB = (const char*)g.Bt + (size_t)cur.pn * tstep;
    S.a_ready(cur);
    if constexpr (SP2) {
        PG8_STAGE(PG8_SB(0, 0), cB, voffB); PG8_STAGE(PG8_SB(0, 1), cB + hstep, voffB); PG8_STAGE(PG8_SA(0, 0), cA, voffA); PG8_STAGE(PG8_SA(0, 1), cA + hstep, voffA);
        if (wr == 1) PG8_BAR;
        PG8_WAIT_V(2); PG8_BAR;
        PG8_STAGE(PG8_SB(1, 0), cB + kstep, voffB); PG8_STAGE(PG8_SA(1, 0), cA + kstep, voffA); PG8_STAGE(PG8_SB(1, 1), cB + hstep + kstep, voffB);
        PG8_WAIT_V(6); PG8_BAR;
    } else {
        PG8_STAGE(PG8_SB(0, 0), cB, voffB); PG8_STAGE(PG8_SA(0, 0), cA, voffA); PG8_STAGE(PG8_SB(0, 1), cB + hstep, voffB); PG8_STAGE(PG8_SA(0, 1), cA + hstep, voffA);
        if (wr == 1) PG8_BAR;
        PG8_WAIT_V(4); PG8_BAR;
        PG8_STAGE(PG8_SB(1, 0), cB + kstep, voffB); PG8_STAGE(PG8_SA(1, 0), cA + kstep, voffA); PG8_STAGE(PG8_SB(1, 1), cB + hstep + kstep, voffB);
        PG8_WAIT_V(6); PG8_BAR;
    }
    for (;;) {
        const bool has_next = S.next(ui + 1, nxt);
        const char* nA = has_next ? (const char*)g.A + (size_t)nxt.pm * tstep : cA; const char* nB = has_next ? (const char*)g.Bt + (size_t)nxt.pn * tstep : cB;
        for (int t = 0; t < nt; t += 2) {
            const bool last = (t == nt - 2);
            const char* a1 = cA + (size_t)(t + 1) * kstep;
            const char* a2 = last ? nA : cA + (size_t)(t + 2) * kstep; const char* b2 = last ? nB : cB + (size_t)(t + 2) * kstep;
            const char* a3 = a2 + kstep; const char* b3 = b2 + kstep;
            if (last && has_next) S.a_ready(nxt);
            if constexpr (SP2) {
            PG8_LDB(B0, 0, 0); PG8_LDB(B1, 0, 1); PG8_SCHED; PG8_LDA(At, 0, 0); PG8_STAGE(PG8_SA(1, 1), a1 + hstep, voffA);
            PG8_WAIT_V(8); PG8_WAIT_L(0); PG8_BAR; PG8_MMA(0, 0, At, B0); PG8_MMA(0, 1, At, B1); PG8_BAR; PG8_SCHED;
            PG8_LDA(At, 0, 1); PG8_STAGE(PG8_SB(0, 0), b2, voffB); PG8_STAGE(PG8_SB(0, 1), b2 + hstep, voffB); PG8_STAGE(PG8_SA(0, 0), a2, voffA);
            PG8_WAIT_V(8); PG8_WAIT_L(0); PG8_BAR; PG8_MMA(1, 0, At, B0); PG8_MMA(1, 1, At, B1); PG8_BAR; PG8_SCHED;
            PG8_LDB(B0, 1, 0); PG8_LDB(B1, 1, 1); PG8_SCHED; PG8_LDA(At, 1, 0); PG8_STAGE(PG8_SA(0, 1), a2 + hstep, voffA);
            PG8_WAIT_V(8); PG8_WAIT_L(0); PG8_BAR; PG8_MMA(0, 0, At, B0); PG8_MMA(0, 1, At, B1); PG8_BAR; PG8_SCHED;
            PG8_LDA(At, 1, 1); PG8_STAGE(PG8_SB(1, 0), b3, voffB); PG8_STAGE(PG8_SB(1, 1), b3 + hstep, voffB); PG8_STAGE(PG8_SA(1, 0), a3, voffA);
            PG8_WAIT_V(8); PG8_WAIT_L(0); PG8_BAR; PG8_MMA(1, 0, At, B0); PG8_MMA(1, 1, At, B1); PG8_BAR; PG8_SCHED;
            } else {
            PG8_LDB(B0, 0, 0); PG8_SCHED; PG8_LDA(At, 0, 0); PG8_STAGE(PG8_SA(1, 1), a1 + hstep, voffA);
            PG8_WAIT_L(8); PG8_BAR; PG8_WAIT_L(0); PG8_MMA(0, 0, At, B0); PG8_BAR; PG8_SCHED;
            PG8_LDB(B1, 0, 1); PG8_STAGE(PG8_SB(0, 0), b2, voffB);
            PG8_BAR; PG8_WAIT_L(0); PG8_MMA(0, 1, At, B1); PG8_BAR;
            PG8_LDA(At, 0, 1); PG8_STAGE(PG8_SA(0, 0), a2, voffA);
            PG8_BAR; PG8_WAIT_L(0); PG8_MMA(1, 0, At, B0); PG8_BAR; PG8_SCHED;
            PG8_STAGE(PG8_SB(0, 1), b2 + hstep, voffB);
            PG8_WAIT_V(6); PG8_BAR; PG8_MMA(1, 1, At, B1); PG8_BAR;
            PG8_LDB(B0, 1, 0); PG8_SCHED; PG8_LDA(At, 1, 0); PG8_STAGE(PG8_SA(0, 1), a2 + hstep, voffA);
            PG8_WAIT_L(8); PG8_BAR; PG8_WAIT_L(0); PG8_MMA(0, 0, At, B0); PG8_BAR; PG8_SCHED;
            PG8_LDB(B1, 1, 1); PG8_STAGE(PG8_SB(1, 0), b3, voffB);
            PG8_BAR; PG8_WAIT_L(0); PG8_MMA(0, 1, At, B1); PG8_BAR;
            PG8_LDA(At, 1, 1); PG8_STAGE(PG8_SA(1, 0), a3, voffA);
            PG8_BAR; PG8_WAIT_L(0); PG8_MMA(1, 0, At, B0); PG8_BAR; PG8_SCHED;
            PG8_STAGE(PG8_SB(1, 1), b3 + hstep, voffB);
            PG8_WAIT_V(6); PG8_BAR; PG8_MMA(1, 1, At, B1); PG8_BAR;
            }
        }
        if constexpr (ALIGN_EPI) { if (wr == 0) PG8_BAR; }
        if constexpr (!Epi::AFTER_DRAIN) { E(acc, cur, wr, wc, fr, fq); S.done(cur); }
        if (!has_next) break;
#pragma unroll
        for (int a = 0; a < 2; ++a)
#pragma unroll
            for (int b = 0; b < 2; ++b)
#pragma unroll
                for (int m = 0; m < 4; ++m)
#pragma unroll
                    for (int n = 0; n < 2; ++n) acc[a][b][m][n] = (f32x4){0.f, 0.f, 0.f, 0.f};
        cur = nxt; cA = nA; cB = nB; ++ui;
        if constexpr (ALIGN_EPI) { if (wr == 1) PG8_BAR; }
    }
    PG8_WAIT_V(0);
    if constexpr (!ALIGN_EPI) { if (wr == 0) PG8_BAR; }
    PG8_BAR;
    if constexpr (Epi::AFTER_DRAIN) { E.fused(acc, cur, wr, wc, fr, fq, lds, wid, lane); S.done(cur); }
#undef PG8_SA
#undef PG8_SB
#undef PG8_STAGE
#undef PG8_LDA
#undef PG8_LDB
#undef PG8_MMA
#undef PG8_WAIT_V
#undef PG8_WAIT_L
#undef PG8_BAR
#undef PG8_SCHED
}
}

#define GAS __attribute__((address_space(1)))
#define LAS __attribute__((address_space(3)))
typedef unsigned short bf16;
typedef unsigned v4u __attribute__((ext_vector_type(4)));
typedef unsigned v2u __attribute__((ext_vector_type(2)));
typedef float f32x4 __attribute__((ext_vector_type(4)));
typedef float f32x2 __attribute__((ext_vector_type(2)));
typedef float f32x16 __attribute__((ext_vector_type(16)));
typedef short bf16x8 __attribute__((ext_vector_type(8)));
typedef short s16x4 __attribute__((ext_vector_type(4)));
typedef __bf16 bf16x2_t __attribute__((ext_vector_type(2)));

constexpr int NB = 16, LSEQ = 4096, DM = 1024, DEPTH = 4, CTXL = 256;
constexpr int TL = NB * LSEQ, TC = NB * CTXL, TT = TL + TC;
constexpr int NIN = 5664, FF = 2816, N1 = 2304, N2 = 3584, NU = 5632;
constexpr float LN_EPS = 1e-6f;
constexpr float ALPHA = 1.681792830507429f;
constexpr size_t MiB = (size_t)1 << 20;
constexpr size_t WS_POS = 0, WS_MOD = 1 * MiB, WS_W1T = 3 * MiB, WS_W2T = 21 * MiB, WS_WPT = 49 * MiB, WS_WGT = 53 * MiB, WS_WOT = 61 * MiB,
                 WS_WUT = 69 * MiB, WS_WDT = 113 * MiB, WS_XC = 135 * MiB, WS_UX = 151 * MiB, WS_R = 287 * MiB;
constexpr size_t SU = 68 * MiB;
static_assert((size_t)TT * 512 * 2 == SU, "SU");
constexpr size_t R_Q = 0, R_K = SU, R_V = 2 * SU, R_OF = 4 * SU, R_OB = 6 * SU, R_Z = 8 * SU;
constexpr size_t R_POOL = 0, R_GP = SU, R_GG = 578 * MiB, R_POOLED = 3 * SU;
constexpr size_t R_HID = 0;
constexpr size_t WS_STATS = WS_R + 561 * MiB;
constexpr size_t WS_END = WS_R + 716 * MiB;
static_assert(R_GG >= 8 * SU + 5 * MiB && WS_STATS + MiB <= WS_R + R_GG && R_GG + 2 * SU <= 716 * MiB, "R map");
constexpr int LDS_BYTES = 147456;
constexpr int NTHREADS = 512;

__device__ __forceinline__ unsigned cvtpk(float lo, float hi) { f32x2 v = {lo, hi}; bf16x2_t b = __builtin_convertvector(v, bf16x2_t); return __builtin_bit_cast(unsigned, b); }
__device__ __forceinline__ float bflo(unsigned u) { return __uint_as_float(u << 16); }
__device__ __forceinline__ float bfhi(unsigned u) { return __uint_as_float(u & 0xffff0000u); }
__device__ __forceinline__ float sigmoidf_(float x) { return __builtin_amdgcn_rcpf(1.0f + __expf(-x)); }
__device__ __forceinline__ int lane_id_v() { int l; asm volatile("v_mbcnt_lo_u32_b32 %0, -1, 0\n\tv_mbcnt_hi_u32_b32 %0, -1, %0" : "=v"(l)); return l; }
__device__ __forceinline__ float wave_sum(float v, int lane) {
#pragma unroll
    for (int o = 1; o < 64; o <<= 1) v += __int_as_float(__builtin_amdgcn_ds_bpermute((lane ^ o) << 2, __float_as_int(v)));
    return v;
}
__device__ __forceinline__ float half_sum(float v, int lane) {
#pragma unroll
    for (int o = 1; o < 32; o <<= 1) v += __int_as_float(__builtin_amdgcn_ds_bpermute((lane ^ o) << 2, __float_as_int(v)));
    return v;
}

struct RangeOrder {
    int nM, nN, nwg, G, c;
    __device__ void init(int nM_, int nN_, int G_, int c_) { nM = nM_; nN = nN_; nwg = nM * nN; G = G_; c = c_; }
    __device__ bool next(int i, pg8::Unit& u) const {
        const long L = (long)i * G + c; if (L >= nwg) return false;
        int wgid = (int)L; { const int q = nwg / pg8::NXCD, r = nwg % pg8::NXCD, xcd = wgid % pg8::NXCD, off = wgid / pg8::NXCD; wgid = (xcd < r ? xcd * (q + 1) : r * (q + 1) + (xcd - r) * q) + off; }
        const int nig = pg8::WGM * nN, gid = wgid / nig, fm = gid * pg8::WGM, gsz = (nM - fm) < pg8::WGM ? (nM - fm) : pg8::WGM;
        u.pm = fm + ((wgid % nig) % gsz); u.pn = (wgid % nig) / gsz; return true;
    }
    __device__ __forceinline__ void a_ready(const pg8::Unit&) const {}
    __device__ __forceinline__ void done(const pg8::Unit&) const {}
};

typedef pg8::f32x4 af4;
#define EPI_LOOP for (int ai = 0; ai < 2; ++ai) _Pragma("unroll") for (int m = 0; m < 4; ++m) _Pragma("unroll") for (int bj = 0; bj < 2; ++bj)
#define EPI_RR(base_) int RR = (base_) + ai * 128 + m * 16; asm volatile("" : "+v"(RR));

struct EpiA1 {
    static constexpr bool PERM = true, AFTER_DRAIN = false;
    bf16 *Q, *K, *V, *Z;
    __device__ __forceinline__ void operator()(const af4 (&acc)[2][2][4][2], const pg8::Unit& u, int wr, int wc, int fr_, int fq_) const {
        const int ln_ = lane_id_v(); const int fr = ln_ & 15, fq = ln_ >> 4;
        const int row0 = u.pm * 256 + wr * 64 + fr, pn = u.pn;
        if (pn < 8) {
            bf16* base; int ldc, colt; float sc = 1.f;
            if (pn < 2) { base = Q; ldc = 512; colt = pn * 256; sc = 0.08838834764831845f; }
            else if (pn < 4) { base = K; ldc = 512; colt = (pn - 2) * 256; }
            else { base = V; ldc = 1024; colt = (pn - 4) * 256; }
            const int col0 = colt + wc * 32 + 8 * fq;
#pragma unroll
            EPI_LOOP { EPI_RR(row0) const af4 v0 = acc[ai][bj][m][0] * sc, v1 = acc[ai][bj][m][1] * sc; v4u w; w.x = cvtpk(v0[0], v0[1]); w.y = cvtpk(v0[2], v0[3]); w.z = cvtpk(v1[0], v1[1]); w.w = cvtpk(v1[2], v1[3]);
                *(v4u*)(base + (size_t)RR * ldc + col0 + bj * 128) = w; }
        } else if (wc == 0) {
#pragma unroll
            for (int ai = 0; ai < 2; ++ai)
#pragma unroll
                for (int m = 0; m < 4; ++m) { const af4 v0 = acc[ai][0][m][0], v1 = acc[ai][0][m][1]; v4u w; w.x = cvtpk(v0[0], v0[1]); w.y = cvtpk(v0[2], v0[3]); w.z = cvtpk(v1[0], v1[1]); w.w = cvtpk(v1[2], v1[3]);
                    *(v4u*)(Z + (size_t)(row0 + ai * 128 + m * 16) * 32 + 8 * fq) = w; }
        }
    }
};
struct EpiA2 {
    static constexpr bool PERM = true, AFTER_DRAIN = false;
    bf16 *POOL, *ON, *GP, *GG; const bf16* OBp; const float* nw; LAS float* xch;
    __device__ __forceinline__ void operator()(const af4 (&acc)[2][2][4][2], const pg8::Unit& u, int wr, int wc, int fr_, int fq_) const {
        const int ln_ = lane_id_v(); const int fr = ln_ & 15, fq = ln_ >> 4;
        const int row0 = u.pm * 256 + wr * 64 + fr, pn = u.pn;
        if (pn < 2) {
            const int col0 = pn * 256 + wc * 32 + 8 * fq;
#pragma unroll
            EPI_LOOP { EPI_RR(row0) const af4 v0 = acc[ai][bj][m][0], v1 = acc[ai][bj][m][1]; v4u w; w.x = cvtpk(v0[0], v0[1]); w.y = cvtpk(v0[2], v0[3]); w.z = cvtpk(v1[0], v1[1]); w.w = cvtpk(v1[2], v1[3]);
                *(v4u*)(POOL + (size_t)RR * 512 + col0 + bj * 128) = w; }
        } else if (pn < 6) {
            const int col0 = (pn - 2) * 256 + wc * 32 + 8 * fq;
            float ssq[8];
#pragma unroll
            for (int b_ = 0; b_ < 4; ++b_) {
                const int ai = b_ >> 1, mp = b_ & 1;
                int RRb = row0 + ai * 128 + mp * 32; asm volatile("" : "+v"(RRb));
                const size_t ob = (size_t)RRb * 1024 + col0; v4u of_[2][2], ob_[2][2];
#pragma unroll
                for (int mi = 0; mi < 2; ++mi)
#pragma unroll
                    for (int bj = 0; bj < 2; ++bj) { of_[mi][bj] = *(const v4u*)(ON + ob + mi * 16 * 1024 + bj * 128); ob_[mi][bj] = *(const v4u*)(OBp + ob + mi * 16 * 1024 + bj * 128); }
#pragma unroll
                for (int mi = 0; mi < 2; ++mi) { float q = 0.f;
#pragma unroll
                    for (int bj = 0; bj < 2; ++bj) { const v4u a = of_[mi][bj], c = ob_[mi][bj];
                        const float o0 = bflo(a.x) + bflo(c.x), o1 = bfhi(a.x) + bfhi(c.x), o2 = bflo(a.y) + bflo(c.y), o3 = bfhi(a.y) + bfhi(c.y), o4 = bflo(a.z) + bflo(c.z), o5 = bfhi(a.z) + bfhi(c.z), o6 = bflo(a.w) + bflo(c.w), o7 = bfhi(a.w) + bfhi(c.w);
                        q += (o0 * o0 + o1 * o1) + (o2 * o2 + o3 * o3) + (o4 * o4 + o5 * o5) + (o6 * o6 + o7 * o7); }
                    ssq[ai * 4 + mp * 2 + mi] = q; }
                asm volatile("" ::: "memory");
            }
#pragma unroll
            for (int k = 0; k < 8; ++k) { float v = ssq[k];
                v += __int_as_float(__builtin_amdgcn_ds_bpermute((ln_ ^ 16) << 2, __float_as_int(v)));
                v += __int_as_float(__builtin_amdgcn_ds_bpermute((ln_ ^ 32) << 2, __float_as_int(v))); ssq[k] = v; }
            if (fq == 0) {
#pragma unroll
                for (int k = 0; k < 8; ++k) xch[((k >> 2) * 128 + wr * 64 + (k & 3) * 16 + fr) * 4 + wc] = ssq[k];
            }
            asm volatile("s_waitcnt lgkmcnt(0)" ::: "memory"); __builtin_amdgcn_s_barrier(); asm volatile("" ::: "memory");
            float rs[8];
#pragma unroll
            for (int k = 0; k < 8; ++k) { const f32x4 p4 = *(const LAS f32x4*)(xch + ((k >> 2) * 128 + wr * 64 + (k & 3) * 16 + fr) * 4);
                rs[k] = 1.0f / sqrtf(((p4[0] + p4[1]) + (p4[2] + p4[3])) * (1.f / 256.f) + LN_EPS); }
            f32x4 nwv[2][2];
#pragma unroll
            for (int bj = 0; bj < 2; ++bj) { nwv[bj][0] = *(const f32x4*)(nw + col0 + bj * 128); nwv[bj][1] = *(const f32x4*)(nw + col0 + bj * 128 + 4); }
#pragma unroll
            for (int b_ = 0; b_ < 4; ++b_) {
                const int ai = b_ >> 1, mp = b_ & 1;
                int RRb = row0 + ai * 128 + mp * 32; asm volatile("" : "+v"(RRb));
                const size_t ob = (size_t)RRb * 1024 + col0; v4u of_[2][2], ob_[2][2];
#pragma unroll
                for (int mi = 0; mi < 2; ++mi)
#pragma unroll
                    for (int bj = 0; bj < 2; ++bj) { of_[mi][bj] = *(const v4u*)(ON + ob + mi * 16 * 1024 + bj * 128); ob_[mi][bj] = *(const v4u*)(OBp + ob + mi * 16 * 1024 + bj * 128); }
#pragma unroll
                for (int mi = 0; mi < 2; ++mi) { const float rstd = rs[ai * 4 + mp * 2 + mi];
#pragma unroll
                    for (int bj = 0; bj < 2; ++bj) { af4 v0 = acc[ai][bj][mp * 2 + mi][0], v1 = acc[ai][bj][mp * 2 + mi][1]; asm volatile("" : "+v"(v0), "+v"(v1)); const v4u a = of_[mi][bj], c = ob_[mi][bj];
#pragma unroll
                        for (int e = 0; e < 4; ++e) { v0[e] = v0[e] * sigmoidf_(v0[e]) * (rstd * nwv[bj][0][e]); v1[e] = v1[e] * sigmoidf_(v1[e]) * (rstd * nwv[bj][1][e]); }
                        v4u w; w.x = cvtpk(v0[0] * (bflo(a.x) + bflo(c.x)), v0[1] * (bfhi(a.x) + bfhi(c.x))); w.y = cvtpk(v0[2] * (bflo(a.y) + bflo(c.y)), v0[3] * (bfhi(a.y) + bfhi(c.y)));
                        w.z = cvtpk(v1[0] * (bflo(a.z) + bflo(c.z)), v1[1] * (bfhi(a.z) + bfhi(c.z))); w.w = cvtpk(v1[2] * (bflo(a.w) + bflo(c.w)), v1[3] * (bfhi(a.w) + bfhi(c.w)));
                        *(v4u*)(ON + ob + mi * 16 * 1024 + bj * 128) = w; } }
                asm volatile("" ::: "memory");
            }
        } else {
            bf16* base = pn < 10 ? GP : GG; const int col0 = ((pn - 6) & 3) * 256 + wc * 32 + 8 * fq;
#pragma unroll
            EPI_LOOP { EPI_RR(row0) af4 v0 = acc[ai][bj][m][0], v1 = acc[ai][bj][m][1];
#pragma unroll
                for (int e = 0; e < 4; ++e) { v0[e] = sigmoidf_(v0[e]); v1[e] = sigmoidf_(v1[e]); }
                v4u w; w.x = cvtpk(v0[0], v0[1]); w.y = cvtpk(v0[2], v0[3]); w.z = cvtpk(v1[0], v1[1]); w.w = cvtpk(v1[2], v1[3]);
                *(v4u*)(base + (size_t)RR * 1024 + col0 + bj * 128) = w; asm volatile("" ::: "memory"); }
        }
    }
};
struct EpiMul {
    static constexpr bool PERM = true, AFTER_DRAIN = false;
    bf16* G;
    __device__ __forceinline__ void operator()(const af4 (&acc)[2][2][4][2], const pg8::Unit& u, int wr, int wc, int fr_, int fq_) const {
        const int ln_ = lane_id_v(); const int fr = ln_ & 15, fq = ln_ >> 4;
        const int row0 = u.pm * 256 + wr * 64 + fr, col0 = u.pn * 256 + wc * 32 + 8 * fq;
        v4u o[2][2][2];
#define MUL_LOAD(buf, b_) do { int RRl = row0 + ((b_) >> 1) * 128 + ((b_) & 1) * 32; asm volatile("" : "+v"(RRl)); const bf16* pl = G + (size_t)RRl * 1024 + col0; \
            _Pragma("unroll") for (int mi = 0; mi < 2; ++mi) _Pragma("unroll") for (int bj = 0; bj < 2; ++bj) o[buf][mi][bj] = *(const v4u*)(pl + mi * 16 * 1024 + bj * 128); } while (0)
        MUL_LOAD(0, 0);
#pragma unroll
        for (int b_ = 0; b_ < 4; ++b_) {
            const int ai = b_ >> 1, mp = b_ & 1, cur = b_ & 1;
            if (b_ + 1 < 4) { if (cur == 0) MUL_LOAD(1, b_ + 1); else MUL_LOAD(0, b_ + 1); }
            int RRb = row0 + ai * 128 + mp * 32; asm volatile("" : "+v"(RRb));
            bf16* pb = G + (size_t)RRb * 1024 + col0;
#pragma unroll
            for (int mi = 0; mi < 2; ++mi)
#pragma unroll
                for (int bj = 0; bj < 2; ++bj) { const af4 v0 = acc[ai][bj][mp * 2 + mi][0], v1 = acc[ai][bj][mp * 2 + mi][1]; const v4u oo = o[cur][mi][bj];
                    v4u w; w.x = cvtpk(v0[0] * bflo(oo.x), v0[1] * bfhi(oo.x)); w.y = cvtpk(v0[2] * bflo(oo.y), v0[3] * bfhi(oo.y)); w.z = cvtpk(v1[0] * bflo(oo.z), v1[1] * bfhi(oo.z)); w.w = cvtpk(v1[2] * bflo(oo.w), v1[3] * bfhi(oo.w));
                    *(v4u*)(pb + mi * 16 * 1024 + bj * 128) = w; }
            asm volatile("" ::: "memory");
        }
#undef MUL_LOAD
    }
};
struct EpiMulAdd {
    static constexpr bool PERM = true, AFTER_DRAIN = false;
    bf16* G; const bf16* Y;
    __device__ __forceinline__ void operator()(const af4 (&acc)[2][2][4][2], const pg8::Unit& u, int wr, int wc, int fr_, int fq_) const {
        const int ln_ = lane_id_v(); const int fr = ln_ & 15, fq = ln_ >> 4;
        const int row0 = u.pm * 256 + wr * 64 + fr, col0 = u.pn * 256 + wc * 32 + 8 * fq;
        v4u o[2][2][2], yv[2][2][2];
#define MA_LOAD(buf, b_) do { int RRl = row0 + ((b_) >> 1) * 128 + ((b_) & 1) * 32; asm volatile("" : "+v"(RRl)); const size_t ol = (size_t)RRl * 1024 + col0; \
            _Pragma("unroll") for (int mi = 0; mi < 2; ++mi) _Pragma("unroll") for (int bj = 0; bj < 2; ++bj) { o[buf][mi][bj] = *(const v4u*)(G + ol + mi * 16 * 1024 + bj * 128); yv[buf][mi][bj] = *(const v4u*)(Y + ol + mi * 16 * 1024 + bj * 128); } } while (0)
        MA_LOAD(0, 0);
#pragma unroll
        for (int b_ = 0; b_ < 4; ++b_) {
            const int ai = b_ >> 1, mp = b_ & 1, cur = b_ & 1;
            if (b_ + 1 < 4) { if (cur == 0) MA_LOAD(1, b_ + 1); else MA_LOAD(0, b_ + 1); }
            int RRb = row0 + ai * 128 + mp * 32; asm volatile("" : "+v"(RRb));
            const size_t ob = (size_t)RRb * 1024 + col0;
#pragma unroll
            for (int mi = 0; mi < 2; ++mi)
#pragma unroll
                for (int bj = 0; bj < 2; ++bj) { const af4 v0 = acc[ai][bj][mp * 2 + mi][0], v1 = acc[ai][bj][mp * 2 + mi][1]; const v4u oo = o[cur][mi][bj], y = yv[cur][mi][bj];
                    v4u w; w.x = cvtpk(bflo(y.x) + v0[0] * bflo(oo.x), bfhi(y.x) + v0[1] * bfhi(oo.x)); w.y = cvtpk(bflo(y.y) + v0[2] * bflo(oo.y), bfhi(y.y) + v0[3] * bfhi(oo.y));
                    w.z = cvtpk(bflo(y.z) + v1[0] * bflo(oo.z), bfhi(y.z) + v1[1] * bfhi(oo.z)); w.w = cvtpk(bflo(y.w) + v1[2] * bflo(oo.w), bfhi(y.w) + v1[3] * bfhi(oo.w));
                    *(v4u*)(G + ob + mi * 16 * 1024 + bj * 128) = w; }
            asm volatile("" ::: "memory");
        }
#undef MA_LOAD
    }
};
struct EpiRes {
    static constexpr bool PERM = true, AFTER_DRAIN = false;
    float* xl; float* xc; const float* gate; int rowbase; const float* stats; const float* lnw; const float* lnb;
    __device__ __forceinline__ void operator()(const af4 (&acc)[2][2][4][2], const pg8::Unit& u, int wr, int wc, int fr_, int fq_) const {
        const int ln_ = lane_id_v(); const int fr = ln_ & 15, fq = ln_ >> 4;
        const int grow = rowbase + u.pm * 256; const int bi = grow < TL ? grow / LSEQ : NB;
        float* xb = grow < TL ? xl + (size_t)grow * DM : xc + (size_t)(grow - TL) * DM;
        const float* stb = stats + 2 * (size_t)grow;
        const int col0 = u.pn * 256 + wc * 32 + 8 * fq; const float* gp = gate + (size_t)bi * 6144 + col0;
        f32x4 g[2][2], wa[2][2], ba[2][2];
#pragma unroll
        for (int bj = 0; bj < 2; ++bj)
#pragma unroll
            for (int hf = 0; hf < 2; ++hf) { g[bj][hf] = *(const f32x4*)(gp + bj * 128 + 4 * hf);
                if (lnw) { wa[bj][hf] = *(const f32x4*)(lnw + col0 + bj * 128 + 4 * hf) * ALPHA; ba[bj][hf] = *(const f32x4*)(lnb + col0 + bj * 128 + 4 * hf) * ALPHA; }
                else { wa[bj][hf] = (f32x4){ALPHA, ALPHA, ALPHA, ALPHA}; ba[bj][hf] = (f32x4){0.f, 0.f, 0.f, 0.f}; } }
        const int row0 = wr * 64 + fr;
#pragma unroll
        for (int b_ = 0; b_ < 4; ++b_) {
            const int ai = b_ >> 1, mp = b_ & 1;
            int RRb = row0 + ai * 128 + mp * 32; asm volatile("" : "+v"(RRb));
            float* pb = xb + (size_t)RRb * DM + col0;
            f32x4 xv[2][2][2]; f32x2 st[2];
#pragma unroll
            for (int mi = 0; mi < 2; ++mi) { st[mi] = *(const f32x2*)(stb + 2 * (RRb + mi * 16));
#pragma unroll
                for (int bj = 0; bj < 2; ++bj) { xv[mi][bj][0] = *(const f32x4*)(pb + mi * 16 * DM + bj * 128); xv[mi][bj][1] = *(const f32x4*)(pb + mi * 16 * DM + bj * 128 + 4); } }
#pragma unroll
            for (int mi = 0; mi < 2; ++mi)
#pragma unroll
                for (int bj = 0; bj < 2; ++bj) { f32x4 o0, o1; const float mean = st[mi].x, rstd = st[mi].y;
#pragma unroll
                    for (int e = 0; e < 4; ++e) {
                        o0[e] = (xv[mi][bj][0][e] - mean) * (wa[bj][0][e] * rstd) + (ba[bj][0][e] + g[bj][0][e] * acc[ai][bj][mp * 2 + mi][0][e]);
                        o1[e] = (xv[mi][bj][1][e] - mean) * (wa[bj][1][e] * rstd) + (ba[bj][1][e] + g[bj][1][e] * acc[ai][bj][mp * 2 + mi][1][e]); }
                    *(f32x4*)(pb + mi * 16 * DM + bj * 128) = o0; *(f32x4*)(pb + mi * 16 * DM + bj * 128 + 4) = o1; }
            asm volatile("" ::: "memory");
        }
    }
};
struct EpiUp {
    static constexpr bool PERM = true, AFTER_DRAIN = false;
    bf16* UP;
    __device__ __forceinline__ void operator()(const af4 (&acc)[2][2][4][2], const pg8::Unit& u, int wr, int wc, int fr_, int fq_) const {
        const int ln_ = lane_id_v(); const int fr = ln_ & 15, fq = ln_ >> 4;
        const int row0 = u.pm * 256 + wr * 64 + fr, col0 = u.pn * 256 + wc * 32 + 8 * fq;
#pragma unroll
        EPI_LOOP { EPI_RR(row0) const af4 v0 = acc[ai][bj][m][0], v1 = acc[ai][bj][m][1]; v4u w; w.x = cvtpk(v0[0], v0[1]); w.y = cvtpk(v0[2], v0[3]); w.z = cvtpk(v1[0], v1[1]); w.w = cvtpk(v1[2], v1[3]);
            *(v4u*)(UP + (size_t)RR * NU + col0 + bj * 128) = w; }
    }
};


__device__ __forceinline__ float gelu_erf(float v) {
    const float av = fabsf(v), t = __builtin_amdgcn_rcpf(av * 0.2316418882f + 1.0f);
    float q = t * 0.5307027145f + (-0.7265760135f); q = q * t + 0.7107068705f; q = q * t + (-0.142248368f); q = q * t + 0.127414796f; q = q * t;
    const float e = __builtin_amdgcn_exp2f((v * v) * (-0.72134752044f));
    const float mm = v * (q * e);
    return v < 0.f ? mm : v - mm;
}

__device__ __forceinline__ f32x2 gelu_pk(f32x2 v) {
    const f32x2 av = __builtin_elementwise_abs(v), d = av * 0.2316418882f + 1.0f;
    f32x2 t; t.x = __builtin_amdgcn_rcpf(d.x); t.y = __builtin_amdgcn_rcpf(d.y);
    f32x2 q = t * 0.5307027145f + (-0.7265760135f); q = q * t + 0.7107068705f; q = q * t + (-0.142248368f); q = q * t + 0.127414796f; q = q * t;
    const f32x2 sq = (v * v) * (-0.72134752044f);
    f32x2 e; e.x = __builtin_amdgcn_exp2f(sq.x); e.y = __builtin_amdgcn_exp2f(sq.y);
    const f32x2 mm = v * (q * e), rr = v - mm;
    f32x2 o; o.x = v.x < 0.f ? mm.x : rr.x; o.y = v.y < 0.f ? mm.y : rr.y; return o;
}
#define DPP_ROR1(x) __int_as_float(__builtin_amdgcn_update_dpp(0, __float_as_int(x), 0x121, 0xf, 0xf, false))
#define DPP_ROR15(x) __int_as_float(__builtin_amdgcn_update_dpp(0, __float_as_int(x), 0x12F, 0xf, 0xf, false))
struct EpiUpConv {
    static constexpr bool PERM = true, AFTER_DRAIN = false;
    bf16* HID; const float* cw; const float* cb; LAS float* xch;
    __device__ __forceinline__ void operator()(const af4 (&acc)[2][2][4][2], const pg8::Unit& u, int wr, int wc, int fr_, int fq_) const {
        const int ln_ = lane_id_v(); const int fr = ln_ & 15, fq = ln_ >> 4;
        const int row0 = u.pm * 256 + wr * 64 + fr, jl = 32 * wc + 8 * fq, j0 = 128 * u.pn + jl;
        const bool isctx = u.pm >= TL / 256;
        f32x4 cwv[2][4];
#pragma unroll
        for (int n = 0; n < 2; ++n) { cwv[n][0] = *(const f32x4*)(cw + j0 + 4 * n); cwv[n][1] = *(const f32x4*)(cw + FF + j0 + 4 * n); cwv[n][2] = *(const f32x4*)(cw + 2 * FF + j0 + 4 * n); cwv[n][3] = *(const f32x4*)(cb + j0 + 4 * n); }
        if (isctx) {
#pragma unroll
            for (int ai = 0; ai < 2; ++ai) { const int blk = 2 * ai + wr;
                if (fr == 0) { *(LAS f32x4*)(xch + (blk * 2 + 0) * 128 + jl) = acc[ai][0][0][0]; *(LAS f32x4*)(xch + (blk * 2 + 0) * 128 + jl + 4) = acc[ai][0][0][1]; }
                if (fr == 15) { *(LAS f32x4*)(xch + (blk * 2 + 1) * 128 + jl) = acc[ai][0][3][0]; *(LAS f32x4*)(xch + (blk * 2 + 1) * 128 + jl + 4) = acc[ai][0][3][1]; } }
            asm volatile("s_waitcnt lgkmcnt(0)" ::: "memory"); __builtin_amdgcn_s_barrier(); asm volatile("" ::: "memory");
        }
#pragma unroll
        for (int ai = 0; ai < 2; ++ai)
#pragma unroll
            for (int n = 0; n < 2; ++n) {
                const f32x4 w0 = cwv[n][0], w1 = cwv[n][1], w2 = cwv[n][2], bb = cwv[n][3];
                f32x4 bprev = {0.f, 0.f, 0.f, 0.f}, bnext = {0.f, 0.f, 0.f, 0.f};
                if (isctx) { const int blk = 2 * ai + wr;
                    if (blk > 0) bprev = *(const LAS f32x4*)(xch + ((blk - 1) * 2 + 1) * 128 + jl + 4 * n);
                    if (blk < 3) bnext = *(const LAS f32x4*)(xch + ((blk + 1) * 2 + 0) * 128 + jl + 4 * n); }
                f32x4 R[4], L[4];
#pragma unroll
                for (int m = 0; m < 4; ++m)
#pragma unroll
                    for (int e = 0; e < 4; ++e) { R[m][e] = DPP_ROR1(acc[ai][0][m][n][e]); L[m][e] = DPP_ROR15(acc[ai][0][m][n][e]); }
#pragma unroll
                for (int m = 0; m < 4; ++m) {
                    f32x2 o2[2];
#pragma unroll
                    for (int ep = 0; ep < 2; ++ep) {
                        f32x2 pv, nv;
#pragma unroll
                        for (int q = 0; q < 2; ++q) { const int e = 2 * ep + q;
                            pv[q] = (fr == 0) ? (m == 0 ? bprev[e] : R[m == 0 ? 0 : m - 1][e]) : R[m][e];
                            nv[q] = (fr == 15) ? (m == 3 ? bnext[e] : L[m == 3 ? 3 : m + 1][e]) : L[m][e]; }
                        const f32x2 a2 = {acc[ai][0][m][n][2 * ep], acc[ai][0][m][n][2 * ep + 1]}, g2 = {acc[ai][1][m][n][2 * ep], acc[ai][1][m][n][2 * ep + 1]};
                        const f32x2 w0p = {w0[2 * ep], w0[2 * ep + 1]}, w1p = {w1[2 * ep], w1[2 * ep + 1]}, w2p = {w2[2 * ep], w2[2 * ep + 1]}, bbp = {bb[2 * ep], bb[2 * ep + 1]};
                        const f32x2 c2 = w0p * pv + (w1p * a2 + (w2p * nv + bbp));
                        o2[ep] = gelu_pk(c2) * g2;
                    }
                    v2u w; w.x = cvtpk(o2[0].x, o2[0].y); w.y = cvtpk(o2[1].x, o2[1].y);
                    *(v2u*)(HID + (size_t)(row0 + ai * 128 + m * 16) * FF + j0 + 4 * n) = w;
                }
            }
    }
};
template <class Epi, bool ALIGN = false> __device__ __forceinline__ void run_gemm(LAS unsigned char* lds, const bf16* A, const bf16* Bt, int nM, int N, int K, const Epi& E, const int wave_s) {
    pg8::Gemm g{A, Bt, nM * 256, N, K}; RangeOrder S; S.init(nM, N / 256, (int)gridDim.x, (int)blockIdx.x);
    pg8::gemm_phase<Epi, RangeOrder, ALIGN, true>(lds, g, S, E, wave_s);
}

__device__ __forceinline__ void transpose_block(const float* W, int ldw, int src_n0, int k0, bf16* WT, int K, int dst_n0, LAS float* scr, int lane) {
    if (src_n0 >= 0) {
#pragma unroll
        for (int i = 0; i < 32; ++i) { const int kk = 2 * i + (lane >> 5); scr[kk * 33 + (lane & 31)] = W[(size_t)(k0 + kk) * ldw + src_n0 + (lane & 31)]; }
    } else {
#pragma unroll 8
        for (int i = 0; i < 32; ++i) { const int kk = 2 * i + (lane >> 5); scr[kk * 33 + (lane & 31)] = 0.f; }
    }
    asm volatile("s_waitcnt lgkmcnt(0)" ::: "memory");
    const int c = lane & 7;
#pragma unroll
    for (int j = 0; j < 4; ++j) { const int n = (lane >> 3) + 8 * j; const LAS float* s = scr + (8 * c) * 33 + n;
        v4u o; o.x = cvtpk(s[0 * 33], s[1 * 33]); o.y = cvtpk(s[2 * 33], s[3 * 33]); o.z = cvtpk(s[4 * 33], s[5 * 33]); o.w = cvtpk(s[6 * 33], s[7 * 33]);
        *(v4u*)(WT + (size_t)(dst_n0 + n) * K + k0 + 8 * c) = o; }
    asm volatile("s_waitcnt lgkmcnt(0)" ::: "memory");
}

struct P {
    const float* in[25]; float* out; unsigned char* ws;
};

__device__ __forceinline__ void ln_core(f32x4 (&v)[4], int lane) {
    float s = 0.f;
#pragma unroll
    for (int j = 0; j < 4; ++j) s += (v[j][0] + v[j][1]) + (v[j][2] + v[j][3]);
    const float mean = wave_sum(s, lane) * (1.f / DM); float s2 = 0.f;
#pragma unroll
    for (int j = 0; j < 4; ++j) { v[j] = v[j] - mean; s2 += (v[j][0] * v[j][0] + v[j][1] * v[j][1]) + (v[j][2] * v[j][2] + v[j][3] * v[j][3]); }
    const float rstd = 1.0f / sqrtf(wave_sum(s2, lane) * (1.f / DM) + LN_EPS);
#pragma unroll
    for (int j = 0; j < 4; ++j) v[j] = v[j] * rstd;
}
__device__ __forceinline__ void store_x_ux(const f32x4 (&v)[4], float* xrow, bf16* uxrow, const float* sh, const float* sc, int lane) {
#pragma unroll
    for (int j = 0; j < 4; ++j) {
        const int c = 4 * lane + 256 * j;
        *(f32x4*)(xrow + c) = v[j];
        if (uxrow) { const f32x4 a = *(const f32x4*)(sc + c), b = *(const f32x4*)(sh + c);
            v2u w; w.x = cvtpk(v[j][0] * (1.f + a[0]) + b[0], v[j][1] * (1.f + a[1]) + b[1]); w.y = cvtpk(v[j][2] * (1.f + a[2]) + b[2], v[j][3] * (1.f + a[3]) + b[3]);
            *(v2u*)(uxrow + c) = w; }
    }
}


__device__ __forceinline__ float dpp_row_total(float v) {
    v += __int_as_float(__builtin_amdgcn_update_dpp(0, __float_as_int(v), 0xB1, 0xf, 0xf, false));
    v += __int_as_float(__builtin_amdgcn_update_dpp(0, __float_as_int(v), 0x4E, 0xf, 0xf, false));
    v += __int_as_float(__builtin_amdgcn_update_dpp(0, __float_as_int(v), 0x141, 0xf, 0xf, false));
    v += __int_as_float(__builtin_amdgcn_update_dpp(0, __float_as_int(v), 0x140, 0xf, 0xf, false));
    return v;
}
__device__ __forceinline__ float wave_sum_dpp(float v) {
    v = dpp_row_total(v); const int i = __float_as_int(v);
    return (__int_as_float(__builtin_amdgcn_readlane(i, 0)) + __int_as_float(__builtin_amdgcn_readlane(i, 16))) + (__int_as_float(__builtin_amdgcn_readlane(i, 32)) + __int_as_float(__builtin_amdgcn_readlane(i, 48)));
}
__device__ __forceinline__ float half_sum_dpp(float v, int lane) {
    v = dpp_row_total(v); const int i = __float_as_int(v);
    const float t0 = __int_as_float(__builtin_amdgcn_readlane(i, 0)) + __int_as_float(__builtin_amdgcn_readlane(i, 16));
    const float t1 = __int_as_float(__builtin_amdgcn_readlane(i, 32)) + __int_as_float(__builtin_amdgcn_readlane(i, 48));
    return lane < 32 ? t0 : t1;
}
__device__ __forceinline__ void ln_phase(const int lane, const int gw, const int NGW, const int rows, float* xl, float* xcp, const float* lw, const float* lb,
                                         const float* modl, const int sh_off, const int sc_off, bf16* UXp, const float* x_init, const float* ctx_init, const float* POSp, float* stats, const bool final_x) {
    for (int row0 = gw * 4; row0 < rows; row0 += NGW * 4) {
        f32x4 v[4][4]; const bool lat = row0 < TL; const int bi = lat ? row0 / LSEQ : NB;
#pragma unroll
        for (int rr = 0; rr < 4; ++rr) { const int row = row0 + rr;
            const float* src = x_init ? (lat ? x_init + (size_t)row * DM : ctx_init + (size_t)(row - TL) * DM) : (lat ? xl + (size_t)row * DM : xcp + (size_t)(row - TL) * DM);
#pragma unroll
            for (int j = 0; j < 4; ++j) v[rr][j] = *(const f32x4*)(src + 4 * lane + 256 * j); }
        if (x_init && lat) {
#pragma unroll
            for (int rr = 0; rr < 4; ++rr) { const int t = (row0 + rr) % LSEQ; const float* e0 = POSp + (t >> 6) * 512; const float* e1 = POSp + (t & 63) * 512;
#pragma unroll
                for (int j = 0; j < 4; ++j) { const int c = 4 * lane + 256 * j; v[rr][j] += (j < 2) ? *(const f32x4*)(e0 + c) : *(const f32x4*)(e1 + c - 512); } }
        }
        if (x_init) {
#pragma unroll
            for (int rr = 0; rr < 4; ++rr) { const int row = row0 + rr; float* dst = lat ? xl + (size_t)row * DM : xcp + (size_t)(row - TL) * DM;
#pragma unroll
                for (int j = 0; j < 4; ++j) *(f32x4*)(dst + 4 * lane + 256 * j) = v[rr][j]; }
        }
        float mean[4], rstd[4];
#pragma unroll
        for (int rr = 0; rr < 4; ++rr) { float s = 0.f;
#pragma unroll
            for (int j = 0; j < 4; ++j) s += (v[rr][j][0] + v[rr][j][1]) + (v[rr][j][2] + v[rr][j][3]);
            mean[rr] = wave_sum_dpp(s) * (1.f / DM); }
#pragma unroll
        for (int rr = 0; rr < 4; ++rr) { float s2 = 0.f;
#pragma unroll
            for (int j = 0; j < 4; ++j) { v[rr][j] = v[rr][j] - mean[rr]; s2 += (v[rr][j][0] * v[rr][j][0] + v[rr][j][1] * v[rr][j][1]) + (v[rr][j][2] * v[rr][j][2] + v[rr][j][3] * v[rr][j][3]); }
            rstd[rr] = 1.0f / sqrtf(wave_sum_dpp(s2) * (1.f / DM) + LN_EPS); }
        if (lane == 0) {
#pragma unroll
            for (int rr = 0; rr < 4; ++rr) *(f32x2*)(stats + 2 * (size_t)(row0 + rr)) = (f32x2){mean[rr], rstd[rr]};
        }
        const float* md = modl + (size_t)bi * 6144;
#pragma unroll
        for (int j = 0; j < 4; ++j) { const int c = 4 * lane + 256 * j;
            f32x4 w4 = {1.f, 1.f, 1.f, 1.f}, b4 = {0.f, 0.f, 0.f, 0.f}; if (lw) { w4 = *(const f32x4*)(lw + c); b4 = *(const f32x4*)(lb + c); }
            f32x4 sc4 = {0.f, 0.f, 0.f, 0.f}, sh4 = {0.f, 0.f, 0.f, 0.f}; if (UXp) { sc4 = *(const f32x4*)(md + sc_off + c); sh4 = *(const f32x4*)(md + sh_off + c); }
#pragma unroll
            for (int rr = 0; rr < 4; ++rr) { const int row = row0 + rr; const f32x4 y = v[rr][j] * rstd[rr] * w4 + b4;
                if (final_x) { float* dst = lat ? xl + (size_t)row * DM : xcp + (size_t)(row - TL) * DM; *(f32x4*)(dst + c) = y; }
                if (UXp) { v2u w; w.x = cvtpk(y[0] * (1.f + sc4[0]) + sh4[0], y[1] * (1.f + sc4[1]) + sh4[1]); w.y = cvtpk(y[2] * (1.f + sc4[2]) + sh4[2], y[3] * (1.f + sc4[3]) + sh4[3]); *(v2u*)(UXp + (size_t)row * DM + c) = w; } }
        }
    }
}
#define MFMA32(a, b, c) __builtin_amdgcn_mfma_f32_32x32x16_bf16((a), (b), (c), 0, 0, 0)
__device__ __forceinline__ bf16x8 pack_step(const f32x16& x, int s) {
    v4u p; p.x = cvtpk(x[8 * s + 0], x[8 * s + 1]); p.y = cvtpk(x[8 * s + 2], x[8 * s + 3]); p.z = cvtpk(x[8 * s + 4], x[8 * s + 5]); p.w = cvtpk(x[8 * s + 6], x[8 * s + 7]);
    return __builtin_bit_cast(bf16x8, p);
}
constexpr int G_QE = 0, G_KE = 17408, G_KT = 34816, G_VT = 53248, G_BC = 71680, G_ZS = G_BC + 64 * 528, G_SEG = G_ZS + 4096, G_DEC = G_SEG + 2048, G_END = G_DEC + 512;
static_assert(G_END <= 131072, "gla lds");
constexpr int NCHUNK = 68;

__device__ __forceinline__ int gla_row(int n, int p, int b, int dir) {
    const bool isctx = n < 4; const int nn = isctx ? n : n - 4; const int Ls = isctx ? CTXL : LSEQ; const int Pp = 64 * nn + p;
    const int tok = dir ? (Ls - 1 - Pp) : Pp; return (isctx ? TL + b * CTXL : b * LSEQ) + tok;
}

__device__ __forceinline__ void gla_phase(LAS unsigned char* lds, const bf16* Q, const bf16* K, const bf16* V, const bf16* Z, bf16* OF, bf16* OB,
                                          const float* wgf, const float* bgf, const float* wgb, const float* bgb, const int wave_s) {
    const int lane = lane_id_v(), wid = wave_s, tid = wid * 64 + lane, r = lane & 31, h = lane >> 5, wv = wid & 3, wi = wid >> 2;
    LAS unsigned char* Qe = lds + G_QE; LAS unsigned char* Ke = lds + G_KE; LAS unsigned char* KT = lds + G_KT; LAS unsigned char* VT = lds + G_VT;
    LAS float* Bc = (LAS float*)(lds + G_BC); LAS unsigned char* Zs = lds + G_ZS; LAS float* Seg = (LAS float*)(lds + G_SEG); LAS float* Dec = (LAS float*)(lds + G_DEC);
    for (int w = blockIdx.x; w < 256; w += gridDim.x) {
        const int b = w >> 4, hh = (w >> 2) & 3, dir = (w >> 1) & 1, vh = w & 1;
        const float* wg = dir ? wgb : wgf; const float* bg = dir ? bgb : bgf; bf16* O = dir ? OB : OF;
        const float bgl = bg[hh * 128 + 32 * wv + r];
        bf16x8 wghi;
        { float wf[8];
#pragma unroll
          for (int j = 0; j < 8; ++j) wf[j] = wg[(8 * h + j) * 512 + hh * 128 + 32 * wv + r];
          v4u ph; ph.x = cvtpk(wf[0], wf[1]); ph.y = cvtpk(wf[2], wf[3]); ph.z = cvtpk(wf[4], wf[5]); ph.w = cvtpk(wf[6], wf[7]);
          wghi = __builtin_bit_cast(bf16x8, ph); }
        f32x16 S[4];
#pragma unroll
        for (int t = 0; t < 4; ++t)
#pragma unroll
            for (int e = 0; e < 16; ++e) S[t][e] = 0.f;
        v4u rq[2], rk[2], rv[2], rz;
        rz = (v4u){0u, 0u, 0u, 0u};
#define GLA_LOAD(n) do { _Pragma("unroll") for (int i = 0; i < 2; ++i) { const int idx = tid + 512 * i, p = idx >> 4, c8 = idx & 15; const size_t row = (size_t)gla_row((n), p, b, dir); \
            rq[i] = *(const v4u*)(Q + row * 512 + hh * 128 + 8 * c8); rk[i] = *(const v4u*)(K + row * 512 + hh * 128 + 8 * c8); rv[i] = *(const v4u*)(V + row * 1024 + hh * 256 + vh * 128 + 8 * c8); } } while (0)
#define GLA_LOADZ(n) do { if (tid < 128) { const size_t row = (size_t)gla_row((n), tid >> 1, b, dir); rz = *(const v4u*)(Z + row * 32 + dir * 16 + 8 * (tid & 1)); } } while (0)
#define GLA_ZSTORE() do { if (tid < 128) *(LAS v4u*)(Zs + (tid >> 1) * 32 + 16 * (tid & 1)) = rz; } while (0)
#define GLA_GATEB() do { const bf16x8 za = *(const LAS bf16x8*)(Zs + (32 * wi + r) * 32 + 16 * h); f32x16 gt_; \
            _Pragma("unroll") for (int e = 0; e < 16; ++e) gt_[e] = 0.f; \
            gt_ = MFMA32(za, wghi, gt_); \
            float c_[16], s_[4], t_[4]; \
            _Pragma("unroll") for (int j = 0; j < 4; ++j) { float run = 0.f; \
                _Pragma("unroll") for (int i = 0; i < 4; ++i) { const float g = gt_[4 * j + i] + bgl; \
                    const float la = (fminf(g, 0.f) - __logf(1.0f + __expf(-fabsf(g)))) * (1.0f / 16.0f); run += la; c_[4 * j + i] = run; } \
                s_[j] = run; } \
            _Pragma("unroll") for (int j = 0; j < 4; ++j) t_[j] = __int_as_float(__builtin_amdgcn_ds_bpermute((lane ^ 32) << 2, __float_as_int(s_[j]))); \
            float offj = 0.f; \
            _Pragma("unroll") for (int j = 0; j < 4; ++j) { const float o_ = offj + (h ? t_[j] : 0.f); \
                _Pragma("unroll") for (int i = 0; i < 4; ++i) Bc[(32 * wi + 8 * j + 4 * h + i) * 132 + 32 * wv + r] = c_[4 * j + i] + o_; \
                offj += s_[j] + t_[j]; } \
            if (h == 0) Seg[wi * 128 + 32 * wv + r] = offj; } while (0)
        GLA_LOAD(0); GLA_LOADZ(0);
        __syncthreads();
        GLA_ZSTORE();
        GLA_LOADZ(1);
        __syncthreads();
        GLA_GATEB();
        for (int n = 0; n < NCHUNK; ++n) {
            __syncthreads();
#pragma unroll
            for (int i = 0; i < 2; ++i) { const int idx = tid + 512 * i, p = idx >> 4, c8 = idx & 15; const int pcol = ((((p >> 3) ^ (c8 & 7)) << 4) + ((p & 7) << 1));
                const f32x4 b0 = *(const LAS f32x4*)(Bc + p * 132 + 8 * c8), b1 = *(const LAS f32x4*)(Bc + p * 132 + 8 * c8 + 4);
                const f32x4 t00 = *(const LAS f32x4*)(Seg + 8 * c8), t01 = *(const LAS f32x4*)(Seg + 8 * c8 + 4), t10 = *(const LAS f32x4*)(Seg + 128 + 8 * c8), t11 = *(const LAS f32x4*)(Seg + 128 + 8 * c8 + 4);
                float qf[8], kf[8], bc[8], dc[8];
                qf[0] = bflo(rq[i].x); qf[1] = bfhi(rq[i].x); qf[2] = bflo(rq[i].y); qf[3] = bfhi(rq[i].y); qf[4] = bflo(rq[i].z); qf[5] = bfhi(rq[i].z); qf[6] = bflo(rq[i].w); qf[7] = bfhi(rq[i].w);
                kf[0] = bflo(rk[i].x); kf[1] = bfhi(rk[i].x); kf[2] = bflo(rk[i].y); kf[3] = bfhi(rk[i].y); kf[4] = bflo(rk[i].z); kf[5] = bfhi(rk[i].z); kf[6] = bflo(rk[i].w); kf[7] = bfhi(rk[i].w);
#pragma unroll
                for (int e = 0; e < 4; ++e) { bc[e] = b0[e] + (p >= 32 ? t00[e] : 0.f); bc[4 + e] = b1[e] + (p >= 32 ? t01[e] : 0.f); dc[e] = __expf(t00[e] + t10[e]); dc[4 + e] = __expf(t01[e] + t11[e]); }
                if (p == 0) { *(LAS f32x4*)(Dec + 8 * c8) = (f32x4){dc[0], dc[1], dc[2], dc[3]}; *(LAS f32x4*)(Dec + 8 * c8 + 4) = (f32x4){dc[4], dc[5], dc[6], dc[7]}; }
                float qe[8], ke[8], kn[8];
#pragma unroll
                for (int e = 0; e < 8; ++e) { const float ex = __expf(bc[e]); const float inv = __builtin_amdgcn_rcpf(ex); qe[e] = qf[e] * ex; ke[e] = kf[e] * inv; kn[e] = ke[e] * dc[e]; }
                v4u wq, wk; wq.x = cvtpk(qe[0], qe[1]); wq.y = cvtpk(qe[2], qe[3]); wq.z = cvtpk(qe[4], qe[5]); wq.w = cvtpk(qe[6], qe[7]);
                wk.x = cvtpk(ke[0], ke[1]); wk.y = cvtpk(ke[2], ke[3]); wk.z = cvtpk(ke[4], ke[5]); wk.w = cvtpk(ke[6], ke[7]);
                *(LAS v4u*)(Qe + p * 272 + 16 * c8) = wq; *(LAS v4u*)(Ke + p * 272 + 16 * c8) = wk;
#pragma unroll
                for (int e = 0; e < 8; e += 2) { const unsigned pk = cvtpk(kn[e], kn[e + 1]);
                    *(LAS unsigned short*)(KT + (8 * c8 + e) * 144 + pcol) = (unsigned short)(pk & 0xffffu); *(LAS unsigned short*)(KT + (8 * c8 + e + 1) * 144 + pcol) = (unsigned short)(pk >> 16); }
                const unsigned vv[4] = {rv[i].x, rv[i].y, rv[i].z, rv[i].w};
#pragma unroll
                for (int e = 0; e < 4; ++e) { *(LAS unsigned short*)(VT + (8 * c8 + 2 * e) * 144 + pcol) = (unsigned short)(vv[e] & 0xffffu); *(LAS unsigned short*)(VT + (8 * c8 + 2 * e + 1) * 144 + pcol) = (unsigned short)(vv[e] >> 16); }
                asm volatile("" ::: "memory");
            }
            GLA_ZSTORE();
            if (n + 2 < NCHUNK) GLA_LOADZ(n + 2);
            if (n + 1 < NCHUNK) GLA_LOAD(n + 1);
            __syncthreads();
            if (wi == 0 && n + 1 < NCHUNK) GLA_GATEB();
            __builtin_amdgcn_s_setprio(1);
            f32x16 oT;
#pragma unroll
            for (int e = 0; e < 16; ++e) oT[e] = 0.f;
            const LAS unsigned char* qrow = Qe + (32 * wi + r) * 272;
            const LAS unsigned char* vrow = VT + (32 * wv + r) * 144;
            {
                f32x16 at0;
#pragma unroll
                for (int e = 0; e < 16; ++e) at0[e] = 0.f;
#pragma unroll
                for (int hb = 0; hb < 2; ++hb) {
                    bf16x8 bq[4], ka[4];
#pragma unroll
                    for (int t = 0; t < 4; ++t) { bq[t] = *(const LAS bf16x8*)(qrow + 32 * (4 * hb + t) + 16 * h); ka[t] = *(const LAS bf16x8*)(Ke + r * 272 + 32 * (4 * hb + t) + 16 * h); }
                    asm volatile("" ::: "memory");
#pragma unroll
                    for (int t = 0; t < 4; ++t) at0 = MFMA32(ka[t], bq[t], at0);
                }
#pragma unroll
                for (int dkt = 0; dkt < 4; ++dkt) {
                    v4u qq[2];
#pragma unroll
                    for (int s2 = 0; s2 < 2; ++s2) { const v2u q0 = *(const LAS v2u*)(qrow + 64 * dkt + 32 * s2 + 8 * h), q1 = *(const LAS v2u*)(qrow + 64 * dkt + 32 * s2 + 8 * h + 16); qq[s2] = (v4u){q0.x, q0.y, q1.x, q1.y}; }
                    asm volatile("" ::: "memory");
#pragma unroll
                    for (int s2 = 0; s2 < 2; ++s2) oT = MFMA32(pack_step(S[dkt], s2), __builtin_bit_cast(bf16x8, qq[s2]), oT);
                }
                const int lim = 32 * wi + r - 4 * h;
                {
                    v4u va[2];
#pragma unroll
                    for (int t = 0; t < 2; ++t) { const v2u v0 = *(const LAS v2u*)(vrow + (((2 * t) ^ ((4 * wv + (r >> 3)) & 7)) << 4) + 8 * h), v1 = *(const LAS v2u*)(vrow + (((2 * t + 1) ^ ((4 * wv + (r >> 3)) & 7)) << 4) + 8 * h); va[t] = (v4u){v0.x, v0.y, v1.x, v1.y}; }
#pragma unroll
                    for (int e = 0; e < 16; ++e) at0[e] = (((e & 3) + 8 * (e >> 2)) > lim) ? 0.f : at0[e];
#pragma unroll
                    for (int s2 = 0; s2 < 2; ++s2) oT = MFMA32(__builtin_bit_cast(bf16x8, va[s2]), pack_step(at0, s2), oT);
                }
                if (wi) {
                    f32x16 at1;
#pragma unroll
                    for (int e = 0; e < 16; ++e) at1[e] = 0.f;
#pragma unroll
                    for (int hb = 0; hb < 2; ++hb) {
                        bf16x8 bq[4], ka[4];
#pragma unroll
                        for (int t = 0; t < 4; ++t) { bq[t] = *(const LAS bf16x8*)(qrow + 32 * (4 * hb + t) + 16 * h); ka[t] = *(const LAS bf16x8*)(Ke + (32 + r) * 272 + 32 * (4 * hb + t) + 16 * h); }
                        asm volatile("" ::: "memory");
#pragma unroll
                        for (int t = 0; t < 4; ++t) at1 = MFMA32(ka[t], bq[t], at1);
                    }
                    v4u va[2];
#pragma unroll
                    for (int t = 0; t < 2; ++t) { const v2u v0 = *(const LAS v2u*)(vrow + (((4 + 2 * t) ^ ((4 * wv + (r >> 3)) & 7)) << 4) + 8 * h), v1 = *(const LAS v2u*)(vrow + (((4 + 2 * t + 1) ^ ((4 * wv + (r >> 3)) & 7)) << 4) + 8 * h); va[t] = (v4u){v0.x, v0.y, v1.x, v1.y}; }
#pragma unroll
                    for (int e = 0; e < 16; ++e) at1[e] = ((32 + (e & 3) + 8 * (e >> 2)) > lim) ? 0.f : at1[e];
#pragma unroll
                    for (int s2 = 0; s2 < 2; ++s2) oT = MFMA32(__builtin_bit_cast(bf16x8, va[s2]), pack_step(at1, s2), oT);
                }
            }
            {
                bf16x8 vt[4];
#pragma unroll
                for (int t = 0; t < 4; ++t) vt[t] = *(const LAS bf16x8*)(vrow + (((2 * t + h) ^ ((4 * wv + (r >> 3)) & 7)) << 4));
#pragma unroll
                for (int dkt = 0; dkt < 4; ++dkt) {
                    bf16x8 kt[4]; f32x4 dd[4];
#pragma unroll
                    for (int t = 0; t < 4; ++t) { kt[t] = *(const LAS bf16x8*)(KT + (32 * dkt + r) * 144 + (((2 * t + h) ^ ((4 * dkt + (r >> 3)) & 7)) << 4)); dd[t] = *(const LAS f32x4*)(Dec + 32 * dkt + 8 * t + 4 * h); }
                    asm volatile("" ::: "memory");
#pragma unroll
                    for (int g4 = 0; g4 < 4; ++g4)
#pragma unroll
                        for (int e = 0; e < 4; ++e) S[dkt][4 * g4 + e] *= dd[g4][e];
#pragma unroll
                    for (int t = 0; t < 4; ++t) S[dkt] = MFMA32(kt[t], vt[t], S[dkt]);
                }
            }
            __builtin_amdgcn_s_setprio(0);
            if (wi == 1 && n + 1 < NCHUNK) GLA_GATEB();
            { const size_t row = (size_t)gla_row(n, 32 * wi + r, b, dir); bf16* op = O + row * 1024 + hh * 256 + vh * 128 + 32 * wv + 4 * h;
#pragma unroll
              for (int g4 = 0; g4 < 4; ++g4) { v2u w2; w2.x = cvtpk(oT[4 * g4], oT[4 * g4 + 1]); w2.y = cvtpk(oT[4 * g4 + 2], oT[4 * g4 + 3]); *(v2u*)(op + 8 * g4) = w2; } }
        }
#undef GLA_LOAD
#undef GLA_LOADZ
#undef GLA_ZSTORE
#undef GLA_GATEB
    }
}

#define KA() const P __attribute__((address_space(4)))* ka_ = (const P __attribute__((address_space(4)))*)__builtin_amdgcn_kernarg_segment_ptr(); asm volatile("" : "+s"(ka_)); unsigned char* ws = ka_->ws; float* xl = ka_->out; (void)xl; (void)ws;
constexpr size_t WS_BAR = 512 * 1024;
constexpr int LDS_ST = 131072;
constexpr int LDS_XCH = 131072 + 1024;
#define XB_TMO      128
#define XB_XCNT(j)  (256  + 64 * (j))
#define XB_XSUB(j)  (1280 + 64 * (j))
#define XB_XGEN(j)  (2304 + 64 * (j))
#define XB_TOP      3328
#define XB_TOPGEN   3392
#define XCD_BAR_WORDS 3456
#define XB_SPIN_CAP (1u << 22)
__device__ __forceinline__ unsigned xb_ld(unsigned* p)              { return __hip_atomic_load(p, __ATOMIC_RELAXED, __HIP_MEMORY_SCOPE_AGENT); }
__device__ __forceinline__ unsigned xb_add(unsigned* p, unsigned v) { return __hip_atomic_fetch_add(p, v, __ATOMIC_RELAXED, __HIP_MEMORY_SCOPE_AGENT); }
__device__ __forceinline__ unsigned xb_xcc_id() { return (unsigned)__builtin_amdgcn_s_getreg((3 << 11) | 20) & 0xFu; }
#define XB_SPIN(cond, bar) do { unsigned _sp = 0; while (cond) { __builtin_amdgcn_s_sleep(1); \
    if ((++_sp & 255u) == 0u) { if (xb_ld(&(bar)[XB_TMO])) break; if (_sp > XB_SPIN_CAP) { atomicAdd(&(bar)[XB_TMO], 1u); break; } } } } while (0)
__device__ __forceinline__ void xcd_barrier_complete(unsigned* bar, unsigned x, unsigned& nloc, unsigned& nx) {
    const unsigned G = gridDim.x * gridDim.y * gridDim.z;
    unsigned sum, cnt, mine, sp = 0u;
    for (;;) {
        sum = 0u; cnt = 0u; mine = 0u;
#pragma unroll
        for (unsigned j = 0; j < 16; ++j) { const unsigned c = xb_ld(&bar[XB_XCNT(j)]); sum += c; cnt += (c > 0u) ? 1u : 0u; mine = (j == x) ? c : mine; }
        if (sum == G) break;
        __builtin_amdgcn_s_sleep(1);
        if ((++sp & 255u) == 0u) { if (xb_ld(&bar[XB_TMO])) break; if (sp > XB_SPIN_CAP) { atomicAdd(&bar[XB_TMO], 1u); break; } }
    }
    nloc = mine > 0u ? mine : 1u; nx = cnt > 0u ? cnt : 1u;
}
__device__ __forceinline__ void grid_barrier(unsigned char* wsb, LAS unsigned char* lds, const int wave_s) {
    asm volatile("s_waitcnt vmcnt(0)" ::: "memory");
    __syncthreads();
    if (wave_s == 0 && lane_id_v() == 0) {
        unsigned* bar = (unsigned*)(wsb + WS_BAR);
        volatile LAS unsigned* st = (volatile LAS unsigned*)(lds + LDS_ST);
        const unsigned x = xb_xcc_id();
        __builtin_amdgcn_s_waitcnt(0);
        unsigned nloc = st[0], nx = st[1];
        if (nloc == 0u) { xcd_barrier_complete(bar, x, nloc, nx); st[0] = nloc; st[1] = nx; }
        const unsigned old = xb_add(&bar[XB_XSUB(x)], 1u);
        const unsigned gen = old / nloc;
        if (old + 1u == (gen + 1u) * nloc) {
            __builtin_amdgcn_fence(__ATOMIC_RELEASE, "agent");
            asm volatile("s_waitcnt vmcnt(0)" ::: "memory");
            const unsigned og = xb_add(&bar[XB_TOP], 1u);
            const unsigned tg = og / nx;
            if (og + 1u == (tg + 1u) * nx) xb_add(&bar[XB_TOPGEN], 1u);
            else XB_SPIN(xb_ld(&bar[XB_TOPGEN]) == tg, bar);
            __builtin_amdgcn_fence(__ATOMIC_ACQUIRE, "agent");
            xb_add(&bar[XB_XGEN(x)], 1u);
            asm volatile("s_waitcnt vmcnt(0)" ::: "memory");
        } else {
            XB_SPIN(xb_ld(&bar[XB_XGEN(x)]) == gen, bar);
            __builtin_amdgcn_fence(__ATOMIC_ACQUIRE, "agent");
            asm volatile("s_waitcnt vmcnt(0)" ::: "memory");
        }
    }
    __syncthreads();
}
#define GSYNC() do { KA(); grid_barrier(ws, lds, wave_s); } while (0)
#define x_in (ka_->in[0])
#define c_in (ka_->in[1])
#define ctx_in (ka_->in[2])
#define cctx_in (ka_->in[3])
#define w_mod (ka_->in[4])
#define b_mod (ka_->in[5])
#define w_in (ka_->in[6])
#define w_gate_f (ka_->in[7])
#define b_gate_f (ka_->in[8])
#define w_gate_b (ka_->in[9])
#define b_gate_b (ka_->in[10])
#define gla_norm_w (ka_->in[11])
#define w_pool (ka_->in[12])
#define pool_scale (ka_->in[13])
#define w_br_pool (ka_->in[14])
#define w_br_gla (ka_->in[15])
#define w_out (ka_->in[16])
#define ln1_w (ka_->in[17])
#define ln1_b (ka_->in[18])
#define w_up (ka_->in[19])
#define conv_w (ka_->in[20])
#define conv_b (ka_->in[21])
#define w_down (ka_->in[22])
#define ln2_w (ka_->in[23])
#define ln2_b (ka_->in[24])
#define POS ((float*)(ws + WS_POS))
#define MOD ((float*)(ws + WS_MOD))
#define W1T ((bf16*)(ws + WS_W1T))
#define W2T ((bf16*)(ws + WS_W2T))
#define WPT ((bf16*)(ws + WS_WPT))
#define WGT ((bf16*)(ws + WS_WGT))
#define WOT ((bf16*)(ws + WS_WOT))
#define WUT ((bf16*)(ws + WS_WUT))
#define WDT ((bf16*)(ws + WS_WDT))
#define xc ((float*)(ws + WS_XC))
#define UX ((bf16*)(ws + WS_UX))
#define Qb ((bf16*)(ws + WS_R + R_Q))
#define Kb ((bf16*)(ws + WS_R + R_K))
#define Vb ((bf16*)(ws + WS_R + R_V))
#define OFb ((bf16*)(ws + WS_R + R_OF))
#define OBb ((bf16*)(ws + WS_R + R_OB))
#define Zb ((bf16*)(ws + WS_R + R_Z))
#define POOLb ((bf16*)(ws + WS_R + R_POOL))
#define GPb ((bf16*)(ws + WS_R + R_GP))
#define GGb ((bf16*)(ws + WS_R + R_GG))
#define POOLEDb ((bf16*)(ws + WS_R + R_POOLED))
#define HIDb ((bf16*)(ws + WS_R + R_HID))
#define STATS ((float*)(ws + WS_STATS))
#define FRESH() KA(); const int lane = lane_id_v(), wave = wave_s, tid = wave * 64 + lane, gw = blockIdx.x * 8 + wave, gt = blockIdx.x * NTHREADS + tid; (void)lane; (void)gw; (void)gt; (void)wave;
template <int l> __device__ __forceinline__ void layer_body(LAS unsigned char* lds, const int wave_s) {
    const int G = gridDim.x, NGW = G * 8, NGT = G * NTHREADS; (void)NGW; (void)NGT;
        const bool last = (l == DEPTH - 1);
        const int nMall = TT / 256, nMpost = last ? TL / 256 : TT / 256, rows_post = nMpost * 256;
        { KA(); EpiA1 E{Qb, Kb, Vb, Zb}; run_gemm(lds, UX, W1T + (size_t)l * N1 * 1024, nMall, N1, 1024, E, wave_s); }
        GSYNC();
        { KA(); gla_phase(lds, Qb, Kb, Vb, Zb, OFb, OBb, w_gate_f + (size_t)l * 16 * 512, b_gate_f + l * 512, w_gate_b + (size_t)l * 16 * 512, b_gate_b + l * 512, wave_s); }
        GSYNC();
        { KA(); EpiA2 E{POOLb, OFb, GPb, GGb, OBb, gla_norm_w + l * 1024, (LAS float*)(lds + LDS_XCH)}; run_gemm<EpiA2, true>(lds, UX, W2T + (size_t)l * N2 * 1024, nMpost, N2, 1024, E, wave_s); }
        GSYNC();
        { FRESH();
        for (int row = gw; row < rows_post; row += NGW) {
            int pos, Ls; if (row < TL) { pos = row & 63; Ls = 64; } else { pos = (row - TL) & 255; Ls = 256; }
            const int hw = 1 << (lane >> 4);
            const int lo = max(pos - hw, 0), hi = min(pos + hw, Ls);
            const bf16* base = POOLb + (size_t)(row - pos) * 512 + 8 * lane;
            float s[8];
#pragma unroll
            for (int e = 0; e < 8; ++e) s[e] = 0.f;
            v4u av[16];
#pragma unroll
            for (int k = 0; k < 16; ++k) { const int p = lo + k; const int pc = p < hi ? p : pos; av[k] = *(const v4u*)(base + (size_t)pc * 512); }
#pragma unroll
            for (int k = 0; k < 16; ++k) { const float vm = (lo + k < hi) ? 1.f : 0.f; const v4u a = av[k];
                s[0] += vm * bflo(a.x); s[1] += vm * bfhi(a.x); s[2] += vm * bflo(a.y); s[3] += vm * bfhi(a.y); s[4] += vm * bflo(a.z); s[5] += vm * bfhi(a.z); s[6] += vm * bflo(a.w); s[7] += vm * bfhi(a.w); }
            const v4u me = *(const v4u*)(base + (size_t)pos * 512); const float inv = 1.0f / (float)(hi - lo);
            v4u w; w.x = cvtpk(s[0] * inv - bflo(me.x), s[1] * inv - bfhi(me.x)); w.y = cvtpk(s[2] * inv - bflo(me.y), s[3] * inv - bfhi(me.y));
            w.z = cvtpk(s[4] * inv - bflo(me.z), s[5] * inv - bfhi(me.z)); w.w = cvtpk(s[6] * inv - bflo(me.w), s[7] * inv - bfhi(me.w));
            *(v4u*)(POOLEDb + (size_t)row * 512 + 8 * lane) = w;
        } }
        GSYNC();
        { KA(); EpiMul E{GPb}; run_gemm(lds, POOLEDb, WPT + (size_t)l * 1024 * 512, nMpost, 1024, 512, E, wave_s); }
        GSYNC();
        { KA(); EpiMulAdd E{GGb, GPb}; run_gemm(lds, OFb, WGT + (size_t)l * 1024 * 1024, nMpost, 1024, 1024, E, wave_s); }
        GSYNC();
        { KA(); EpiRes E{xl, xc, MOD + (size_t)l * 17 * 6144 + 2048, 0, STATS, l > 0 ? ln2_w + (l - 1) * 1024 : (const float*)nullptr, l > 0 ? ln2_b + (l - 1) * 1024 : (const float*)nullptr}; run_gemm(lds, GGb, WOT + (size_t)l * 1024 * 1024, nMpost, 1024, 1024, E, wave_s); }
        GSYNC();
        { FRESH(); ln_phase(lane, gw, NGW, rows_post, xl, xc, ln1_w + l * 1024, ln1_b + l * 1024, MOD + (size_t)l * 17 * 6144, 3072, 4096, UX, nullptr, nullptr, nullptr, STATS, false); }
        GSYNC();
        { KA(); EpiUpConv E{HIDb, conv_w + (size_t)l * 3 * FF, conv_b + (size_t)l * FF, (LAS float*)(lds + LDS_XCH)}; run_gemm<EpiUpConv, true>(lds, UX, WUT + (size_t)l * NU * 1024, nMpost, NU, 1024, E, wave_s); }
        GSYNC();
        { KA(); EpiRes E{xl, xc, MOD + (size_t)l * 17 * 6144 + 5120, 0, STATS, ln1_w + l * 1024, ln1_b + l * 1024}; run_gemm(lds, HIDb, WDT + (size_t)l * 1024 * FF, nMpost, 1024, FF, E, wave_s); }
        GSYNC();
        { FRESH(); ln_phase(lane, gw, NGW, rows_post, xl, xc, ln2_w + l * 1024, ln2_b + l * 1024, MOD + (size_t)(last ? l : l + 1) * 17 * 6144, 0, 1024, last ? (bf16*)nullptr : UX, nullptr, nullptr, nullptr, STATS, last); }
        if (!last) GSYNC();
}

__global__ void __launch_bounds__(NTHREADS, 2) fwd_mega(P prm) {
    extern __shared__ __attribute__((aligned(16))) unsigned char lds_raw[];
    LAS unsigned char* lds = (LAS unsigned char*)lds_raw;
    cg::grid_group grid = cg::this_grid();
    const int G = gridDim.x, NGW = G * 8, NGT = G * NTHREADS;
    const int wave_s = __builtin_amdgcn_readfirstlane(threadIdx.x >> 6);
    if (threadIdx.x < 64) ((LAS unsigned*)(lds + LDS_ST))[threadIdx.x] = 0u;
    __syncthreads();
    if (threadIdx.x == 0) (void)xb_add((unsigned*)(prm.ws + WS_BAR) + XB_XCNT(xb_xcc_id()), 1u);
    {
        FRESH();
        LAS float* sc = (LAS float*)lds;
        LAS float* part = (LAS float*)(lds + 69632);
        for (int i = tid; i < 17 * 1024; i += NTHREADS) { const float v = i < 16 * 1024 ? c_in[i] : cctx_in[i - 16 * 1024]; sc[i] = v * sigmoidf_(v); }
        __syncthreads();
        for (int it = blockIdx.x; it < 4 * 96; it += G) {
            const int l = it / 96, j0 = (it % 96) * 64, jl = tid & 63, kp = tid >> 6;
            float acc[17];
#pragma unroll
            for (int bi = 0; bi < 17; ++bi) acc[bi] = 0.f;
            const float* wp = w_mod + (size_t)l * 1024 * 6144 + (size_t)(kp * 128) * 6144 + j0 + jl;
            for (int k0 = 0; k0 < 128; k0 += 16) { float wv_[16];
#pragma unroll
                for (int k = 0; k < 16; ++k) wv_[k] = wp[(size_t)(k0 + k) * 6144];
#pragma unroll
                for (int k = 0; k < 16; ++k) { const int kk = kp * 128 + k0 + k;
#pragma unroll
                    for (int bi = 0; bi < 17; ++bi) acc[bi] += sc[bi * 1024 + kk] * wv_[k]; } }
#pragma unroll
            for (int bi = 0; bi < 17; ++bi) part[(kp * 17 + bi) * 64 + jl] = acc[bi];
            __syncthreads();
            for (int o = tid; o < 17 * 64; o += NTHREADS) { const int bi = o >> 6, j = o & 63; float s = b_mod[l * 6144 + j0 + j];
#pragma unroll
                for (int q = 0; q < 8; ++q) s += part[(q * 17 + bi) * 64 + j];
                MOD[((size_t)l * 17 + bi) * 6144 + j0 + j] = s; }
            __syncthreads();
        }
        for (int i = gt; i < 64 * 512; i += NGT) { const int p = i >> 9, q = i & 511, fi = q & 255;
            const double om = exp(-9.210340371976184 * (double)fi / 256.0); double rev = (double)p * om * 0.15915494309189535; rev -= floor(rev);
            POS[i] = (q < 256) ? __builtin_amdgcn_sinf((float)rev) : __builtin_amdgcn_cosf((float)rev); }
        for (int i = gt; i < 4 * 64 * 1024; i += NGT) { const int n = i & 1023, kg = (i >> 10) & 63, l = i >> 16, g = kg >> 4, c0 = (kg & 15) * 8;
            float acc[8];
#pragma unroll
            for (int e = 0; e < 8; ++e) acc[e] = 0.f;
            const float* wpl = w_pool + ((size_t)(l * 4 + g) * 128 + c0) * 128; const float* ps = pool_scale + l * 512 + g * 128; const float* wb = w_br_pool + ((size_t)l * 512 + g * 128) * 1024 + n;
            for (int d0 = 0; d0 < 128; d0 += 16) { float t[16];
#pragma unroll
                for (int d = 0; d < 16; ++d) t[d] = wb[(size_t)(d0 + d) * 1024];
#pragma unroll
                for (int d = 0; d < 16; ++d) { const float tt = t[d] * ps[d0 + d];
#pragma unroll
                    for (int e = 0; e < 8; ++e) acc[e] += wpl[e * 128 + d0 + d] * tt; } }
            v4u o; o.x = cvtpk(acc[0], acc[1]); o.y = cvtpk(acc[2], acc[3]); o.z = cvtpk(acc[4], acc[5]); o.w = cvtpk(acc[6], acc[7]);
            *(v4u*)(WPT + ((size_t)l * 1024 + n) * 512 + g * 128 + c0) = o; }
        LAS float* scr = (LAS float*)(lds + wave * 16384);
        for (int it = gw; it < 4 * 8192; it += NGW) {
            const int l = it >> 13; int rr = it & 8191;
            if (rr < 1152) { const int kb = rr / 72, nb = rr % 72, d0 = nb * 32; const int s0 = d0 < 2048 ? 512 + d0 : (d0 < 2080 ? 3584 + (d0 - 2048) : -1);
                transpose_block(w_in + (size_t)l * 1024 * NIN, NIN, s0, kb * 64, W1T + (size_t)l * N1 * 1024, 1024, d0, scr, lane); continue; } rr -= 1152;
            if (rr < 1792) { const int kb = rr / 112, nb = rr % 112, d0 = nb * 32; const int s0 = d0 < 512 ? d0 : (d0 < 1536 ? 2560 + (d0 - 512) : 3616 + (d0 - 1536));
                transpose_block(w_in + (size_t)l * 1024 * NIN, NIN, s0, kb * 64, W2T + (size_t)l * N2 * 1024, 1024, d0, scr, lane); continue; } rr -= 1792;
            if (rr < 512) { const int kb = rr / 32, nb = rr % 32; transpose_block(w_br_gla + (size_t)l * 1024 * 1024, 1024, nb * 32, kb * 64, WGT + (size_t)l * 1024 * 1024, 1024, nb * 32, scr, lane); continue; } rr -= 512;
            if (rr < 512) { const int kb = rr / 32, nb = rr % 32; transpose_block(w_out + (size_t)l * 1024 * 1024, 1024, nb * 32, kb * 64, WOT + (size_t)l * 1024 * 1024, 1024, nb * 32, scr, lane); continue; } rr -= 512;
            if (rr < 2816) { const int kb = rr / 176, nb = rr % 176, d0 = nb * 32, pn = d0 >> 8, wq = d0 & 255; const int s0 = wq < 128 ? 128 * pn + wq : FF + 128 * pn + (wq - 128);
                transpose_block(w_up + (size_t)l * 1024 * NU, NU, s0, kb * 64, WUT + (size_t)l * NU * 1024, 1024, d0, scr, lane); continue; } rr -= 2816;
            { const int kb = rr / 32, nb = rr % 32; transpose_block(w_down + (size_t)l * FF * 1024, 1024, nb * 32, kb * 64, WDT + (size_t)l * 1024 * FF, FF, nb * 32, scr, lane); }
        }
    }
    grid.sync();
    { FRESH(); ln_phase(lane, gw, NGW, TT, xl, xc, nullptr, nullptr, MOD, 0, 1024, UX, x_in, ctx_in, POS, STATS, false); }
    GSYNC();

    layer_body<0>(lds, wave_s); layer_body<1>(lds, wave_s); layer_body<2>(lds, wave_s); layer_body<3>(lds, wave_s);
}

extern "C" void kernel_launch(void* const* d_in, const int* in_sizes, int n_in, void* d_out, int out_size, void* d_ws, size_t ws_size, hipStream_t stream) {
    static int grid = 0;
    if (grid == 0) {
        if (n_in != 25 || out_size != TL * DM || ws_size < WS_END) { fprintf(stderr, "kernel_launch: unexpected shapes (n_in %d out %d ws %zu need %zu)\n", n_in, out_size, ws_size, (size_t)WS_END); grid = -1; return; }
        int dev = 0, cus = 0, per_cu = 0;
        if (hipGetDevice(&dev) != hipSuccess || hipDeviceGetAttribute(&cus, hipDeviceAttributeMultiprocessorCount, dev) != hipSuccess) { grid = -1; return; }
        if (hipFuncSetAttribute((const void*)fwd_mega, hipFuncAttributeMaxDynamicSharedMemorySize, LDS_BYTES) != hipSuccess) { fprintf(stderr, "hipFuncSetAttribute failed\n"); grid = -1; return; }
        if (hipOccupancyMaxActiveBlocksPerMultiprocessor(&per_cu, (const void*)fwd_mega, NTHREADS, LDS_BYTES) != hipSuccess || per_cu < 1) { fprintf(stderr, "occupancy query: %d\n", per_cu); per_cu = 1; }
        (void)hipGetLastError();
        grid = cus;
    }
    if (grid < 0) return;
    if (hipMemsetAsync((char*)d_ws + WS_BAR, 0, 16384, stream) != hipSuccess) { fprintf(stderr, "memset failed\n"); return; }
    P prm{};
    for (int i = 0; i < 25; ++i) prm.in[i] = (const float*)d_in[i];
    prm.out = (float*)d_out; prm.ws = (unsigned char*)d_ws;
    void* args[] = {&prm};
    hipError_t e = hipLaunchCooperativeKernel((const void*)fwd_mega, dim3(grid), dim3(NTHREADS), args, LDS_BYTES, stream);
    if (e != hipSuccess) fprintf(stderr, "cooperative launch failed: %s\n", hipGetErrorString(e));
}
```

```cpp
#include <hip/hip_runtime.h>
#include <hip/hip_cooperative_groups.h>
#include <cstdio>
#include <cstdint>
namespace cg = cooperative_groups;
namespace pg8 {
#define PG8_LAS __attribute__((address_space(3)))
typedef unsigned short bf16_t;
typedef short bf16x8 __attribute__((ext_vector_type(8)));
typedef float f32x4 __attribute__((ext_vector_type(4)));
typedef unsigned u32x4 __attribute__((ext_vector_type(4)));
constexpr int BM = 256, BK = 64, HALF = 128, HTB = HALF * BK * 2  , STAGE_BYTES = 8 * HTB, NXCD = 8, WGM = 4;

__host__ __device__ __forceinline__ int lds_byte(int r, int c) { const int st = (r >> 4) * 2 + (c >> 5), rr = r & 15, cc = c & 31, ob = rr * 64 + cc * 2; return st * 1024 + (ob ^ (((ob >> 9) & 1) << 5)); }
__host__ __device__ __forceinline__ void stage_rc(int b, int& R, int& C) { const int st = b / 1024, sb = b % 1024, swz = sb ^ (((sb >> 9) & 1) << 5); R = (st >> 1) * 16 + swz / 64; C = (st & 1) * 32 + (swz % 64) / 2; }
__host__ __device__ __forceinline__ int perm32(int rho) { const int n = rho >> 4, i = rho & 15; return 8 * (i >> 2) + 4 * n + (i & 3); }

struct Unit { int pm, pn; };
struct Gemm { const bf16_t* A; const bf16_t* Bt; int M, N, K; };

struct StaticOrder {
    int nM, nN, nwg, G, c;
    __host__ __device__ void init(int M, int N, int G_, int c_) { nM = M / BM; nN = N / BM; nwg = nM * nN; G = G_; c = c_; }
    __host__ __device__ bool next(int i, Unit& u) const {
        const long L = (long)i * G + c; if (L >= nwg) return false;
        int wgid = (int)L; { const int q = nwg / NXCD, r = nwg % NXCD, xcd = wgid % NXCD, off = wgid / NXCD; wgid = (xcd < r ? xcd * (q + 1) : r * (q + 1) + (xcd - r) * q) + off; }
        const int nig = WGM * nN, gid = wgid / nig, fm = gid * WGM, gsz = (nM - fm) < WGM ? (nM - fm) : WGM;
        u.pm = fm + ((wgid % nig) % gsz); u.pn = (wgid % nig) / gsz; return true;
    }
    __device__ __forceinline__ void a_ready(const Unit&) const {}
    __device__ __forceinline__ void done(const Unit&) const {}
};

template <class Epi, class Sched, bool ALIGN_EPI = false, bool SP2 = false>
__device__ __forceinline__ void gemm_phase(PG8_LAS unsigned char* lds, const Gemm g, const Sched& S, const Epi& E, const int wave_s) {
    int lane_; asm volatile("v_mbcnt_lo_u32_b32 %0, -1, 0\n\tv_mbcnt_hi_u32_b32 %0, -1, %0" : "=v"(lane_)); const int lane = lane_, wid = wave_s, tid = wid * 64 + lane, wr = wid >> 2, wc = wid & 3, fr = lane & 15, fq = lane >> 4;
    const int K = g.K, nt = K / BK;
    unsigned voffA[2], voffB[2];
#pragma unroll
    for (int i = 0; i < 2; ++i) { int R, C; stage_rc(tid * 16 + i * 8192, R, C); const int Rb = Epi::PERM ? ((R & ~31) + perm32(R & 31)) : R;
        voffA[i] = (unsigned)(R * K + C) * 2u; voffB[i] = (unsigned)(Rb * K + C) * 2u; }
    const size_t kstep = (size_t)(BK * 2);
    const size_t hstep = (size_t)HALF * K * 2;
    const size_t tstep = 2 * hstep;
    const unsigned ldsw = (unsigned)wid * 1024u;
    const int aoff = lds_byte(wr * 64 + fr, fq * 8), boff = lds_byte(wc * 32 + fr, fq * 8);
#define PG8_SA(b, h) (((b) * 2 + (h)) * HTB)
#define PG8_SB(b, h) ((4 + (b) * 2 + (h)) * HTB)
#define PG8_STAGE(bufoff, gbase, voff) do { _Pragma("unroll") for (int _i = 0; _i < 2; ++_i) \
        __builtin_amdgcn_global_load_lds((const unsigned*)((const char*)(gbase) + (voff)[_i]), (PG8_LAS unsigned*)(lds + (bufoff) + ldsw + _i * 8192), 16, 0, 0); } while (0)
#define PG8_LDA(dst, b, h) do { _Pragma("unroll") for (int m = 0; m < 4; ++m) _Pragma("unroll") for (int k = 0; k < 2; ++k) dst[m][k] = *(const PG8_LAS bf16x8*)(lds + PG8_SA(b, h) + aoff + m * 2048 + k * 1024); } while (0)
#define PG8_LDB(dst, b, h) do { _Pragma("unroll") for (int n = 0; n < 2; ++n) _Pragma("unroll") for (int k = 0; k < 2; ++k) dst[n][k] = *(const PG8_LAS bf16x8*)(lds + PG8_SB(b, h) + boff + n * 2048 + k * 1024); } while (0)
#define PG8_MMA(ai, bj, At, Bt) do { __builtin_amdgcn_s_setprio(1); _Pragma("unroll") for (int m = 0; m < 4; ++m) _Pragma("unroll") for (int n = 0; n < 2; ++n) _Pragma("unroll") for (int k = 0; k < 2; ++k) \
        acc[ai][bj][m][n] = __builtin_amdgcn_mfma_f32_16x16x32_bf16(Bt[n][k], At[m][k], acc[ai][bj][m][n], 0, 0, 0); __builtin_amdgcn_s_setprio(0); } while (0)
#define PG8_WAIT_V(n) asm volatile("s_waitcnt vmcnt(" #n ")" ::: "memory")
#define PG8_WAIT_L(n) asm volatile("s_waitcnt lgkmcnt(" #n ")" ::: "memory")
#define PG8_BAR __builtin_amdgcn_s_barrier()
#define PG8_SCHED __builtin_amdgcn_sched_barrier(0)
    Unit cur, nxt; int ui = 0;
    if (!S.next(0, cur)) return;
    f32x4 acc[2][2][4][2];
#pragma unroll
    for (int a = 0; a < 2; ++a)
#pragma unroll
        for (int b = 0; b < 2; ++b)
#pragma unroll
            for (int m = 0; m < 4; ++m)
#pragma unroll
                for (int n = 0; n < 2; ++n) acc[a][b][m][n] = (f32x4){0.f, 0.f, 0.f, 0.f};
    bf16x8 At[4][2], B0[2][2], B1[2][2];
    const char* cA = (const char*)g.A + (size_t)cur.pm * tstep; const char* cB = (const char*)g.Bt + (size_t)cur.pn * tstep;
    S.a_ready(cur);
    if constexpr (SP2) {
        PG8_STAGE(PG8_SB(0, 0), cB, voffB); PG8_STAGE(PG8_SB(0, 1), cB + hstep, voffB); PG8_STAGE(PG8_SA(0, 0), cA, voffA); PG8_STAGE(PG8_SA(0, 1), cA + hstep, voffA);
        if (wr == 1) PG8_BAR;
        PG8_WAIT_V(2); PG8_BAR;
        PG8_STAGE(PG8_SB(1, 0), cB + kstep, voffB); PG8_STAGE(PG8_SA(1, 0), cA + kstep, voffA); PG8_STAGE(PG8_SB(1, 1), cB + hstep + kstep, voffB);
        PG8_WAIT_V(6); PG8_BAR;
    } else {
        PG8_STAGE(PG8_SB(0, 0), cB, voffB); PG8_STAGE(PG8_SA(0, 0), cA, voffA); PG8_STAGE(PG8_SB(0, 1), cB + hstep, voffB); PG8_STAGE(PG8_SA(0, 1), cA + hstep, voffA);
        if (wr == 1) PG8_BAR;
        PG8_WAIT_V(4); PG8_BAR;
        PG8_STAGE(PG8_SB(1, 0), cB + kstep, voffB); PG8_STAGE(PG8_SA(1, 0), cA + kstep, voffA); PG8_STAGE(PG8_SB(1, 1), cB + hstep + kstep, voffB);
        PG8_WAIT_V(6); PG8_BAR;
    }
    for (;;) {
        const bool has_next = S.next(ui + 1, nxt);
        const char* nA = has_next ? (const char*)g.A + (size_t)nxt.pm * tstep : cA; const char* nB = has_next ? (const char*)g.Bt + (size_t)nxt.pn * tstep : cB;
        for (int t = 0; t < nt; t += 2) {
            const bool last = (t == nt - 2);
            const char* a1 = cA + (size_t)(t + 1) * kstep;
            const char* a2 = last ? nA : cA + (size_t)(t + 2) * kstep; const char* b2 = last ? nB : cB + (size_t)(t + 2) * kstep;
            const char* a3 = a2 + kstep; const char* b3 = b2 + kstep;
            if (last && has_next) S.a_ready(nxt);
            if constexpr (SP2) {
            PG8_LDB(B0, 0, 0); PG8_LDB(B1, 0, 1); PG8_SCHED; PG8_LDA(At, 0, 0); PG8_STAGE(PG8_SA(1, 1), a1 + hstep, voffA);
            PG8_WAIT_V(8); PG8_WAIT_L(0); PG8_BAR; PG8_MMA(0, 0, At, B0); PG8_MMA(0, 1, At, B1); PG8_BAR; PG8_SCHED;
            PG8_LDA(At, 0, 1); PG8_STAGE(PG8_SB(0, 0), b2, voffB); PG8_STAGE(PG8_SB(0, 1), b2 + hstep, voffB); PG8_STAGE(PG8_SA(0, 0), a2, voffA);
            PG8_WAIT_V(8); PG8_WAIT_L(0); PG8_BAR; PG8_MMA(1, 0, At, B0); PG8_MMA(1, 1, At, B1); PG8_BAR; PG8_SCHED;
            PG8_LDB(B0, 1, 0); PG8_LDB(B1, 1, 1); PG8_SCHED; PG8_LDA(At, 1, 0); PG8_STAGE(PG8_SA(0, 1), a2 + hstep, voffA);
            PG8_WAIT_V(8); PG8_WAIT_L(0); PG8_BAR; PG8_MMA(0, 0, At, B0); PG8_MMA(0, 1, At, B1); PG8_BAR; PG8_SCHED;
            PG8_LDA(At, 1, 1); PG8_STAGE(PG8_SB(1, 0), b3, voffB); PG8_STAGE(PG8_SB(1, 1), b3 + hstep, voffB); PG8_STAGE(PG8_SA(1, 0), a3, voffA);
            PG8_WAIT_V(8); PG8_WAIT_L(0); PG8_BAR; PG8_MMA(1, 0, At, B0); PG8_MMA(1, 1, At, B1); PG8_BAR; PG8_SCHED;
            } else {
            PG8_LDB(B0, 0, 0); PG8_SCHED; PG8_LDA(At, 0, 0); PG8_STAGE(PG8_SA(1, 1), a1 + hstep, voffA);
            PG8_WAIT_L(8); PG8_BAR; PG8_WAIT_L(0); PG8_MMA(0, 0, At, B0); PG8_BAR; PG8_SCHED;
            PG8_LDB(B1, 0, 1); PG8_STAGE(PG8_SB(0, 0), b2, voffB);
            PG8_BAR; PG8_WAIT_L(0); PG8_MMA(0, 1, At, B1); PG8_BAR;
            PG8_LDA(At, 0, 1); PG8_STAGE(PG8_SA(0, 0), a2, voffA);
            PG8_BAR; PG8_WAIT_L(0); PG8_MMA(1, 0, At, B0); PG8_BAR; PG8_SCHED;
            PG8_STAGE(PG8_SB(0, 1), b2 + hstep, voffB);
            PG8_WAIT_V(6); PG8_BAR; PG8_MMA(1, 1, At, B1); PG8_BAR;
            PG8_LDB(B0, 1, 0); PG8_SCHED; PG8_LDA(At, 1, 0); PG8_STAGE(PG8_SA(0, 1), a2 + hstep, voffA);
            PG8_WAIT_L(8); PG8_BAR; PG8_WAIT_L(0); PG8_MMA(0, 0, At, B0); PG8_BAR; PG8_SCHED;
            PG8_LDB(B1, 1, 1); PG8_STAGE(PG8_SB(1, 0), b3, voffB);
            PG8_BAR; PG8_WAIT_L(0); PG8_MMA(0, 1, At, B1); PG8_BAR;
            PG8_LDA(At, 1, 1); PG8_STAGE(PG8_SA(1, 0), a3, voffA);
            PG8_BAR; PG8_WAIT_L(0); PG8_MMA(1, 0, At, B0); PG8_BAR; PG8_SCHED;
            PG8_STAGE(PG8_SB(1, 1), b3 + hstep, voffB);
            PG8_WAIT_V(6); PG8_BAR; PG8_MMA(1, 1, At, B1); PG8_BAR;
            }
        }
        if constexpr (ALIGN_EPI) { if (wr == 0) PG8_BAR; }
        if constexpr (!Epi::AFTER_DRAIN) { E(acc, cur, wr, wc, fr, fq); S.done(cur); }
        if (!has_next) break;
#pragma unroll
        for (int a = 0; a < 2; ++a)
#pragma unroll
            for (int b = 0; b < 2; ++b)
#pragma unroll
                for (int m = 0; m < 4; ++m)
#pragma unroll
                    for (int n = 0; n < 2; ++n) acc[a][b][m][n] = (f32x4){0.f, 0.f, 0.f, 0.f};
        cur = nxt; cA = nA; cB = nB; ++ui;
        if constexpr (ALIGN_EPI) { if (wr == 1) PG8_BAR; }
    }
    PG8_WAIT_V(0);
    if constexpr (!ALIGN_EPI) { if (wr == 0) PG8_BAR; }
    PG8_BAR;
    if constexpr (Epi::AFTER_DRAIN) { E.fused(acc, cur, wr, wc, fr, fq, lds, wid, lane); S.done(cur); }
#undef PG8_SA
#undef PG8_SB
#undef PG8_STAGE
#undef PG8_LDA
#undef PG8_LDB
#undef PG8_MMA
#undef PG8_WAIT_V
#undef PG8_WAIT_L
#undef PG8_BAR
#undef PG8_SCHED
}
}

#define GAS __attribute__((address_space(1)))
#define LAS __attribute__((address_space(3)))
typedef unsigned short bf16;
typedef unsigned v4u __attribute__((ext_vector_type(4)));
typedef unsigned v2u __attribute__((ext_vector_type(2)));
typedef float f32x4 __attribute__((ext_vector_type(4)));
typedef float f32x2 __attribute__((ext_vector_type(2)));
typedef float f32x16 __attribute__((ext_vector_type(16)));
typedef short bf16x8 __attribute__((ext_vector_type(8)));
typedef short s16x4 __attribute__((ext_vector_type(4)));
typedef __bf16 bf16x2_t __attribute__((ext_vector_type(2)));

constexpr int NB = 16, LSEQ = 4096, DM = 1024, DEPTH = 4, CTXL = 256;
constexpr int TL = NB * LSEQ, TC = NB * CTXL, TT = TL + TC;
constexpr int NIN = 5664, FF = 2816, N1 = 2304, N2 = 3584, NU = 5632;
constexpr float LN_EPS = 1e-6f;
constexpr float ALPHA = 1.681792830507429f;
constexpr size_t MiB = (size_t)1 << 20;
constexpr size_t WS_POS = 0, WS_MOD = 1 * MiB, WS_W1T = 3 * MiB, WS_W2T = 21 * MiB, WS_WPT = 49 * MiB, WS_WGT = 53 * MiB, WS_WOT = 61 * MiB,
                 WS_WUT = 69 * MiB, WS_WDT = 113 * MiB, WS_XC = 135 * MiB, WS_UX = 151 * MiB, WS_R = 287 * MiB;
constexpr size_t SU = 68 * MiB;
static_assert((size_t)TT * 512 * 2 == SU, "SU");
constexpr size_t R_Q = 0, R_K = SU, R_V = 2 * SU, R_OF = 4 * SU, R_OB = 6 * SU, R_Z = 8 * SU;
constexpr size_t R_POOL = 0, R_GP = SU, R_GG = 578 * MiB, R_POOLED = 3 * SU;
constexpr size_t R_HID = 0;
constexpr size_t WS_STATS = WS_R + 561 * MiB;
constexpr size_t WS_END = WS_R + 716 * MiB;
static_assert(R_GG >= 8 * SU + 5 * MiB && WS_STATS + MiB <= WS_R + R_GG && R_GG + 2 * SU <= 716 * MiB, "R map");
constexpr int LDS_BYTES = 147456;
constexpr int NTHREADS = 512;

__device__ __forceinline__ unsigned cvtpk(float lo, float hi) { f32x2 v = {lo, hi}; bf16x2_t b = __builtin_convertvector(v, bf16x2_t); return __builtin_bit_cast(unsigned, b); }
__device__ __forceinline__ float bflo(unsigned u) { return __uint_as_float(u << 16); }
__device__ __forceinline__ float bfhi(unsigned u) { return __uint_as_float(u & 0xffff0000u); }
__device__ __forceinline__ float sigmoidf_(float x) { return __builtin_amdgcn_rcpf(1.0f + __expf(-x)); }
__device__ __forceinline__ int lane_id_v() { int l; asm volatile("v_mbcnt_lo_u32_b32 %0, -1, 0\n\tv_mbcnt_hi_u32_b32 %0, -1, %0" : "=v"(l)); return l; }
__device__ __forceinline__ float wave_sum(float v, int lane) {
#pragma unroll
    for (int o = 1; o < 64; o <<= 1) v += __int_as_float(__builtin_amdgcn_ds_bpermute((lane ^ o) << 2, __float_as_int(v)));
    return v;
}
__device__ __forceinline__ float half_sum(float v, int lane) {
#pragma unroll
    for (int o = 1; o < 32; o <<= 1) v += __int_as_float(__builtin_amdgcn_ds_bpermute((lane ^ o) << 2, __float_as_int(v)));
    return v;
}

struct RangeOrder {
    int nM, nN, nwg, G, c;
    __device__ void init(int nM_, int nN_, int G_, int c_) { nM = nM_; nN = nN_; nwg = nM * nN; G = G_; c = c_; }
    __device__ bool next(int i, pg8::Unit& u) const {
        const long L = (long)i * G + c; if (L >= nwg) return false;
        int wgid = (int)L; { const int q = nwg / pg8::NXCD, r = nwg % pg8::NXCD, xcd = wgid % pg8::NXCD, off = wgid / pg8::NXCD; wgid = (xcd < r ? xcd * (q + 1) : r * (q + 1) + (xcd - r) * q) + off; }
        const int nig = pg8::WGM * nN, gid = wgid / nig, fm = gid * pg8::WGM, gsz = (nM - fm) < pg8::WGM ? (nM - fm) : pg8::WGM;
        u.pm = fm + ((wgid % nig) % gsz); u.pn = (wgid % nig) / gsz; return true;
    }
    __device__ __forceinline__ void a_ready(const pg8::Unit&) const {}
    __device__ __forceinline__ void done(const pg8::Unit&) const {}
};

typedef pg8::f32x4 af4;
#define EPI_LOOP for (int ai = 0; ai < 2; ++ai) _Pragma("unroll") for (int m = 0; m < 4; ++m) _Pragma("unroll") for (int bj = 0; bj < 2; ++bj)
#define EPI_RR(base_) int RR = (base_) + ai * 128 + m * 16; asm volatile("" : "+v"(RR));

struct EpiA1 {
    static constexpr bool PERM = true, AFTER_DRAIN = false;
    bf16 *Q, *K, *V, *Z;
    __device__ __forceinline__ void operator()(const af4 (&acc)[2][2][4][2], const pg8::Unit& u, int wr, int wc, int fr_, int fq_) const {
        const int ln_ = lane_id_v(); const int fr = ln_ & 15, fq = ln_ >> 4;
        const int row0 = u.pm * 256 + wr * 64 + fr, pn = u.pn;
        if (pn < 8) {
            bf16* base; int ldc, colt; float sc = 1.f;
            if (pn < 2) { base = Q; ldc = 512; colt = pn * 256; sc = 0.08838834764831845f; }
            else if (pn < 4) { base = K; ldc = 512; colt = (pn - 2) * 256; }
            else { base = V; ldc = 1024; colt = (pn - 4) * 256; }
            const int col0 = colt + wc * 32 + 8 * fq;
#pragma unroll
            EPI_LOOP { EPI_RR(row0) const af4 v0 = acc[ai][bj][m][0] * sc, v1 = acc[ai][bj][m][1] * sc; v4u w; w.x = cvtpk(v0[0], v0[1]); w.y = cvtpk(v0[2], v0[3]); w.z = cvtpk(v1[0], v1[1]); w.w = cvtpk(v1[2], v1[3]);
                *(v4u*)(base + (size_t)RR * ldc + col0 + bj * 128) = w; }
        } else if (wc == 0) {
#pragma unroll
            for (int ai = 0; ai < 2; ++ai)
#pragma unroll
                for (int m = 0; m < 4; ++m) { const af4 v0 = acc[ai][0][m][0], v1 = acc[ai][0][m][1]; v4u w; w.x = cvtpk(v0[0], v0[1]); w.y = cvtpk(v0[2], v0[3]); w.z = cvtpk(v1[0], v1[1]); w.w = cvtpk(v1[2], v1[3]);
                    *(v4u*)(Z + (size_t)(row0 + ai * 128 + m * 16) * 32 + 8 * fq) = w; }
        }
    }
};
struct EpiA2 {
    static constexpr bool PERM = true, AFTER_DRAIN = false;
    bf16 *POOL, *ON, *GP, *GG; const bf16* OBp; const float* nw; LAS float* xch;
    __device__ __forceinline__ void operator()(const af4 (&acc)[2][2][4][2], const pg8::Unit& u, int wr, int wc, int fr_, int fq_) const {
        const int ln_ = lane_id_v(); const int fr = ln_ & 15, fq = ln_ >> 4;
        const int row0 = u.pm * 256 + wr * 64 + fr, pn = u.pn;
        if (pn < 2) {
            const int col0 = pn * 256 + wc * 32 + 8 * fq;
#pragma unroll
            EPI_LOOP { EPI_RR(row0) const af4 v0 = acc[ai][bj][m][0], v1 = acc[ai][bj][m][1]; v4u w; w.x = cvtpk(v0[0], v0[1]); w.y = cvtpk(v0[2], v0[3]); w.z = cvtpk(v1[0], v1[1]); w.w = cvtpk(v1[2], v1[3]);
                *(v4u*)(POOL + (size_t)RR * 512 + col0 + bj * 128) = w; }
        } else if (pn < 6) {
            const int col0 = (pn - 2) * 256 + wc * 32 + 8 * fq;
            float ssq[8];
#pragma unroll
            for (int b_ = 0; b_ < 4; ++b_) {
                const int ai = b_ >> 1, mp = b_ & 1;
                int RRb = row0 + ai * 128 + mp * 32; asm volatile("" : "+v"(RRb));
                const size_t ob = (size_t)RRb * 1024 + col0; v4u of_[2][2], ob_[2][2];
#pragma unroll
                for (int mi = 0; mi < 2; ++mi)
#pragma unroll
                    for (int bj = 0; bj < 2; ++bj) { of_[mi][bj] = *(const v4u*)(ON + ob + mi * 16 * 1024 + bj * 128); ob_[mi][bj] = *(const v4u*)(OBp + ob + mi * 16 * 1024 + bj * 128); }
#pragma unroll
                for (int mi = 0; mi < 2; ++mi) { float q = 0.f;
#pragma unroll
                    for (int bj = 0; bj < 2; ++bj) { const v4u a = of_[mi][bj], c = ob_[mi][bj];
                        const float o0 = bflo(a.x) + bflo(c.x), o1 = bfhi(a.x) + bfhi(c.x), o2 = bflo(a.y) + bflo(c.y), o3 = bfhi(a.y) + bfhi(c.y), o4 = bflo(a.z) + bflo(c.z), o5 = bfhi(a.z) + bfhi(c.z), o6 = bflo(a.w) + bflo(c.w), o7 = bfhi(a.w) + bfhi(c.w);
                        q += (o0 * o0 + o1 * o1) + (o2 * o2 + o3 * o3) + (o4 * o4 + o5 * o5) + (o6 * o6 + o7 * o7); }
                    ssq[ai * 4 + mp * 2 + mi] = q; }
                asm volatile("" ::: "memory");
            }
#pragma unroll
            for (int k = 0; k < 8; ++k) { float v = ssq[k];
                v += __int_as_float(__builtin_amdgcn_ds_bpermute((ln_ ^ 16) << 2, __float_as_int(v)));
                v += __int_as_float(__builtin_amdgcn_ds_bpermute((ln_ ^ 32) << 2, __float_as_int(v))); ssq[k] = v; }
            if (fq == 0) {
#pragma unroll
                for (int k = 0; k < 8; ++k) xch[((k >> 2) * 128 + wr * 64 + (k & 3) * 16 + fr) * 4 + wc] = ssq[k];
            }
            asm volatile("s_waitcnt lgkmcnt(0)" ::: "memory"); __builtin_amdgcn_s_barrier(); asm volatile("" ::: "memory");
            float rs[8];
#pragma unroll
            for (int k = 0; k < 8; ++k) { const f32x4 p4 = *(const LAS f32x4*)(xch + ((k >> 2) * 128 + wr * 64 + (k & 3) * 16 + fr) * 4);
                rs[k] = 1.0f / sqrtf(((p4[0] + p4[1]) + (p4[2] + p4[3])) * (1.f / 256.f) + LN_EPS); }
            f32x4 nwv[2][2];
#pragma unroll
            for (int bj = 0; bj < 2; ++bj) { nwv[bj][0] = *(const f32x4*)(nw + col0 + bj * 128); nwv[bj][1] = *(const f32x4*)(nw + col0 + bj * 128 + 4); }
#pragma unroll
            for (int b_ = 0; b_ < 4; ++b_) {
                const int ai = b_ >> 1, mp = b_ & 1;
                int RRb = row0 + ai * 128 + mp * 32; asm volatile("" : "+v"(RRb));
                const size_t ob = (size_t)RRb * 1024 + col0; v4u of_[2][2], ob_[2][2];
#pragma unroll
                for (int mi = 0; mi < 2; ++mi)
#pragma unroll
                    for (int bj = 0; bj < 2; ++bj) { of_[mi][bj] = *(const v4u*)(ON + ob + mi * 16 * 1024 + bj * 128); ob_[mi][bj] = *(const v4u*)(OBp + ob + mi * 16 * 1024 + bj * 128); }
#pragma unroll
                for (int mi = 0; mi < 2; ++mi) { const float rstd = rs[ai * 4 + mp * 2 + mi];
#pragma unroll
                    for (int bj = 0; bj < 2; ++bj) { af4 v0 = acc[ai][bj][mp * 2 + mi][0], v1 = acc[ai][bj][mp * 2 + mi][1]; asm volatile("" : "+v"(v0), "+v"(v1)); const v4u a = of_[mi][bj], c = ob_[mi][bj];
#pragma unroll
                        for (int e = 0; e < 4; ++e) { v0[e] = v0[e] * sigmoidf_(v0[e]) * (rstd * nwv[bj][0][e]); v1[e] = v1[e] * sigmoidf_(v1[e]) * (rstd * nwv[bj][1][e]); }
                        v4u w; w.x = cvtpk(v0[0] * (bflo(a.x) + bflo(c.x)), v0[1] * (bfhi(a.x) + bfhi(c.x))); w.y = cvtpk(v0[2] * (bflo(a.y) + bflo(c.y)), v0[3] * (bfhi(a.y) + bfhi(c.y)));
                        w.z = cvtpk(v1[0] * (bflo(a.z) + bflo(c.z)), v1[1] * (bfhi(a.z) + bfhi(c.z))); w.w = cvtpk(v1[2] * (bflo(a.w) + bflo(c.w)), v1[3] * (bfhi(a.w) + bfhi(c.w)));
                        *(v4u*)(ON + ob + mi * 16 * 1024 + bj * 128) = w; } }
                asm volatile("" ::: "memory");
            }
        } else {
            bf16* base = pn < 10 ? GP : GG; const int col0 = ((pn - 6) & 3) * 256 + wc * 32 + 8 * fq;
#pragma unroll
            EPI_LOOP { EPI_RR(row0) af4 v0 = acc[ai][bj][m][0], v1 = acc[ai][bj][m][1];
#pragma unroll
                for (int e = 0; e < 4; ++e) { v0[e] = sigmoidf_(v0[e]); v1[e] = sigmoidf_(v1[e]); }
                v4u w; w.x = cvtpk(v0[0], v0[1]); w.y = cvtpk(v0[2], v0[3]); w.z = cvtpk(v1[0], v1[1]); w.w = cvtpk(v1[2], v1[3]);
                *(v4u*)(base + (size_t)RR * 1024 + col0 + bj * 128) = w; asm volatile("" ::: "memory"); }
        }
    }
};
struct EpiMul {
    static constexpr bool PERM = true, AFTER_DRAIN = false;
    bf16* G;
    __device__ __forceinline__ void operator()(const af4 (&acc)[2][2][4][2], const pg8::Unit& u, int wr, int wc, int fr_, int fq_) const {
        const int ln_ = lane_id_v(); const int fr = ln_ & 15, fq = ln_ >> 4;
        const int row0 = u.pm * 256 + wr * 64 + fr, col0 = u.pn * 256 + wc * 32 + 8 * fq;
        v4u o[2][2][2];
#define MUL_LOAD(buf, b_) do { int RRl = row0 + ((b_) >> 1) * 128 + ((b_) & 1) * 32; asm volatile("" : "+v"(RRl)); const bf16* pl = G + (size_t)RRl * 1024 + col0; \
            _Pragma("unroll") for (int mi = 0; mi < 2; ++mi) _Pragma("unroll") for (int bj = 0; bj < 2; ++bj) o[buf][mi][bj] = *(const v4u*)(pl + mi * 16 * 1024 + bj * 128); } while (0)
        MUL_LOAD(0, 0);
#pragma unroll
        for (int b_ = 0; b_ < 4; ++b_) {
            const int ai = b_ >> 1, mp = b_ & 1, cur = b_ & 1;
            if (b_ + 1 < 4) { if (cur == 0) MUL_LOAD(1, b_ + 1); else MUL_LOAD(0, b_ + 1); }
            int RRb = row0 + ai * 128 + mp * 32; asm volatile("" : "+v"(RRb));
            bf16* pb = G + (size_t)RRb * 1024 + col0;
#pragma unroll
            for (int mi = 0; mi < 2; ++mi)
#pragma unroll
                for (int bj = 0; bj < 2; ++bj) { const af4 v0 = acc[ai][bj][mp * 2 + mi][0], v1 = acc[ai][bj][mp * 2 + mi][1]; const v4u oo = o[cur][mi][bj];
                    v4u w; w.x = cvtpk(v0[0] * bflo(oo.x), v0[1] * bfhi(oo.x)); w.y = cvtpk(v0[2] * bflo(oo.y), v0[3] * bfhi(oo.y)); w.z = cvtpk(v1[0] * bflo(oo.z), v1[1] * bfhi(oo.z)); w.w = cvtpk(v1[2] * bflo(oo.w), v1[3] * bfhi(oo.w));
                    *(v4u*)(pb + mi * 16 * 1024 + bj * 128) = w; }
            asm volatile("" ::: "memory");
        }
#undef MUL_LOAD
    }
};
struct EpiMulAdd {
    static constexpr bool PERM = true, AFTER_DRAIN = false;
    bf16* G; const bf16* Y;
    __device__ __forceinline__ void operator()(const af4 (&acc)[2][2][4][2], const pg8::Unit& u, int wr, int wc, int fr_, int fq_) const {
        const int ln_ = lane_id_v(); const int fr = ln_ & 15, fq = ln_ >> 4;
        const int row0 = u.pm * 256 + wr * 64 + fr, col0 = u.pn * 256 + wc * 32 + 8 * fq;
        v4u o[2][2][2], yv[2][2][2];
#define MA_LOAD(buf, b_) do { int RRl = row0 + ((b_) >> 1) * 128 + ((b_) & 1) * 32; asm volatile("" : "+v"(RRl)); const size_t ol = (size_t)RRl * 1024 + col0; \
            _Pragma("unroll") for (int mi = 0; mi < 2; ++mi) _Pragma("unroll") for (int bj = 0; bj < 2; ++bj) { o[buf][mi][bj] = *(const v4u*)(G + ol + mi * 16 * 1024 + bj * 128); yv[buf][mi][bj] = *(const v4u*)(Y + ol + mi * 16 * 1024 + bj * 128); } } while (0)
        MA_LOAD(0, 0);
#pragma unroll
        for (int b_ = 0; b_ < 4; ++b_) {
            const int ai = b_ >> 1, mp = b_ & 1, cur = b_ & 1;
            if (b_ + 1 < 4) { if (cur == 0) MA_LOAD(1, b_ + 1); else MA_LOAD(0, b_ + 1); }
            int RRb = row0 + ai * 128 + mp * 32; asm volatile("" : "+v"(RRb));
            const size_t ob = (size_t)RRb * 1024 + col0;
#pragma unroll
            for (int mi = 0; mi < 2; ++mi)
#pragma unroll
                for (int bj = 0; bj < 2; ++bj) { const af4 v0 = acc[ai][bj][mp * 2 + mi][0], v1 = acc[ai][bj][mp * 2 + mi][1]; const v4u oo = o[cur][mi][bj], y = yv[cur][mi][bj];
                    v4u w; w.x = cvtpk(bflo(y.x) + v0[0] * bflo(oo.x), bfhi(y.x) + v0[1] * bfhi(oo.x)); w.y = cvtpk(bflo(y.y) + v0[2] * bflo(oo.y), bfhi(y.y) + v0[3] * bfhi(oo.y));
                    w.z = cvtpk(bflo(y.z) + v1[0] * bflo(oo.z), bfhi(y.z) + v1[1] * bfhi(oo.z)); w.w = cvtpk(bflo(y.w) + v1[2] * bflo(oo.w), bfhi(y.w) + v1[3] * bfhi(oo.w));
                    *(v4u*)(G + ob + mi * 16 * 1024 + bj * 128) = w; }
            asm volatile("" ::: "memory");
        }
#undef MA_LOAD
    }
};
struct EpiRes {
    static constexpr bool PERM = true, AFTER_DRAIN = false;
    float* xl; float* xc; const float* gate; int rowbase; const float* stats; const float* lnw; const float* lnb;
    __device__ __forceinline__ void operator()(const af4 (&acc)[2][2][4][2], const pg8::Unit& u, int wr, int wc, int fr_, int fq_) const {
        const int ln_ = lane_id_v(); const int fr = ln_ & 15, fq = ln_ >> 4;
        const int grow = rowbase + u.pm * 256; const int bi = grow < TL ? grow / LSEQ : NB;
        float* xb = grow < TL ? xl + (size_t)grow * DM : xc + (size_t)(grow - TL) * DM;
        const float* stb = stats + 2 * (size_t)grow;
        const int col0 = u.pn * 256 + wc * 32 + 8 * fq; const float* gp = gate + (size_t)bi * 6144 + col0;
        f32x4 g[2][2], wa[2][2], ba[2][2];
#pragma unroll
        for (int bj = 0; bj < 2; ++bj)
#pragma unroll
            for (int hf = 0; hf < 2; ++hf) { g[bj][hf] = *(const f32x4*)(gp + bj * 128 + 4 * hf);
                if (lnw) { wa[bj][hf] = *(const f32x4*)(lnw + col0 + bj * 128 + 4 * hf) * ALPHA; ba[bj][hf] = *(const f32x4*)(lnb + col0 + bj * 128 + 4 * hf) * ALPHA; }
                else { wa[bj][hf] = (f32x4){ALPHA, ALPHA, ALPHA, ALPHA}; ba[bj][hf] = (f32x4){0.f, 0.f, 0.f, 0.f}; } }
        const int row0 = wr * 64 + fr;
#pragma unroll
        for (int b_ = 0; b_ < 4; ++b_) {
            const int ai = b_ >> 1, mp = b_ & 1;
            int RRb = row0 + ai * 128 + mp * 32; asm volatile("" : "+v"(RRb));
            float* pb = xb + (size_t)RRb * DM + col0;
            f32x4 xv[2][2][2]; f32x2 st[2];
#pragma unroll
            for (int mi = 0; mi < 2; ++mi) { st[mi] = *(const f32x2*)(stb + 2 * (RRb + mi * 16));
#pragma unroll
                for (int bj = 0; bj < 2; ++bj) { xv[mi][bj][0] = *(const f32x4*)(pb + mi * 16 * DM + bj * 128); xv[mi][bj][1] = *(const f32x4*)(pb + mi * 16 * DM + bj * 128 + 4); } }
#pragma unroll
            for (int mi = 0; mi < 2; ++mi)
#pragma unroll
                for (int bj = 0; bj < 2; ++bj) { f32x4 o0, o1; const float mean = st[mi].x, rstd = st[mi].y;
#pragma unroll
                    for (int e = 0; e < 4; ++e) {
                        o0[e] = (xv[mi][bj][0][e] - mean) * (wa[bj][0][e] * rstd) + (ba[bj][0][e] + g[bj][0][e] * acc[ai][bj][mp * 2 + mi][0][e]);
                        o1[e] = (xv[mi][bj][1][e] - mean) * (wa[bj][1][e] * rstd) + (ba[bj][1][e] + g[bj][1][e] * acc[ai][bj][mp * 2 + mi][1][e]); }
                    *(f32x4*)(pb + mi * 16 * DM + bj * 128) = o0; *(f32x4*)(pb + mi * 16 * DM + bj * 128 + 4) = o1; }
            asm volatile("" ::: "memory");
        }
    }
};
struct EpiUp {
    static constexpr bool PERM = true, AFTER_DRAIN = false;
    bf16* UP;
    __device__ __forceinline__ void operator()(const af4 (&acc)[2][2][4][2], const pg8::Unit& u, int wr, int wc, int fr_, int fq_) const {
        const int ln_ = lane_id_v(); const int fr = ln_ & 15, fq = ln_ >> 4;
        const int row0 = u.pm * 256 + wr * 64 + fr, col0 = u.pn * 256 + wc * 32 + 8 * fq;
#pragma unroll
        EPI_LOOP { EPI_RR(row0) const af4 v0 = acc[ai][bj][m][0], v1 = acc[ai][bj][m][1]; v4u w; w.x = cvtpk(v0[0], v0[1]); w.y = cvtpk(v0[2], v0[3]); w.z = cvtpk(v1[0], v1[1]); w.w = cvtpk(v1[2], v1[3]);
            *(v4u*)(UP + (size_t)RR * NU + col0 + bj * 128) = w; }
    }
};


__device__ __forceinline__ float gelu_erf(float v) {
    const float av = fabsf(v), t = __builtin_amdgcn_rcpf(av * 0.2316418882f + 1.0f);
    float q = t * 0.5307027145f + (-0.7265760135f); q = q * t + 0.7107068705f; q = q * t + (-0.142248368f); q = q * t + 0.127414796f; q = q * t;
    const float e = __builtin_amdgcn_exp2f((v * v) * (-0.72134752044f));
    const float mm = v * (q * e);
    return v < 0.f ? mm : v - mm;
}

__device__ __forceinline__ f32x2 gelu_pk(f32x2 v) {
    const f32x2 av = __builtin_elementwise_abs(v), d = av * 0.2316418882f + 1.0f;
    f32x2 t; t.x = __builtin_amdgcn_rcpf(d.x); t.y = __builtin_amdgcn_rcpf(d.y);
    f32x2 q = t * 0.5307027145f + (-0.7265760135f); q = q * t + 0.7107068705f; q = q * t + (-0.142248368f); q = q * t + 0.127414796f; q = q * t;
    const f32x2 sq = (v * v) * (-0.72134752044f);
    f32x2 e; e.x = __builtin_amdgcn_exp2f(sq.x); e.y = __builtin_amdgcn_exp2f(sq.y);
    const f32x2 mm = v * (q * e), rr = v - mm;
    f32x2 o; o.x = v.x < 0.f ? mm.x : rr.x; o.y = v.y < 0.f ? mm.y : rr.y; return o;
}
#define DPP_ROR1(x) __int_as_float(__builtin_amdgcn_update_dpp(0, __float_as_int(x), 0x121, 0xf, 0xf, false))
#define DPP_ROR15(x) __int_as_float(__builtin_amdgcn_update_dpp(0, __float_as_int(x), 0x12F, 0xf, 0xf, false))
struct EpiUpConv {
    static constexpr bool PERM = true, AFTER_DRAIN = false;
    bf16* HID; const float* cw; const float* cb; LAS float* xch;
    __device__ __forceinline__ void operator()(const af4 (&acc)[2][2][4][2], const pg8::Unit& u, int wr, int wc, int fr_, int fq_) const {
        const int ln_ = lane_id_v(); const int fr = ln_ & 15, fq = ln_ >> 4;
        const int row0 = u.pm * 256 + wr * 64 + fr, jl = 32 * wc + 8 * fq, j0 = 128 * u.pn + jl;
        const bool isctx = u.pm >= TL / 256;
        f32x4 cwv[2][4];
#pragma unroll
        for (int n = 0; n < 2; ++n) { cwv[n][0] = *(const f32x4*)(cw + j0 + 4 * n); cwv[n][1] = *(const f32x4*)(cw + FF + j0 + 4 * n); cwv[n][2] = *(const f32x4*)(cw + 2 * FF + j0 + 4 * n); cwv[n][3] = *(const f32x4*)(cb + j0 + 4 * n); }
        if (isctx) {
#pragma unroll
            for (int ai = 0; ai < 2; ++ai) { const int blk = 2 * ai + wr;
                if (fr == 0) { *(LAS f32x4*)(xch + (blk * 2 + 0) * 128 + jl) = acc[ai][0][0][0]; *(LAS f32x4*)(xch + (blk * 2 + 0) * 128 + jl + 4) = acc[ai][0][0][1]; }
                if (fr == 15) { *(LAS f32x4*)(xch + (blk * 2 + 1) * 128 + jl) = acc[ai][0][3][0]; *(LAS f32x4*)(xch + (blk * 2 + 1) * 128 + jl + 4) = acc[ai][0][3][1]; } }
            asm volatile("s_waitcnt lgkmcnt(0)" ::: "memory"); __builtin_amdgcn_s_barrier(); asm volatile("" ::: "memory");
        }
#pragma unroll
        for (int ai = 0; ai < 2; ++ai)
#pragma unroll
            for (int n = 0; n < 2; ++n) {
                const f32x4 w0 = cwv[n][0], w1 = cwv[n][1], w2 = cwv[n][2], bb = cwv[n][3];
                f32x4 bprev = {0.f, 0.f, 0.f, 0.f}, bnext = {0.f, 0.f, 0.f, 0.f};
                if (isctx) { const int blk = 2 * ai + wr;
                    if (blk > 0) bprev = *(const LAS f32x4*)(xch + ((blk - 1) * 2 + 1) * 128 + jl + 4 * n);
                    if (blk < 3) bnext = *(const LAS f32x4*)(xch + ((blk + 1) * 2 + 0) * 128 + jl + 4 * n); }
                f32x4 R[4], L[4];
#pragma unroll
                for (int m = 0; m < 4; ++m)
#pragma unroll
                    for (int e = 0; e < 4; ++e) { R[m][e] = DPP_ROR1(acc[ai][0][m][n][e]); L[m][e] = DPP_ROR15(acc[ai][0][m][n][e]); }
#pragma unroll
                for (int m = 0; m < 4; ++m) {
                    f32x2 o2[2];
#pragma unroll
                    for (int ep = 0; ep < 2; ++ep) {
                        f32x2 pv, nv;
#pragma unroll
                        for (int q = 0; q < 2; ++q) { const int e = 2 * ep + q;
                            pv[q] = (fr == 0) ? (m == 0 ? bprev[e] : R[m == 0 ? 0 : m - 1][e]) : R[m][e];
                            nv[q] = (fr == 15) ? (m == 3 ? bnext[e] : L[m == 3 ? 3 : m + 1][e]) : L[m][e]; }
                        const f32x2 a2 = {acc[ai][0][m][n][2 * ep], acc[ai][0][m][n][2 * ep + 1]}, g2 = {acc[ai][1][m][n][2 * ep], acc[ai][1][m][n][2 * ep + 1]};
                        const f32x2 w0p = {w0[2 * ep], w0[2 * ep + 1]}, w1p = {w1[2 * ep], w1[2 * ep + 1]}, w2p = {w2[2 * ep], w2[2 * ep + 1]}, bbp = {bb[2 * ep], bb[2 * ep + 1]};
                        const f32x2 c2 = w0p * pv + (w1p * a2 + (w2p * nv + bbp));
                        o2[ep] = gelu_pk(c2) * g2;
                    }
                    v2u w; w.x = cvtpk(o2[0].x, o2[0].y); w.y = cvtpk(o2[1].x, o2[1].y);
                    *(v2u*)(HID + (size_t)(row0 + ai * 128 + m * 16) * FF + j0 + 4 * n) = w;
                }
            }
    }
};
template <class Epi, bool ALIGN = false> __device__ __forceinline__ void run_gemm(LAS unsigned char* lds, const bf16* A, const bf16* Bt, int nM, int N, int K, const Epi& E, const int wave_s) {
    pg8::Gemm g{A, Bt, nM * 256, N, K}; RangeOrder S; S.init(nM, N / 256, (int)gridDim.x, (int)blockIdx.x);
    pg8::gemm_phase<Epi, RangeOrder, ALIGN, true>(lds, g, S, E, wave_s);
}

__device__ __forceinline__ void transpose_block(const float* W, int ldw, int src_n0, int k0, bf16* WT, int K, int dst_n0, LAS float* scr, int lane) {
    if (src_n0 >= 0) {
#pragma unroll
        for (int i = 0; i < 32; ++i) { const int kk = 2 * i + (lane >> 5); scr[kk * 33 + (lane & 31)] = W[(size_t)(k0 + kk) * ldw + src_n0 + (lane & 31)]; }
    } else {
#pragma unroll 8
        for (int i = 0; i < 32; ++i) { const int kk = 2 * i + (lane >> 5); scr[kk * 33 + (lane & 31)] = 0.f; }
    }
    asm volatile("s_waitcnt lgkmcnt(0)" ::: "memory");
    const int c = lane & 7;
#pragma unroll
    for (int j = 0; j < 4; ++j) { const int n = (lane >> 3) + 8 * j; const LAS float* s = scr + (8 * c) * 33 + n;
        v4u o; o.x = cvtpk(s[0 * 33], s[1 * 33]); o.y = cvtpk(s[2 * 33], s[3 * 33]); o.z = cvtpk(s[4 * 33], s[5 * 33]); o.w = cvtpk(s[6 * 33], s[7 * 33]);
        *(v4u*)(WT + (size_t)(dst_n0 + n) * K + k0 + 8 * c) = o; }
    asm volatile("s_waitcnt lgkmcnt(0)" ::: "memory");
}

struct P {
    const float* in[25]; float* out; unsigned char* ws;
};

__device__ __forceinline__ void ln_core(f32x4 (&v)[4], int lane) {
    float s = 0.f;
#pragma unroll
    for (int j = 0; j < 4; ++j) s += (v[j][0] + v[j][1]) + (v[j][2] + v[j][3]);
    const float mean = wave_sum(s, lane) * (1.f / DM); float s2 = 0.f;
#pragma unroll
    for (int j = 0; j < 4; ++j) { v[j] = v[j] - mean; s2 += (v[j][0] * v[j][0] + v[j][1] * v[j][1]) + (v[j][2] * v[j][2] + v[j][3] * v[j][3]); }
    const float rstd = 1.0f / sqrtf(wave_sum(s2, lane) * (1.f / DM) + LN_EPS);
#pragma unroll
    for (int j = 0; j < 4; ++j) v[j] = v[j] * rstd;
}
__device__ __forceinline__ void store_x_ux(const f32x4 (&v)[4], float* xrow, bf16* uxrow, const float* sh, const float* sc, int lane) {
#pragma unroll
    for (int j = 0; j < 4; ++j) {
        const int c = 4 * lane + 256 * j;
        *(f32x4*)(xrow + c) = v[j];
        if (uxrow) { const f32x4 a = *(const f32x4*)(sc + c), b = *(const f32x4*)(sh + c);
            v2u w; w.x = cvtpk(v[j][0] * (1.f + a[0]) + b[0], v[j][1] * (1.f + a[1]) + b[1]); w.y = cvtpk(v[j][2] * (1.f + a[2]) + b[2], v[j][3] * (1.f + a[3]) + b[3]);
            *(v2u*)(uxrow + c) = w; }
    }
}


__device__ __forceinline__ float dpp_row_total(float v) {
    v += __int_as_float(__builtin_amdgcn_update_dpp(0, __float_as_int(v), 0xB1, 0xf, 0xf, false));
    v += __int_as_float(__builtin_amdgcn_update_dpp(0, __float_as_int(v), 0x4E, 0xf, 0xf, false));
    v += __int_as_float(__builtin_amdgcn_update_dpp(0, __float_as_int(v), 0x141, 0xf, 0xf, false));
    v += __int_as_float(__builtin_amdgcn_update_dpp(0, __float_as_int(v), 0x140, 0xf, 0xf, false));
    return v;
}
__device__ __forceinline__ float wave_sum_dpp(float v) {
    v = dpp_row_total(v); const int i = __float_as_int(v);
    return (__int_as_float(__builtin_amdgcn_readlane(i, 0)) + __int_as_float(__builtin_amdgcn_readlane(i, 16))) + (__int_as_float(__builtin_amdgcn_readlane(i, 32)) + __int_as_float(__builtin_amdgcn_readlane(i, 48)));
}
__device__ __forceinline__ float half_sum_dpp(float v, int lane) {
    v = dpp_row_total(v); const int i = __float_as_int(v);
    const float t0 = __int_as_float(__builtin_amdgcn_readlane(i, 0)) + __int_as_float(__builtin_amdgcn_readlane(i, 16));
    const float t1 = __int_as_float(__builtin_amdgcn_readlane(i, 32)) + __int_as_float(__builtin_amdgcn_readlane(i, 48));
    return lane < 32 ? t0 : t1;
}
__device__ __forceinline__ void ln_phase(const int lane, const int gw, const int NGW, const int rows, float* xl, float* xcp, const float* lw, const float* lb,
                                         const float* modl, const int sh_off, const int sc_off, bf16* UXp, const float* x_init, const float* ctx_init, const float* POSp, float* stats, const bool final_x) {
    for (int row0 = gw * 4; row0 < rows; row0 += NGW * 4) {
        f32x4 v[4][4]; const bool lat = row0 < TL; const int bi = lat ? row0 / LSEQ : NB;
#pragma unroll
        for (int rr = 0; rr < 4; ++rr) { const int row = row0 + rr;
            const float* src = x_init ? (lat ? x_init + (size_t)row * DM : ctx_init + (size_t)(row - TL) * DM) : (lat ? xl + (size_t)row * DM : xcp + (size_t)(row - TL) * DM);
#pragma unroll
            for (int j = 0; j < 4; ++j) v[rr][j] = *(const f32x4*)(src + 4 * lane + 256 * j); }
        if (x_init && lat) {
#pragma unroll
            for (int rr = 0; rr < 4; ++rr) { const int t = (row0 + rr) % LSEQ; const float* e0 = POSp + (t >> 6) * 512; const float* e1 = POSp + (t & 63) * 512;
#pragma unroll
                for (int j = 0; j < 4; ++j) { const int c = 4 * lane + 256 * j; v[rr][j] += (j < 2) ? *(const f32x4*)(e0 + c) : *(const f32x4*)(e1 + c - 512); } }
        }
        if (x_init) {
#pragma unroll
            for (int rr = 0; rr < 4; ++rr) { const int row = row0 + rr; float* dst = lat ? xl + (size_t)row * DM : xcp + (size_t)(row - TL) * DM;
#pragma unroll
                for (int j = 0; j < 4; ++j) *(f32x4*)(dst + 4 * lane + 256 * j) = v[rr][j]; }
        }
        float mean[4], rstd[4];
#pragma unroll
        for (int rr = 0; rr < 4; ++rr) { float s = 0.f;
#pragma unroll
            for (int j = 0; j < 4; ++j) s += (v[rr][j][0] + v[rr][j][1]) + (v[rr][j][2] + v[rr][j][3]);
            mean[rr] = wave_sum_dpp(s) * (1.f / DM); }
#pragma unroll
        for (int rr = 0; rr < 4; ++rr) { float s2 = 0.f;
#pragma unroll
            for (int j = 0; j < 4; ++j) { v[rr][j] = v[rr][j] - mean[rr]; s2 += (v[rr][j][0] * v[rr][j][0] + v[rr][j][1] * v[rr][j][1]) + (v[rr][j][2] * v[rr][j][2] + v[rr][j][3] * v[rr][j][3]); }
            rstd[rr] = 1.0f / sqrtf(wave_sum_dpp(s2) * (1.f / DM) + LN_EPS); }
        if (lane == 0) {
#pragma unroll
            for (int rr = 0; rr < 4; ++rr) *(f32x2*)(stats + 2 * (size_t)(row0 + rr)) = (f32x2){mean[rr], rstd[rr]};
        }
        const float* md = modl + (size_t)bi * 6144;
#pragma unroll
        for (int j = 0; j < 4; ++j) { const int c = 4 * lane + 256 * j;
            f32x4 w4 = {1.f, 1.f, 1.f, 1.f}, b4 = {0.f, 0.f, 0.f, 0.f}; if (lw) { w4 = *(const f32x4*)(lw + c); b4 = *(const f32x4*)(lb + c); }
            f32x4 sc4 = {0.f, 0.f, 0.f, 0.f}, sh4 = {0.f, 0.f, 0.f, 0.f}; if (UXp) { sc4 = *(const f32x4*)(md + sc_off + c); sh4 = *(const f32x4*)(md + sh_off + c); }
#pragma unroll
            for (int rr = 0; rr < 4; ++rr) { const int row = row0 + rr; const f32x4 y = v[rr][j] * rstd[rr] * w4 + b4;
                if (final_x) { float* dst = lat ? xl + (size_t)row * DM : xcp + (size_t)(row - TL) * DM; *(f32x4*)(dst + c) = y; }
                if (UXp) { v2u w; w.x = cvtpk(y[0] * (1.f + sc4[0]) + sh4[0], y[1] * (1.f + sc4[1]) + sh4[1]); w.y = cvtpk(y[2] * (1.f + sc4[2]) + sh4[2], y[3] * (1.f + sc4[3]) + sh4[3]); *(v2u*)(UXp + (size_t)row * DM + c) = w; } }
        }
    }
}
#define MFMA32(a, b, c) __builtin_amdgcn_mfma_f32_32x32x16_bf16((a), (b), (c), 0, 0, 0)
__device__ __forceinline__ bf16x8 pack_step(const f32x16& x, int s) {
    v4u p; p.x = cvtpk(x[8 * s + 0], x[8 * s + 1]); p.y = cvtpk(x[8 * s + 2], x[8 * s + 3]); p.z = cvtpk(x[8 * s + 4], x[8 * s + 5]); p.w = cvtpk(x[8 * s + 6], x[8 * s + 7]);
    return __builtin_bit_cast(bf16x8, p);
}
constexpr int G_QE = 0, G_KE = 17408, G_KT = 34816, G_VT = 53248, G_BC = 71680, G_ZS = G_BC + 64 * 528, G_SEG = G_ZS + 4096, G_DEC = G_SEG + 2048, G_END = G_DEC + 512;
static_assert(G_END <= 131072, "gla lds");
constexpr int NCHUNK = 68;

__device__ __forceinline__ int gla_row(int n, int p, int b, int dir) {
    const bool isctx = n < 4; const int nn = isctx ? n : n - 4; const int Ls = isctx ? CTXL : LSEQ; const int Pp = 64 * nn + p;
    const int tok = dir ? (Ls - 1 - Pp) : Pp; return (isctx ? TL + b * CTXL : b * LSEQ) + tok;
}

__device__ __forceinline__ void gla_phase(LAS unsigned char* lds, const bf16* Q, const bf16* K, const bf16* V, const bf16* Z, bf16* OF, bf16* OB,
                                          const float* wgf, const float* bgf, const float* wgb, const float* bgb, const int wave_s) {
    const int lane = lane_id_v(), wid = wave_s, tid = wid * 64 + lane, r = lane & 31, h = lane >> 5, wv = wid & 3, wi = wid >> 2;
    LAS unsigned char* Qe = lds + G_QE; LAS unsigned char* Ke = lds + G_KE; LAS unsigned char* KT = lds + G_KT; LAS unsigned char* VT = lds + G_VT;
    LAS float* Bc = (LAS float*)(lds + G_BC); LAS unsigned char* Zs = lds + G_ZS; LAS float* Seg = (LAS float*)(lds + G_SEG); LAS float* Dec = (LAS float*)(lds + G_DEC);
    for (int w = blockIdx.x; w < 256; w += gridDim.x) {
        const int wm = ((((w & 7) << 4) + (w >> 4)) << 1) | ((w >> 3) & 1);
        const int b = wm >> 4, hh = (wm >> 2) & 3, dir = (wm >> 1) & 1, vh = wm & 1;
        const float* wg = dir ? wgb : wgf; const float* bg = dir ? bgb : bgf; bf16* O = dir ? OB : OF;
        const float bgl = bg[hh * 128 + 32 * wv + r];
        bf16x8 wghi;
        { float wf[8];
#pragma unroll
          for (int j = 0; j < 8; ++j) wf[j] = wg[(8 * h + j) * 512 + hh * 128 + 32 * wv + r];
          v4u ph; ph.x = cvtpk(wf[0], wf[1]); ph.y = cvtpk(wf[2], wf[3]); ph.z = cvtpk(wf[4], wf[5]); ph.w = cvtpk(wf[6], wf[7]);
          wghi = __builtin_bit_cast(bf16x8, ph); }
        f32x16 S[4];
#pragma unroll
        for (int t = 0; t < 4; ++t)
#pragma unroll
            for (int e = 0; e < 16; ++e) S[t][e] = 0.f;
        v4u rq[2], rk[2], rv[2], rz;
        rz = (v4u){0u, 0u, 0u, 0u};
#define GLA_LOAD(n) do { _Pragma("unroll") for (int i = 0; i < 2; ++i) { const int idx = tid + 512 * i, p = idx >> 4, c8 = idx & 15; const size_t row = (size_t)gla_row((n), p, b, dir); \
            rq[i] = *(const v4u*)(Q + row * 512 + hh * 128 + 8 * c8); rk[i] = *(const v4u*)(K + row * 512 + hh * 128 + 8 * c8); rv[i] = *(const v4u*)(V + row * 1024 + hh * 256 + vh * 128 + 8 * c8); } } while (0)
#define GLA_LOADZ(n) do { if (tid < 128) { const size_t row = (size_t)gla_row((n), tid >> 1, b, dir); rz = *(const v4u*)(Z + row * 32 + dir * 16 + 8 * (tid & 1)); } } while (0)
#define GLA_ZSTORE() do { if (tid < 128) *(LAS v4u*)(Zs + (tid >> 1) * 32 + 16 * (tid & 1)) = rz; } while (0)
#define GLA_GATEB() do { const bf16x8 za = *(const LAS bf16x8*)(Zs + (32 * wi + r) * 32 + 16 * h); f32x16 gt_; \
            _Pragma("unroll") for (int e = 0; e < 16; ++e) gt_[e] = 0.f; \
            gt_ = MFMA32(za, wghi, gt_); \
            float c_[16], s_[4], t_[4]; \
            _Pragma("unroll") for (int j = 0; j < 4; ++j) { float run = 0.f; \
                _Pragma("unroll") for (int i = 0; i < 4; ++i) { const float g = gt_[4 * j + i] + bgl; \
                    const float la = (fminf(g, 0.f) - __logf(1.0f + __expf(-fabsf(g)))) * (1.0f / 16.0f); run += la; c_[4 * j + i] = run; } \
                s_[j] = run; } \
            _Pragma("unroll") for (int j = 0; j < 4; ++j) t_[j] = __int_as_float(__builtin_amdgcn_ds_bpermute((lane ^ 32) << 2, __float_as_int(s_[j]))); \
            float offj = 0.f; \
            _Pragma("unroll") for (int j = 0; j < 4; ++j) { const float o_ = offj + (h ? t_[j] : 0.f); \
                _Pragma("unroll") for (int i = 0; i < 4; ++i) Bc[(32 * wi + 8 * j + 4 * h + i) * 132 + 32 * wv + r] = c_[4 * j + i] + o_; \
                offj += s_[j] + t_[j]; } \
            if (h == 0) Seg[wi * 128 + 32 * wv + r] = offj; } while (0)
        GLA_LOAD(0); GLA_LOADZ(0);
        __syncthreads();
        GLA_ZSTORE();
        GLA_LOADZ(1);
        __syncthreads();
        GLA_GATEB();
        for (int n = 0; n < NCHUNK; ++n) {
            __syncthreads();
#pragma unroll
            for (int i = 0; i < 2; ++i) { const int idx = tid + 512 * i, p = idx >> 4, c8 = idx & 15; const int pcol = ((((p >> 3) ^ (c8 & 7)) << 4) + ((p & 7) << 1));
                const f32x4 b0 = *(const LAS f32x4*)(Bc + p * 132 + 8 * c8), b1 = *(const LAS f32x4*)(Bc + p * 132 + 8 * c8 + 4);
                const f32x4 t00 = *(const LAS f32x4*)(Seg + 8 * c8), t01 = *(const LAS f32x4*)(Seg + 8 * c8 + 4), t10 = *(const LAS f32x4*)(Seg + 128 + 8 * c8), t11 = *(const LAS f32x4*)(Seg + 128 + 8 * c8 + 4);
                float qf[8], kf[8], bc[8], dc[8];
                qf[0] = bflo(rq[i].x); qf[1] = bfhi(rq[i].x); qf[2] = bflo(rq[i].y); qf[3] = bfhi(rq[i].y); qf[4] = bflo(rq[i].z); qf[5] = bfhi(rq[i].z); qf[6] = bflo(rq[i].w); qf[7] = bfhi(rq[i].w);
                kf[0] = bflo(rk[i].x); kf[1] = bfhi(rk[i].x); kf[2] = bflo(rk[i].y); kf[3] = bfhi(rk[i].y); kf[4] = bflo(rk[i].z); kf[5] = bfhi(rk[i].z); kf[6] = bflo(rk[i].w); kf[7] = bfhi(rk[i].w);
#pragma unroll
                for (int e = 0; e < 4; ++e) { bc[e] = b0[e] + (p >= 32 ? t00[e] : 0.f); bc[4 + e] = b1[e] + (p >= 32 ? t01[e] : 0.f); dc[e] = __expf(t00[e] + t10[e]); dc[4 + e] = __expf(t01[e] + t11[e]); }
                if (p == 0) { *(LAS f32x4*)(Dec + 8 * c8) = (f32x4){dc[0], dc[1], dc[2], dc[3]}; *(LAS f32x4*)(Dec + 8 * c8 + 4) = (f32x4){dc[4], dc[5], dc[6], dc[7]}; }
                float qe[8], ke[8], kn[8];
#pragma unroll
                for (int e = 0; e < 8; ++e) { const float ex = __expf(bc[e]); const float inv = __builtin_amdgcn_rcpf(ex); qe[e] = qf[e] * ex; ke[e] = kf[e] * inv; kn[e] = ke[e] * dc[e]; }
                v4u wq, wk; wq.x = cvtpk(qe[0], qe[1]); wq.y = cvtpk(qe[2], qe[3]); wq.z = cvtpk(qe[4], qe[5]); wq.w = cvtpk(qe[6], qe[7]);
                wk.x = cvtpk(ke[0], ke[1]); wk.y = cvtpk(ke[2], ke[3]); wk.z = cvtpk(ke[4], ke[5]); wk.w = cvtpk(ke[6], ke[7]);
                *(LAS v4u*)(Qe + p * 272 + 16 * c8) = wq; *(LAS v4u*)(Ke + p * 272 + 16 * c8) = wk;
#pragma unroll
                for (int e = 0; e < 8; e += 2) { const unsigned pk = cvtpk(kn[e], kn[e + 1]);
                    *(LAS unsigned short*)(KT + (8 * c8 + e) * 144 + pcol) = (unsigned short)(pk & 0xffffu); *(LAS unsigned short*)(KT + (8 * c8 + e + 1) * 144 + pcol) = (unsigned short)(pk >> 16); }
                const unsigned vv[4] = {rv[i].x, rv[i].y, rv[i].z, rv[i].w};
#pragma unroll
                for (int e = 0; e < 4; ++e) { *(LAS unsigned short*)(VT + (8 * c8 + 2 * e) * 144 + pcol) = (unsigned short)(vv[e] & 0xffffu); *(LAS unsigned short*)(VT + (8 * c8 + 2 * e + 1) * 144 + pcol) = (unsigned short)(vv[e] >> 16); }
                asm volatile("" ::: "memory");
            }
            GLA_ZSTORE();
            if (n + 2 < NCHUNK) GLA_LOADZ(n + 2);
            if (n + 1 < NCHUNK) GLA_LOAD(n + 1);
            __syncthreads();
            if (wi == 0 && n + 1 < NCHUNK) GLA_GATEB();
            __builtin_amdgcn_s_setprio(1);
            f32x16 oT;
#pragma unroll
            for (int e = 0; e < 16; ++e) oT[e] = 0.f;
            const LAS unsigned char* qrow = Qe + (32 * wi + r) * 272;
            const LAS unsigned char* vrow = VT + (32 * wv + r) * 144;
            {
                f32x16 at0;
#pragma unroll
                for (int e = 0; e < 16; ++e) at0[e] = 0.f;
#pragma unroll
                for (int hb = 0; hb < 2; ++hb) {
                    bf16x8 bq[4], ka[4];
#pragma unroll
                    for (int t = 0; t < 4; ++t) { bq[t] = *(const LAS bf16x8*)(qrow + 32 * (4 * hb + t) + 16 * h); ka[t] = *(const LAS bf16x8*)(Ke + r * 272 + 32 * (4 * hb + t) + 16 * h); }
                    asm volatile("" ::: "memory");
#pragma unroll
                    for (int t = 0; t < 4; ++t) at0 = MFMA32(ka[t], bq[t], at0);
                }
#pragma unroll
                for (int dkt = 0; dkt < 4; ++dkt) {
                    v4u qq[2];
#pragma unroll
                    for (int s2 = 0; s2 < 2; ++s2) { const v2u q0 = *(const LAS v2u*)(qrow + 64 * dkt + 32 * s2 + 8 * h), q1 = *(const LAS v2u*)(qrow + 64 * dkt + 32 * s2 + 8 * h + 16); qq[s2] = (v4u){q0.x, q0.y, q1.x, q1.y}; }
                    asm volatile("" ::: "memory");
#pragma unroll
                    for (int s2 = 0; s2 < 2; ++s2) oT = MFMA32(pack_step(S[dkt], s2), __builtin_bit_cast(bf16x8, qq[s2]), oT);
                }
                const int lim = 32 * wi + r - 4 * h;
                {
                    v4u va[2];
#pragma unroll
                    for (int t = 0; t < 2; ++t) { const v2u v0 = *(const LAS v2u*)(vrow + (((2 * t) ^ ((4 * wv + (r >> 3)) & 7)) << 4) + 8 * h), v1 = *(const LAS v2u*)(vrow + (((2 * t + 1) ^ ((4 * wv + (r >> 3)) & 7)) << 4) + 8 * h); va[t] = (v4u){v0.x, v0.y, v1.x, v1.y}; }
#pragma unroll
                    for (int e = 0; e < 16; ++e) at0[e] = (((e & 3) + 8 * (e >> 2)) > lim) ? 0.f : at0[e];
#pragma unroll
                    for (int s2 = 0; s2 < 2; ++s2) oT = MFMA32(__builtin_bit_cast(bf16x8, va[s2]), pack_step(at0, s2), oT);
                }
                if (wi) {
                    f32x16 at1;
#pragma unroll
                    for (int e = 0; e < 16; ++e) at1[e] = 0.f;
#pragma unroll
                    for (int hb = 0; hb < 2; ++hb) {
                        bf16x8 bq[4], ka[4];
#pragma unroll
                        for (int t = 0; t < 4; ++t) { bq[t] = *(const LAS bf16x8*)(qrow + 32 * (4 * hb + t) + 16 * h); ka[t] = *(const LAS bf16x8*)(Ke + (32 + r) * 272 + 32 * (4 * hb + t) + 16 * h); }
                        asm volatile("" ::: "memory");
#pragma unroll
                        for (int t = 0; t < 4; ++t) at1 = MFMA32(ka[t], bq[t], at1);
                    }
                    v4u va[2];
#pragma unroll
                    for (int t = 0; t < 2; ++t) { const v2u v0 = *(const LAS v2u*)(vrow + (((4 + 2 * t) ^ ((4 * wv + (r >> 3)) & 7)) << 4) + 8 * h), v1 = *(const LAS v2u*)(vrow + (((4 + 2 * t + 1) ^ ((4 * wv + (r >> 3)) & 7)) << 4) + 8 * h); va[t] = (v4u){v0.x, v0.y, v1.x, v1.y}; }
#pragma unroll
                    for (int e = 0; e < 16; ++e) at1[e] = ((32 + (e & 3) + 8 * (e >> 2)) > lim) ? 0.f : at1[e];
#pragma unroll
                    for (int s2 = 0; s2 < 2; ++s2) oT = MFMA32(__builtin_bit_cast(bf16x8, va[s2]), pack_step(at1, s2), oT);
                }
            }
            {
                bf16x8 vt[4];
#pragma unroll
                for (int t = 0; t < 4; ++t) vt[t] = *(const LAS bf16x8*)(vrow + (((2 * t + h) ^ ((4 * wv + (r >> 3)) & 7)) << 4));
#pragma unroll
                for (int dkt = 0; dkt < 4; ++dkt) {
                    bf16x8 kt[4]; f32x4 dd[4];
#pragma unroll
                    for (int t = 0; t < 4; ++t) { kt[t] = *(const LAS bf16x8*)(KT + (32 * dkt + r) * 144 + (((2 * t + h) ^ ((4 * dkt + (r >> 3)) & 7)) << 4)); dd[t] = *(const LAS f32x4*)(Dec + 32 * dkt + 8 * t + 4 * h); }
                    asm volatile("" ::: "memory");
#pragma unroll
                    for (int g4 = 0; g4 < 4; ++g4)
#pragma unroll
                        for (int e = 0; e < 4; ++e) S[dkt][4 * g4 + e] *= dd[g4][e];
#pragma unroll
                    for (int t = 0; t < 4; ++t) S[dkt] = MFMA32(kt[t], vt[t], S[dkt]);
                }
            }
            __builtin_amdgcn_s_setprio(0);
            if (wi == 1 && n + 1 < NCHUNK) GLA_GATEB();
            { const size_t row = (size_t)gla_row(n, 32 * wi + r, b, dir); bf16* op = O + row * 1024 + hh * 256 + vh * 128 + 32 * wv + 4 * h;
#pragma unroll
              for (int g4 = 0; g4 < 4; ++g4) { v2u w2; w2.x = cvtpk(oT[4 * g4], oT[4 * g4 + 1]); w2.y = cvtpk(oT[4 * g4 + 2], oT[4 * g4 + 3]); *(v2u*)(op + 8 * g4) = w2; } }
        }
#undef GLA_LOAD
#undef GLA_LOADZ
#undef GLA_ZSTORE
#undef GLA_GATEB
    }
}

#define KA() const P __attribute__((address_space(4)))* ka_ = (const P __attribute__((address_space(4)))*)__builtin_amdgcn_kernarg_segment_ptr(); asm volatile("" : "+s"(ka_)); unsigned char* ws = ka_->ws; float* xl = ka_->out; (void)xl; (void)ws;
constexpr size_t WS_BAR = 512 * 1024;
constexpr int LDS_ST = 131072;
constexpr int LDS_XCH = 131072 + 1024;
#define XB_TMO      128
#define XB_XCNT(j)  (256  + 64 * (j))
#define XB_XSUB(j)  (1280 + 64 * (j))
#define XB_XGEN(j)  (2304 + 64 * (j))
#define XB_TOP      3328
#define XB_TOPGEN   3392
#define XCD_BAR_WORDS 3456
#define XB_SPIN_CAP (1u << 22)
__device__ __forceinline__ unsigned xb_ld(unsigned* p)              { return __hip_atomic_load(p, __ATOMIC_RELAXED, __HIP_MEMORY_SCOPE_AGENT); }
__device__ __forceinline__ unsigned xb_add(unsigned* p, unsigned v) { return __hip_atomic_fetch_add(p, v, __ATOMIC_RELAXED, __HIP_MEMORY_SCOPE_AGENT); }
__device__ __forceinline__ unsigned xb_xcc_id() { return (unsigned)__builtin_amdgcn_s_getreg((3 << 11) | 20) & 0xFu; }
#define XB_SPIN(cond, bar) do { unsigned _sp = 0; while (cond) { __builtin_amdgcn_s_sleep(1); \
    if ((++_sp & 255u) == 0u) { if (xb_ld(&(bar)[XB_TMO])) break; if (_sp > XB_SPIN_CAP) { atomicAdd(&(bar)[XB_TMO], 1u); break; } } } } while (0)
__device__ __forceinline__ void xcd_barrier_complete(unsigned* bar, unsigned x, unsigned& nloc, unsigned& nx) {
    const unsigned G = gridDim.x * gridDim.y * gridDim.z;
    unsigned sum, cnt, mine, sp = 0u;
    for (;;) {
        sum = 0u; cnt = 0u; mine = 0u;
#pragma unroll
        for (unsigned j = 0; j < 16; ++j) { const unsigned c = xb_ld(&bar[XB_XCNT(j)]); sum += c; cnt += (c > 0u) ? 1u : 0u; mine = (j == x) ? c : mine; }
        if (sum == G) break;
        __builtin_amdgcn_s_sleep(1);
        if ((++sp & 255u) == 0u) { if (xb_ld(&bar[XB_TMO])) break; if (sp > XB_SPIN_CAP) { atomicAdd(&bar[XB_TMO], 1u); break; } }
    }
    nloc = mine > 0u ? mine : 1u; nx = cnt > 0u ? cnt : 1u;
}
__device__ __forceinline__ void grid_barrier(unsigned char* wsb, LAS unsigned char* lds, const int wave_s) {
    asm volatile("s_waitcnt vmcnt(0)" ::: "memory");
    __syncthreads();
    if (wave_s == 0 && lane_id_v() == 0) {
        unsigned* bar = (unsigned*)(wsb + WS_BAR);
        volatile LAS unsigned* st = (volatile LAS unsigned*)(lds + LDS_ST);
        const unsigned x = xb_xcc_id();
        __builtin_amdgcn_s_waitcnt(0);
        unsigned nloc = st[0], nx = st[1];
        if (nloc == 0u) { xcd_barrier_complete(bar, x, nloc, nx); st[0] = nloc; st[1] = nx; }
        const unsigned old = xb_add(&bar[XB_XSUB(x)], 1u);
        const unsigned gen = old / nloc;
        if (old + 1u == (gen + 1u) * nloc) {
            __builtin_amdgcn_fence(__ATOMIC_RELEASE, "agent");
            asm volatile("s_waitcnt vmcnt(0)" ::: "memory");
            const unsigned og = xb_add(&bar[XB_TOP], 1u);
            const unsigned tg = og / nx;
            if (og + 1u == (tg + 1u) * nx) xb_add(&bar[XB_TOPGEN], 1u);
            else XB_SPIN(xb_ld(&bar[XB_TOPGEN]) == tg, bar);
            __builtin_amdgcn_fence(__ATOMIC_ACQUIRE, "agent");
            xb_add(&bar[XB_XGEN(x)], 1u);
            asm volatile("s_waitcnt vmcnt(0)" ::: "memory");
        } else {
            XB_SPIN(xb_ld(&bar[XB_XGEN(x)]) == gen, bar);
            __builtin_amdgcn_fence(__ATOMIC_ACQUIRE, "agent");
            asm volatile("s_waitcnt vmcnt(0)" ::: "memory");
        }
    }
    __syncthreads();
}
#define GSYNC() do { KA(); grid_barrier(ws, lds, wave_s); } while (0)
#define x_in (ka_->in[0])
#define c_in (ka_->in[1])
#define ctx_in (ka_->in[2])
#define cctx_in (ka_->in[3])
#define w_mod (ka_->in[4])
#define b_mod (ka_->in[5])
#define w_in (ka_->in[6])
#define w_gate_f (ka_->in[7])
#define b_gate_f (ka_->in[8])
#define w_gate_b (ka_->in[9])
#define b_gate_b (ka_->in[10])
#define gla_norm_w (ka_->in[11])
#define w_pool (ka_->in[12])
#define pool_scale (ka_->in[13])
#define w_br_pool (ka_->in[14])
#define w_br_gla (ka_->in[15])
#define w_out (ka_->in[16])
#define ln1_w (ka_->in[17])
#define ln1_b (ka_->in[18])
#define w_up (ka_->in[19])
#define conv_w (ka_->in[20])
#define conv_b (ka_->in[21])
#define w_down (ka_->in[22])
#define ln2_w (ka_->in[23])
#define ln2_b (ka_->in[24])
#define POS ((float*)(ws + WS_POS))
#define MOD ((float*)(ws + WS_MOD))
#define W1T ((bf16*)(ws + WS_W1T))
#define W2T ((bf16*)(ws + WS_W2T))
#define WPT ((bf16*)(ws + WS_WPT))
#define WGT ((bf16*)(ws + WS_WGT))
#define WOT ((bf16*)(ws + WS_WOT))
#define WUT ((bf16*)(ws + WS_WUT))
#define WDT ((bf16*)(ws + WS_WDT))
#define xc ((float*)(ws + WS_XC))
#define UX ((bf16*)(ws + WS_UX))
#define Qb ((bf16*)(ws + WS_R + R_Q))
#define Kb ((bf16*)(ws + WS_R + R_K))
#define Vb ((bf16*)(ws + WS_R + R_V))
#define OFb ((bf16*)(ws + WS_R + R_OF))
#define OBb ((bf16*)(ws + WS_R + R_OB))
#define Zb ((bf16*)(ws + WS_R + R_Z))
#define POOLb ((bf16*)(ws + WS_R + R_POOL))
#define GPb ((bf16*)(ws + WS_R + R_GP))
#define GGb ((bf16*)(ws + WS_R + R_GG))
#define POOLEDb ((bf16*)(ws + WS_R + R_POOLED))
#define HIDb ((bf16*)(ws + WS_R + R_HID))
#define STATS ((float*)(ws + WS_STATS))
#define FRESH() KA(); const int lane = lane_id_v(), wave = wave_s, tid = wave * 64 + lane, gw = blockIdx.x * 8 + wave, gt = blockIdx.x * NTHREADS + tid; (void)lane; (void)gw; (void)gt; (void)wave;
template <int l> __device__ __forceinline__ void layer_body(LAS unsigned char* lds, const int wave_s) {
    const int G = gridDim.x, NGW = G * 8, NGT = G * NTHREADS; (void)NGW; (void)NGT;
        const bool last = (l == DEPTH - 1);
        const int nMall = TT / 256, nMpost = last ? TL / 256 : TT / 256, rows_post = nMpost * 256;
        { KA(); EpiA1 E{Qb, Kb, Vb, Zb}; run_gemm(lds, UX, W1T + (size_t)l * N1 * 1024, nMall, N1, 1024, E, wave_s); }
        GSYNC();
        { KA(); gla_phase(lds, Qb, Kb, Vb, Zb, OFb, OBb, w_gate_f + (size_t)l * 16 * 512, b_gate_f + l * 512, w_gate_b + (size_t)l * 16 * 512, b_gate_b + l * 512, wave_s); }
        GSYNC();
        { KA(); EpiA2 E{POOLb, OFb, GPb, GGb, OBb, gla_norm_w + l * 1024, (LAS float*)(lds + LDS_XCH)}; run_gemm<EpiA2, true>(lds, UX, W2T + (size_t)l * N2 * 1024, nMpost, N2, 1024, E, wave_s); }
        GSYNC();
        { FRESH();
        for (int row = gw; row < rows_post; row += NGW) {
            int pos, Ls; if (row < TL) { pos = row & 63; Ls = 64; } else { pos = (row - TL) & 255; Ls = 256; }
            const int hw = 1 << (lane >> 4);
            const int lo = max(pos - hw, 0), hi = min(pos + hw, Ls);
            const bf16* base = POOLb + (size_t)(row - pos) * 512 + 8 * lane;
            float s[8];
#pragma unroll
            for (int e = 0; e < 8; ++e) s[e] = 0.f;
            v4u av[16];
#pragma unroll
            for (int k = 0; k < 16; ++k) { const int p = lo + k; const int pc = p < hi ? p : pos; av[k] = *(const v4u*)(base + (size_t)pc * 512); }
#pragma unroll
            for (int k = 0; k < 16; ++k) { const float vm = (lo + k < hi) ? 1.f : 0.f; const v4u a = av[k];
                s[0] += vm * bflo(a.x); s[1] += vm * bfhi(a.x); s[2] += vm * bflo(a.y); s[3] += vm * bfhi(a.y); s[4] += vm * bflo(a.z); s[5] += vm * bfhi(a.z); s[6] += vm * bflo(a.w); s[7] += vm * bfhi(a.w); }
            const v4u me = *(const v4u*)(base + (size_t)pos * 512); const float inv = 1.0f / (float)(hi - lo);
            v4u w; w.x = cvtpk(s[0] * inv - bflo(me.x), s[1] * inv - bfhi(me.x)); w.y = cvtpk(s[2] * inv - bflo(me.y), s[3] * inv - bfhi(me.y));
            w.z = cvtpk(s[4] * inv - bflo(me.z), s[5] * inv - bfhi(me.z)); w.w = cvtpk(s[6] * inv - bflo(me.w), s[7] * inv - bfhi(me.w));
            *(v4u*)(POOLEDb + (size_t)row * 512 + 8 * lane) = w;
        } }
        GSYNC();
        { KA(); EpiMul E{GPb}; run_gemm(lds, POOLEDb, WPT + (size_t)l * 1024 * 512, nMpost, 1024, 512, E, wave_s); }
        { KA(); EpiMulAdd E{GGb, GPb}; run_gemm(lds, OFb, WGT + (size_t)l * 1024 * 1024, nMpost, 1024, 1024, E, wave_s); }
        GSYNC();
        { KA(); EpiRes E{xl, xc, MOD + (size_t)l * 17 * 6144 + 2048, 0, STATS, l > 0 ? ln2_w + (l - 1) * 1024 : (const float*)nullptr, l > 0 ? ln2_b + (l - 1) * 1024 : (const float*)nullptr}; run_gemm(lds, GGb, WOT + (size_t)l * 1024 * 1024, nMpost, 1024, 1024, E, wave_s); }
        GSYNC();
        { FRESH(); ln_phase(lane, gw, NGW, rows_post, xl, xc, ln1_w + l * 1024, ln1_b + l * 1024, MOD + (size_t)l * 17 * 6144, 3072, 4096, UX, nullptr, nullptr, nullptr, STATS, false); }
        GSYNC();
        { KA(); EpiUpConv E{HIDb, conv_w + (size_t)l * 3 * FF, conv_b + (size_t)l * FF, (LAS float*)(lds + LDS_XCH)}; run_gemm<EpiUpConv, true>(lds, UX, WUT + (size_t)l * NU * 1024, nMpost, NU, 1024, E, wave_s); }
        GSYNC();
        { KA(); EpiRes E{xl, xc, MOD + (size_t)l * 17 * 6144 + 5120, 0, STATS, ln1_w + l * 1024, ln1_b + l * 1024}; run_gemm(lds, HIDb, WDT + (size_t)l * 1024 * FF, nMpost, 1024, FF, E, wave_s); }
        GSYNC();
        { FRESH(); ln_phase(lane, gw, NGW, rows_post, xl, xc, ln2_w + l * 1024, ln2_b + l * 1024, MOD + (size_t)(last ? l : l + 1) * 17 * 6144, 0, 1024, last ? (bf16*)nullptr : UX, nullptr, nullptr, nullptr, STATS, last); }
        if (!last) GSYNC();
}

__global__ void __launch_bounds__(NTHREADS, 2) fwd_mega(P prm) {
    extern __shared__ __attribute__((aligned(16))) unsigned char lds_raw[];
    LAS unsigned char* lds = (LAS unsigned char*)lds_raw;
    cg::grid_group grid = cg::this_grid();
    const int G = gridDim.x, NGW = G * 8, NGT = G * NTHREADS;
    const int wave_s = __builtin_amdgcn_readfirstlane(threadIdx.x >> 6);
    if (threadIdx.x < 64) ((LAS unsigned*)(lds + LDS_ST))[threadIdx.x] = 0u;
    __syncthreads();
    if (threadIdx.x == 0) (void)xb_add((unsigned*)(prm.ws + WS_BAR) + XB_XCNT(xb_xcc_id()), 1u);
    {
        FRESH();
        LAS float* sc = (LAS float*)lds;
        LAS float* part = (LAS float*)(lds + 69632);
        for (int i = tid; i < 17 * 1024; i += NTHREADS) { const float v = i < 16 * 1024 ? c_in[i] : cctx_in[i - 16 * 1024]; sc[i] = v * sigmoidf_(v); }
        __syncthreads();
        for (int it = blockIdx.x; it < 4 * 96; it += G) {
            const int l = it / 96, j0 = (it % 96) * 64, jl = tid & 63, kp = tid >> 6;
            float acc[17];
#pragma unroll
            for (int bi = 0; bi < 17; ++bi) acc[bi] = 0.f;
            const float* wp = w_mod + (size_t)l * 1024 * 6144 + (size_t)(kp * 128) * 6144 + j0 + jl;
            for (int k0 = 0; k0 < 128; k0 += 16) { float wv_[16];
#pragma unroll
                for (int k = 0; k < 16; ++k) wv_[k] = wp[(size_t)(k0 + k) * 6144];
#pragma unroll
                for (int k = 0; k < 16; ++k) { const int kk = kp * 128 + k0 + k;
#pragma unroll
                    for (int bi = 0; bi < 17; ++bi) acc[bi] += sc[bi * 1024 + kk] * wv_[k]; } }
#pragma unroll
            for (int bi = 0; bi < 17; ++bi) part[(kp * 17 + bi) * 64 + jl] = acc[bi];
            __syncthreads();
            for (int o = tid; o < 17 * 64; o += NTHREADS) { const int bi = o >> 6, j = o & 63; float s = b_mod[l * 6144 + j0 + j];
#pragma unroll
                for (int q = 0; q < 8; ++q) s += part[(q * 17 + bi) * 64 + j];
                MOD[((size_t)l * 17 + bi) * 6144 + j0 + j] = s; }
            __syncthreads();
        }
        for (int i = gt; i < 64 * 512; i += NGT) { const int p = i >> 9, q = i & 511, fi = q & 255;
            const double om = exp(-9.210340371976184 * (double)fi / 256.0); double rev = (double)p * om * 0.15915494309189535; rev -= floor(rev);
            POS[i] = (q < 256) ? __builtin_amdgcn_sinf((float)rev) : __builtin_amdgcn_cosf((float)rev); }
        for (int i = gt; i < 4 * 64 * 1024; i += NGT) { const int n = i & 1023, kg = (i >> 10) & 63, l = i >> 16, g = kg >> 4, c0 = (kg & 15) * 8;
            float acc[8];
#pragma unroll
            for (int e = 0; e < 8; ++e) acc[e] = 0.f;
            const float* wpl = w_pool + ((size_t)(l * 4 + g) * 128 + c0) * 128; const float* ps = pool_scale + l * 512 + g * 128; const float* wb = w_br_pool + ((size_t)l * 512 + g * 128) * 1024 + n;
            for (int d0 = 0; d0 < 128; d0 += 16) { float t[16];
#pragma unroll
                for (int d = 0; d < 16; ++d) t[d] = wb[(size_t)(d0 + d) * 1024];
#pragma unroll
                for (int d = 0; d < 16; ++d) { const float tt = t[d] * ps[d0 + d];
#pragma unroll
                    for (int e = 0; e < 8; ++e) acc[e] += wpl[e * 128 + d0 + d] * tt; } }
            v4u o; o.x = cvtpk(acc[0], acc[1]); o.y = cvtpk(acc[2], acc[3]); o.z = cvtpk(acc[4], acc[5]); o.w = cvtpk(acc[6], acc[7]);
            *(v4u*)(WPT + ((size_t)l * 1024 + n) * 512 + g * 128 + c0) = o; }
        LAS float* scr = (LAS float*)(lds + wave * 16384);
        for (int it = gw; it < 4 * 8192; it += NGW) {
            const int l = it >> 13; int rr = it & 8191;
            if (rr < 1152) { const int kb = rr / 72, nb = rr % 72, d0 = nb * 32; const int s0 = d0 < 2048 ? 512 + d0 : (d0 < 2080 ? 3584 + (d0 - 2048) : -1);
                transpose_block(w_in + (size_t)l * 1024 * NIN, NIN, s0, kb * 64, W1T + (size_t)l * N1 * 1024, 1024, d0, scr, lane); continue; } rr -= 1152;
            if (rr < 1792) { const int kb = rr / 112, nb = rr % 112, d0 = nb * 32; const int s0 = d0 < 512 ? d0 : (d0 < 1536 ? 2560 + (d0 - 512) : 3616 + (d0 - 1536));
                transpose_block(w_in + (size_t)l * 1024 * NIN, NIN, s0, kb * 64, W2T + (size_t)l * N2 * 1024, 1024, d0, scr, lane); continue; } rr -= 1792;
            if (rr < 512) { const int kb = rr / 32, nb = rr % 32; transpose_block(w_br_gla + (size_t)l * 1024 * 1024, 1024, nb * 32, kb * 64, WGT + (size_t)l * 1024 * 1024, 1024, nb * 32, scr, lane); continue; } rr -= 512;
            if (rr < 512) { const int kb = rr / 32, nb = rr % 32; transpose_block(w_out + (size_t)l * 1024 * 1024, 1024, nb * 32, kb * 64, WOT + (size_t)l * 1024 * 1024, 1024, nb * 32, scr, lane); continue; } rr -= 512;
            if (rr < 2816) { const int kb = rr / 176, nb = rr % 176, d0 = nb * 32, pn = d0 >> 8, wq = d0 & 255; const int s0 = wq < 128 ? 128 * pn + wq : FF + 128 * pn + (wq - 128);
                transpose_block(w_up + (size_t)l * 1024 * NU, NU, s0, kb * 64, WUT + (size_t)l * NU * 1024, 1024, d0, scr, lane); continue; } rr -= 2816;
            { const int kb = rr / 32, nb = rr % 32; transpose_block(w_down + (size_t)l * FF * 1024, 1024, nb * 32, kb * 64, WDT + (size_t)l * 1024 * FF, FF, nb * 32, scr, lane); }
        }
    }
    grid.sync();
    { FRESH(); ln_phase(lane, gw, NGW, TT, xl, xc, nullptr, nullptr, MOD, 0, 1024, UX, x_in, ctx_in, POS, STATS, false); }
    GSYNC();

    layer_body<0>(lds, wave_s); layer_body<1>(lds, wave_s); layer_body<2>(lds, wave_s); layer_body<3>(lds, wave_s);
}

extern "C" void kernel_launch(void* const* d_in, const int* in_sizes, int n_in, void* d_out, int out_size, void* d_ws, size_t ws_size, hipStream_t stream) {
    static int grid = 0;
    if (grid == 0) {
        if (n_in != 25 || out_size != TL * DM || ws_size < WS_END) { fprintf(stderr, "kernel_launch: unexpected shapes (n_in %d out %d ws %zu need %zu)\n", n_in, out_size, ws_size, (size_t)WS_END); grid = -1; return; }
        int dev = 0, cus = 0, per_cu = 0;
        if (hipGetDevice(&dev) != hipSuccess || hipDeviceGetAttribute(&cus, hipDeviceAttributeMultiprocessorCount, dev) != hipSuccess) { grid = -1; return; }
        if (hipFuncSetAttribute((const void*)fwd_mega, hipFuncAttributeMaxDynamicSharedMemorySize, LDS_BYTES) != hipSuccess) { fprintf(stderr, "hipFuncSetAttribute failed\n"); grid = -1; return; }
        if (hipOccupancyMaxActiveBlocksPerMultiprocessor(&per_cu, (const void*)fwd_mega, NTHREADS, LDS_BYTES) != hipSuccess || per_cu < 1) { fprintf(stderr, "occupancy query: %d\n", per_cu); per_cu = 1; }
        (void)hipGetLastError();
        grid = cus;
    }
    if (grid < 0) return;
    if (hipMemsetAsync((char*)d_ws + WS_BAR, 0, 16384, stream) != hipSuccess) { fprintf(stderr, "memset failed\n"); return; }
    P prm{};
    for (int i = 0; i < 25; ++i) prm.in[i] = (const float*)d_in[i];
    prm.out = (float*)d_out; prm.ws = (unsigned char*)d_ws;
    void* args[] = {&prm};
    hipError_t e = hipLaunchCooperativeKernel((const void*)fwd_mega, dim3(grid), dim3(NTHREADS), args, LDS_BYTES, stream);
    if (e != hipSuccess) fprintf(stderr, "cooperative launch failed: %s\n", hipGetErrorString(e));
}
```

```cpp
#include <hip/hip_runtime.h>
#include <hip/hip_cooperative_groups.h>
#include <cstdio>
#include <cstdint>
namespace cg = cooperative_groups;
namespace pg8 {
#define PG8_LAS __attribute__((address_space(3)))
typedef unsigned short bf16_t;
typedef short bf16x8 __attribute__((ext_vector_type(8)));
typedef float f32x4 __attribute__((ext_vector_type(4)));
typedef unsigned u32x4 __attribute__((ext_vector_type(4)));
constexpr int BM = 256, BK = 64, HALF = 128, HTB = HALF * BK * 2  , STAGE_BYTES = 8 * HTB, NXCD = 8, WGM = 4;

__host__ __device__ __forceinline__ int lds_byte(int r, int c) { const int st = (r >> 4) * 2 + (c >> 5), rr = r & 15, cc = c & 31, ob = rr * 64 + cc * 2; return st * 1024 + (ob ^ (((ob >> 9) & 1) << 5)); }
__host__ __device__ __forceinline__ void stage_rc(int b, int& R, int& C) { const int st = b / 1024, sb = b % 1024, swz = sb ^ (((sb >> 9) & 1) << 5); R = (st >> 1) * 16 + swz / 64; C = (st & 1) * 32 + (swz % 64) / 2; }
__host__ __device__ __forceinline__ int perm32(int rho) { const int n = rho >> 4, i = rho & 15; return 8 * (i >> 2) + 4 * n + (i & 3); }

struct Unit { int pm, pn; };
struct Gemm { const bf16_t* A; const bf16_t* Bt; int M, N, K; };

struct StaticOrder {
    int nM, nN, nwg, G, c;
    __host__ __device__ void init(int M, int N, int G_, int c_) { nM = M / BM; nN = N / BM; nwg = nM * nN; G = G_; c = c_; }
    __host__ __device__ bool next(int i, Unit& u) const {
        const long L = (long)i * G + c; if (L >= nwg) return false;
        int wgid = (int)L; { const int q = nwg / NXCD, r = nwg % NXCD, xcd = wgid % NXCD, off = wgid / NXCD; wgid = (xcd < r ? xcd * (q + 1) : r * (q + 1) + (xcd - r) * q) + off; }
        const int nig = WGM * nN, gid = wgid / nig, fm = gid * WGM, gsz = (nM - fm) < WGM ? (nM - fm) : WGM;
        u.pm = fm + ((wgid % nig) % gsz); u.pn = (wgid % nig) / gsz; return true;
    }
    __device__ __forceinline__ void a_ready(const Unit&) const {}
    __device__ __forceinline__ void done(const Unit&) const {}
};

template <class Epi, class Sched, bool ALIGN_EPI = false, bool SP2 = false>
__device__ __forceinline__ void gemm_phase(PG8_LAS unsigned char* lds, const Gemm g, const Sched& S, const Epi& E, const int wave_s) {
    int lane_; asm volatile("v_mbcnt_lo_u32_b32 %0, -1, 0\n\tv_mbcnt_hi_u32_b32 %0, -1, %0" : "=v"(lane_)); const int lane = lane_, wid = wave_s, tid = wid * 64 + lane, wr = wid >> 2, wc = wid & 3, fr = lane & 15, fq = lane >> 4;
    const int K = g.K, nt = K / BK;
    unsigned voffA[2], voffB[2];
#pragma unroll
    for (int i = 0; i < 2; ++i) { int R, C; stage_rc(tid * 16 + i * 8192, R, C); const int Rb = Epi::PERM ? ((R & ~31) + perm32(R & 31)) : R;
        voffA[i] = (unsigned)(R * K + C) * 2u; voffB[i] = (unsigned)(Rb * K + C) * 2u; }
    const size_t kstep = (size_t)(BK * 2);
    const size_t hstep = (size_t)HALF * K * 2;
    const size_t tstep = 2 * hstep;
    const unsigned ldsw = (unsigned)wid * 1024u;
    const int aoff = lds_byte(wr * 64 + fr, fq * 8), boff = lds_byte(wc * 32 + fr, fq * 8);
#define PG8_SA(b, h) (((b) * 2 + (h)) * HTB)
#define PG8_SB(b, h) ((4 + (b) * 2 + (h)) * HTB)
#define PG8_STAGE(bufoff, gbase, voff) do { _Pragma("unroll") for (int _i = 0; _i < 2; ++_i) \
        __builtin_amdgcn_global_load_lds((const unsigned*)((const char*)(gbase) + (voff)[_i]), (PG8_LAS unsigned*)(lds + (bufoff) + ldsw + _i * 8192), 16, 0, 0); } while (0)
#define PG8_LDA(dst, b, h) do { _Pragma("unroll") for (int m = 0; m < 4; ++m) _Pragma("unroll") for (int k = 0; k < 2; ++k) dst[m][k] = *(const PG8_LAS bf16x8*)(lds + PG8_SA(b, h) + aoff + m * 2048 + k * 1024); } while (0)
#define PG8_LDB(dst, b, h) do { _Pragma("unroll") for (int n = 0; n < 2; ++n) _Pragma("unroll") for (int k = 0; k < 2; ++k) dst[n][k] = *(const PG8_LAS bf16x8*)(lds + PG8_SB(b, h) + boff + n * 2048 + k * 1024); } while (0)
#define PG8_MMA(ai, bj, At, Bt) do { __builtin_amdgcn_s_setprio(1); _Pragma("unroll") for (int m = 0; m < 4; ++m) _Pragma("unroll") for (int n = 0; n < 2; ++n) _Pragma("unroll") for (int k = 0; k < 2; ++k) \
        acc[ai][bj][m][n] = __builtin_amdgcn_mfma_f32_16x16x32_bf16(Bt[n][k], At[m][k], acc[ai][bj][m][n], 0, 0, 0); __builtin_amdgcn_s_setprio(0); } while (0)
#define PG8_WAIT_V(n) asm volatile("s_waitcnt vmcnt(" #n ")" ::: "memory")
#define PG8_WAIT_L(n) asm volatile("s_waitcnt lgkmcnt(" #n ")" ::: "memory")
#define PG8_BAR __builtin_amdgcn_s_barrier()
#define PG8_SCHED __builtin_amdgcn_sched_barrier(0)
    Unit cur, nxt; int ui = 0;
    if (!S.next(0, cur)) return;
    f32x4 acc[2][2][4][2];
#pragma unroll
    for (int a = 0; a < 2; ++a)
#pragma unroll
        for (int b = 0; b < 2; ++b)
#pragma unroll
            for (int m = 0; m < 4; ++m)
#pragma unroll
                for (int n = 0; n < 2; ++n) acc[a][b][m][n] = (f32x4){0.f, 0.f, 0.f, 0.f};
    bf16x8 At[4][2], B0[2][2], B1[2][2];
    const char* cA = (const char*)g.A + (size_t)cur.pm * tstep; const char* cB = (const char*)g.Bt + (size_t)cur.pn * tstep;
    S.a_ready(cur);
    if constexpr (SP2) {
        PG8_STAGE(PG8_SB(0, 0), cB, voffB); PG8_STAGE(PG8_SB(0, 1), cB + hstep, voffB); PG8_STAGE(PG8_SA(0, 0), cA, voffA); PG8_STAGE(PG8_SA(0, 1), cA + hstep, voffA);
        if (wr == 1) PG8_BAR;
        PG8_WAIT_V(2); PG8_BAR;
        PG8_STAGE(PG8_SB(1, 0), cB + kstep, voffB); PG8_STAGE(PG8_SA(1, 0), cA + kstep, voffA); PG8_STAGE(PG8_SB(1, 1), cB + hstep + kstep, voffB);
        PG8_WAIT_V(6); PG8_BAR;
    } else {
        PG8_STAGE(PG8_SB(0, 0), cB, voffB); PG8_STAGE(PG8_SA(0, 0), cA, voffA); PG8_STAGE(PG8_SB(0, 1), cB + hstep, voffB); PG8_STAGE(PG8_SA(0, 1), cA + hstep, voffA);
        if (wr == 1) PG8_BAR;
        PG8_WAIT_V(4); PG8_BAR;
        PG8_STAGE(PG8_SB(1, 0), cB + kstep, voffB); PG8_STAGE(PG8_SA(1, 0), cA + kstep, voffA); PG8_STAGE(PG8_SB(1, 1), cB + hstep + kstep, voffB);
        PG8_WAIT_V(6); PG8_BAR;
    }
    for (;;) {
        const bool has_next = S.next(ui + 1, nxt);
        const char* nA = has_next ? (const char*)g.A + (size_t)nxt.pm * tstep : cA; const char* nB = has_next ? (const char*)g.Bt + (size_t)nxt.pn * tstep : cB;
        for (int t = 0; t < nt; t += 2) {
            const bool last = (t == nt - 2);
            const char* a1 = cA + (size_t)(t + 1) * kstep;
            const char* a2 = last ? nA : cA + (size_t)(t + 2) * kstep; const char* b2 = last ? nB : cB + (size_t)(t + 2) * kstep;
            const char* a3 = a2 + kstep; const char* b3 = b2 + kstep;
            if (last && has_next) S.a_ready(nxt);
            if constexpr (SP2) {
            PG8_LDB(B0, 0, 0); PG8_LDB(B1, 0, 1); PG8_SCHED; PG8_LDA(At, 0, 0); PG8_STAGE(PG8_SA(1, 1), a1 + hstep, voffA);
            PG8_WAIT_V(8); PG8_WAIT_L(0); PG8_BAR; PG8_MMA(0, 0, At, B0); PG8_MMA(0, 1, At, B1); PG8_BAR; PG8_SCHED;
            PG8_LDA(At, 0, 1); PG8_STAGE(PG8_SB(0, 0), b2, voffB); PG8_STAGE(PG8_SB(0, 1), b2 + hstep, voffB); PG8_STAGE(PG8_SA(0, 0), a2, voffA);
            PG8_WAIT_V(8); PG8_WAIT_L(0); PG8_BAR; PG8_MMA(1, 0, At, B0); PG8_MMA(1, 1, At, B1); PG8_BAR; PG8_SCHED;
            PG8_LDB(B0, 1, 0); PG8_LDB(B1, 1, 1); PG8_SCHED; PG8_LDA(At, 1, 0); PG8_STAGE(PG8_SA(0, 1), a2 + hstep, voffA);
            PG8_WAIT_V(8); PG8_WAIT_L(0); PG8_BAR; PG8_MMA(0, 0, At, B0); PG8_MMA(0, 1, At, B1); PG8_BAR; PG8_SCHED;
            PG8_LDA(At, 1, 1); PG8_STAGE(PG8_SB(1, 0), b3, voffB); PG8_STAGE(PG8_SB(1, 1), b3 + hstep, voffB); PG8_STAGE(PG8_SA(1, 0), a3, voffA);
            PG8_WAIT_V(8); PG8_WAIT_L(0); PG8_BAR; PG8_MMA(1, 0, At, B0); PG8_MMA(1, 1, At, B1); PG8_BAR; PG8_SCHED;
            } else {
            PG8_LDB(B0, 0, 0); PG8_SCHED; PG8_LDA(At, 0, 0); PG8_STAGE(PG8_SA(1, 1), a1 + hstep, voffA);
            PG8_WAIT_L(8); PG8_BAR; PG8_WAIT_L(0); PG8_MMA(0, 0, At, B0); PG8_BAR; PG8_SCHED;
            PG8_LDB(B1, 0, 1); PG8_STAGE(PG8_SB(0, 0), b2, voffB);
            PG8_BAR; PG8_WAIT_L(0); PG8_MMA(0, 1, At, B1); PG8_BAR;
            PG8_LDA(At, 0, 1); PG8_STAGE(PG8_SA(0, 0), a2, voffA);
            PG8_BAR; PG8_WAIT_L(0); PG8_MMA(1, 0, At, B0); PG8_BAR; PG8_SCHED;
            PG8_STAGE(PG8_SB(0, 1), b2 + hstep, voffB);
            PG8_WAIT_V(6); PG8_BAR; PG8_MMA(1, 1, At, B1); PG8_BAR;
            PG8_LDB(B0, 1, 0); PG8_SCHED; PG8_LDA(At, 1, 0); PG8_STAGE(PG8_SA(0, 1), a2 + hstep, voffA);
            PG8_WAIT_L(8); PG8_BAR; PG8_WAIT_L(0); PG8_MMA(0, 0, At, B0); PG8_BAR; PG8_SCHED;
            PG8_LDB(B1, 1, 1); PG8_STAGE(PG8_SB(1, 0), b3, voffB);
            PG8_BAR; PG8_WAIT_L(0); PG8_MMA(0, 1, At, B1); PG8_BAR;
            PG8_LDA(At, 1, 1); PG8_STAGE(PG8_SA(1, 0), a3, voffA);
            PG8_BAR; PG8_WAIT_L(0); PG8_MMA(1, 0, At, B0); PG8_BAR; PG8_SCHED;
            PG8_STAGE(PG8_SB(1, 1), b3 + hstep, voffB);
            PG8_WAIT_V(6); PG8_BAR; PG8_MMA(1, 1, At, B1); PG8_BAR;
            }
        }
        if constexpr (ALIGN_EPI) { if (wr == 0) PG8_BAR; }
        if constexpr (!Epi::AFTER_DRAIN) { E(acc, cur, wr, wc, fr, fq); S.done(cur); }
        if (!has_next) break;
#pragma unroll
        for (int a = 0; a < 2; ++a)
#pragma unroll
            for (int b = 0; b < 2; ++b)
#pragma unroll
                for (int m = 0; m < 4; ++m)
#pragma unroll
                    for (int n = 0; n < 2; ++n) acc[a][b][m][n] = (f32x4){0.f, 0.f, 0.f, 0.f};
        cur = nxt; cA = nA; cB = nB; ++ui;
        if constexpr (ALIGN_EPI) { if (wr == 1) PG8_BAR; }
    }
    PG8_WAIT_V(0);
    if constexpr (!ALIGN_EPI) { if (wr == 0) PG8_BAR; }
    PG8_BAR;
    if constexpr (Epi::AFTER_DRAIN) { E.fused(acc, cur, wr, wc, fr, fq, lds, wid, lane); S.done(cur); }
#undef PG8_SA
#undef PG8_SB
#undef PG8_STAGE
#undef PG8_LDA
#undef PG8_LDB
#undef PG8_MMA
#undef PG8_WAIT_V
#undef PG8_WAIT_L
#undef PG8_BAR
#undef PG8_SCHED
}
}

#define GAS __attribute__((address_space(1)))
#define LAS __attribute__((address_space(3)))
typedef unsigned short bf16;
typedef unsigned v4u __attribute__((ext_vector_type(4)));
typedef unsigned v2u __attribute__((ext_vector_type(2)));
typedef float f32x4 __attribute__((ext_vector_type(4)));
typedef float f32x2 __attribute__((ext_vector_type(2)));
typedef float f32x16 __attribute__((ext_vector_type(16)));
typedef short bf16x8 __attribute__((ext_vector_type(8)));
typedef short s16x4 __attribute__((ext_vector_type(4)));
typedef __bf16 bf16x2_t __attribute__((ext_vector_type(2)));

constexpr int NB = 16, LSEQ = 4096, DM = 1024, DEPTH = 4, CTXL = 256;
constexpr int TL = NB * LSEQ, TC = NB * CTXL, TT = TL + TC;
constexpr int NIN = 5664, FF = 2816, N1 = 2304, N2 = 3584, NU = 5632;
constexpr float LN_EPS = 1e-6f;
constexpr float ALPHA = 1.681792830507429f;
constexpr size_t MiB = (size_t)1 << 20;
constexpr size_t WS_POS = 0, WS_MOD = 1 * MiB, WS_W1T = 3 * MiB, WS_W2T = 21 * MiB, WS_WPT = 49 * MiB, WS_WGT = 53 * MiB, WS_WOT = 61 * MiB,
                 WS_WUT = 69 * MiB, WS_WDT = 113 * MiB, WS_XC = 135 * MiB, WS_UX = 151 * MiB, WS_R = 287 * MiB;
constexpr size_t SU = 68 * MiB;
static_assert((size_t)TT * 512 * 2 == SU, "SU");
constexpr size_t R_Q = 0, R_K = SU, R_V = 2 * SU, R_OF = 4 * SU, R_OB = 6 * SU, R_Z = 8 * SU;
constexpr size_t R_POOL = 0, R_GP = SU, R_GG = 578 * MiB, R_POOLED = 3 * SU;
constexpr size_t R_HID = 0;
constexpr size_t WS_STATS = WS_R + 561 * MiB;
constexpr size_t WS_END = WS_R + 716 * MiB;
static_assert(R_GG >= 8 * SU + 5 * MiB && WS_STATS + MiB <= WS_R + R_GG && R_GG + 2 * SU <= 716 * MiB, "R map");
constexpr int LDS_BYTES = 147456;
constexpr int NTHREADS = 512;

__device__ __forceinline__ unsigned cvtpk(float lo, float hi) { f32x2 v = {lo, hi}; bf16x2_t b = __builtin_convertvector(v, bf16x2_t); return __builtin_bit_cast(unsigned, b); }
__device__ __forceinline__ float bflo(unsigned u) { return __uint_as_float(u << 16); }
__device__ __forceinline__ float bfhi(unsigned u) { return __uint_as_float(u & 0xffff0000u); }
__device__ __forceinline__ float sigmoidf_(float x) { return __builtin_amdgcn_rcpf(1.0f + __expf(-x)); }
__device__ __forceinline__ int lane_id_v() { int l; asm volatile("v_mbcnt_lo_u32_b32 %0, -1, 0\n\tv_mbcnt_hi_u32_b32 %0, -1, %0" : "=v"(l)); return l; }
__device__ __forceinline__ float wave_sum(float v, int lane) {
#pragma unroll
    for (int o = 1; o < 64; o <<= 1) v += __int_as_float(__builtin_amdgcn_ds_bpermute((lane ^ o) << 2, __float_as_int(v)));
    return v;
}
__device__ __forceinline__ float half_sum(float v, int lane) {
#pragma unroll
    for (int o = 1; o < 32; o <<= 1) v += __int_as_float(__builtin_amdgcn_ds_bpermute((lane ^ o) << 2, __float_as_int(v)));
    return v;
}

struct RangeOrder {
    int nM, nN, nwg, G, c;
    __device__ void init(int nM_, int nN_, int G_, int c_) { nM = nM_; nN = nN_; nwg = nM * nN; G = G_; c = c_; }
    __device__ bool next(int i, pg8::Unit& u) const {
        const long L = (long)i * G + c; if (L >= nwg) return false;
        int wgid = (int)L; { const int q = nwg / pg8::NXCD, r = nwg % pg8::NXCD, xcd = wgid % pg8::NXCD, off = wgid / pg8::NXCD; wgid = (xcd < r ? xcd * (q + 1) : r * (q + 1) + (xcd - r) * q) + off; }
        const int nig = pg8::WGM * nN, gid = wgid / nig, fm = gid * pg8::WGM, gsz = (nM - fm) < pg8::WGM ? (nM - fm) : pg8::WGM;
        u.pm = fm + ((wgid % nig) % gsz); u.pn = (wgid % nig) / gsz; return true;
    }
    __device__ __forceinline__ void a_ready(const pg8::Unit&) const {}
    __device__ __forceinline__ void done(const pg8::Unit&) const {}
};

typedef pg8::f32x4 af4;
#define EPI_LOOP for (int ai = 0; ai < 2; ++ai) _Pragma("unroll") for (int m = 0; m < 4; ++m) _Pragma("unroll") for (int bj = 0; bj < 2; ++bj)
#define EPI_RR(base_) int RR = (base_) + ai * 128 + m * 16; asm volatile("" : "+v"(RR));

struct EpiA1 {
    static constexpr bool PERM = true, AFTER_DRAIN = false;
    bf16 *Q, *K, *V, *Z;
    __device__ __forceinline__ void operator()(const af4 (&acc)[2][2][4][2], const pg8::Unit& u, int wr, int wc, int fr_, int fq_) const {
        const int ln_ = lane_id_v(); const int fr = ln_ & 15, fq = ln_ >> 4;
        const int row0 = u.pm * 256 + wr * 64 + fr, pn = u.pn;
        if (pn < 8) {
            bf16* base; int ldc, colt; float sc = 1.f;
            if (pn < 2) { base = Q; ldc = 512; colt = pn * 256; sc = 0.08838834764831845f; }
            else if (pn < 4) { base = K; ldc = 512; colt = (pn - 2) * 256; }
            else { base = V; ldc = 1024; colt = (pn - 4) * 256; }
            const int col0 = colt + wc * 32 + 8 * fq;
#pragma unroll
            EPI_LOOP { EPI_RR(row0) const af4 v0 = acc[ai][bj][m][0] * sc, v1 = acc[ai][bj][m][1] * sc; v4u w; w.x = cvtpk(v0[0], v0[1]); w.y = cvtpk(v0[2], v0[3]); w.z = cvtpk(v1[0], v1[1]); w.w = cvtpk(v1[2], v1[3]);
                *(v4u*)(base + (size_t)RR * ldc + col0 + bj * 128) = w; }
        } else if (wc == 0) {
#pragma unroll
            for (int ai = 0; ai < 2; ++ai)
#pragma unroll
                for (int m = 0; m < 4; ++m) { const af4 v0 = acc[ai][0][m][0], v1 = acc[ai][0][m][1]; v4u w; w.x = cvtpk(v0[0], v0[1]); w.y = cvtpk(v0[2], v0[3]); w.z = cvtpk(v1[0], v1[1]); w.w = cvtpk(v1[2], v1[3]);
                    *(v4u*)(Z + (size_t)(row0 + ai * 128 + m * 16) * 32 + 8 * fq) = w; }
        }
    }
};
struct EpiA2 {
    static constexpr bool PERM = true, AFTER_DRAIN = false;
    bf16 *POOL, *ON, *GP, *GG; const bf16* OBp; const float* nw; LAS float* xch;
    __device__ __forceinline__ void operator()(const af4 (&acc)[2][2][4][2], const pg8::Unit& u, int wr, int wc, int fr_, int fq_) const {
        const int ln_ = lane_id_v(); const int fr = ln_ & 15, fq = ln_ >> 4;
        const int row0 = u.pm * 256 + wr * 64 + fr, pn = u.pn;
        if (pn < 2) {
            const int col0 = pn * 256 + wc * 32 + 8 * fq;
#pragma unroll
            EPI_LOOP { EPI_RR(row0) const af4 v0 = acc[ai][bj][m][0], v1 = acc[ai][bj][m][1]; v4u w; w.x = cvtpk(v0[0], v0[1]); w.y = cvtpk(v0[2], v0[3]); w.z = cvtpk(v1[0], v1[1]); w.w = cvtpk(v1[2], v1[3]);
                *(v4u*)(POOL + (size_t)RR * 512 + col0 + bj * 128) = w; }
        } else if (pn < 6) {
            const int col0 = (pn - 2) * 256 + wc * 32 + 8 * fq;
            float ssq[8];
#pragma unroll
            for (int b_ = 0; b_ < 4; ++b_) {
                const int ai = b_ >> 1, mp = b_ & 1;
                int RRb = row0 + ai * 128 + mp * 32; asm volatile("" : "+v"(RRb));
                const size_t ob = (size_t)RRb * 1024 + col0; v4u of_[2][2], ob_[2][2];
#pragma unroll
                for (int mi = 0; mi < 2; ++mi)
#pragma unroll
                    for (int bj = 0; bj < 2; ++bj) { of_[mi][bj] = *(const v4u*)(ON + ob + mi * 16 * 1024 + bj * 128); ob_[mi][bj] = *(const v4u*)(OBp + ob + mi * 16 * 1024 + bj * 128); }
#pragma unroll
                for (int mi = 0; mi < 2; ++mi) { float q = 0.f;
#pragma unroll
                    for (int bj = 0; bj < 2; ++bj) { const v4u a = of_[mi][bj], c = ob_[mi][bj];
                        const float o0 = bflo(a.x) + bflo(c.x), o1 = bfhi(a.x) + bfhi(c.x), o2 = bflo(a.y) + bflo(c.y), o3 = bfhi(a.y) + bfhi(c.y), o4 = bflo(a.z) + bflo(c.z), o5 = bfhi(a.z) + bfhi(c.z), o6 = bflo(a.w) + bflo(c.w), o7 = bfhi(a.w) + bfhi(c.w);
                        q += (o0 * o0 + o1 * o1) + (o2 * o2 + o3 * o3) + (o4 * o4 + o5 * o5) + (o6 * o6 + o7 * o7); }
                    ssq[ai * 4 + mp * 2 + mi] = q; }
                asm volatile("" ::: "memory");
            }
#pragma unroll
            for (int k = 0; k < 8; ++k) { float v = ssq[k];
                v += __int_as_float(__builtin_amdgcn_ds_bpermute((ln_ ^ 16) << 2, __float_as_int(v)));
                v += __int_as_float(__builtin_amdgcn_ds_bpermute((ln_ ^ 32) << 2, __float_as_int(v))); ssq[k] = v; }
            if (fq == 0) {
#pragma unroll
                for (int k = 0; k < 8; ++k) xch[((k >> 2) * 128 + wr * 64 + (k & 3) * 16 + fr) * 4 + wc] = ssq[k];
            }
            asm volatile("s_waitcnt lgkmcnt(0)" ::: "memory"); __builtin_amdgcn_s_barrier(); asm volatile("" ::: "memory");
            float rs[8];
#pragma unroll
            for (int k = 0; k < 8; ++k) { const f32x4 p4 = *(const LAS f32x4*)(xch + ((k >> 2) * 128 + wr * 64 + (k & 3) * 16 + fr) * 4);
                rs[k] = 1.0f / sqrtf(((p4[0] + p4[1]) + (p4[2] + p4[3])) * (1.f / 256.f) + LN_EPS); }
            f32x4 nwv[2][2];
#pragma unroll
            for (int bj = 0; bj < 2; ++bj) { nwv[bj][0] = *(const f32x4*)(nw + col0 + bj * 128); nwv[bj][1] = *(const f32x4*)(nw + col0 + bj * 128 + 4); }
#pragma unroll
            for (int b_ = 0; b_ < 4; ++b_) {
                const int ai = b_ >> 1, mp = b_ & 1;
                int RRb = row0 + ai * 128 + mp * 32; asm volatile("" : "+v"(RRb));
                const size_t ob = (size_t)RRb * 1024 + col0; v4u of_[2][2], ob_[2][2];
#pragma unroll
                for (int mi = 0; mi < 2; ++mi)
#pragma unroll
                    for (int bj = 0; bj < 2; ++bj) { of_[mi][bj] = *(const v4u*)(ON + ob + mi * 16 * 1024 + bj * 128); ob_[mi][bj] = *(const v4u*)(OBp + ob + mi * 16 * 1024 + bj * 128); }
#pragma unroll
                for (int mi = 0; mi < 2; ++mi) { const float rstd = rs[ai * 4 + mp * 2 + mi];
#pragma unroll
                    for (int bj = 0; bj < 2; ++bj) { af4 v0 = acc[ai][bj][mp * 2 + mi][0], v1 = acc[ai][bj][mp * 2 + mi][1]; asm volatile("" : "+v"(v0), "+v"(v1)); const v4u a = of_[mi][bj], c = ob_[mi][bj];
#pragma unroll
                        for (int e = 0; e < 4; ++e) { v0[e] = v0[e] * sigmoidf_(v0[e]) * (rstd * nwv[bj][0][e]); v1[e] = v1[e] * sigmoidf_(v1[e]) * (rstd * nwv[bj][1][e]); }
                        v4u w; w.x = cvtpk(v0[0] * (bflo(a.x) + bflo(c.x)), v0[1] * (bfhi(a.x) + bfhi(c.x))); w.y = cvtpk(v0[2] * (bflo(a.y) + bflo(c.y)), v0[3] * (bfhi(a.y) + bfhi(c.y)));
                        w.z = cvtpk(v1[0] * (bflo(a.z) + bflo(c.z)), v1[1] * (bfhi(a.z) + bfhi(c.z))); w.w = cvtpk(v1[2] * (bflo(a.w) + bflo(c.w)), v1[3] * (bfhi(a.w) + bfhi(c.w)));
                        *(v4u*)(ON + ob + mi * 16 * 1024 + bj * 128) = w; } }
                asm volatile("" ::: "memory");
            }
        } else {
            bf16* base = pn < 10 ? GP : GG; const int col0 = ((pn - 6) & 3) * 256 + wc * 32 + 8 * fq;
#pragma unroll
            EPI_LOOP { EPI_RR(row0) af4 v0 = acc[ai][bj][m][0], v1 = acc[ai][bj][m][1];
#pragma unroll
                for (int e = 0; e < 4; ++e) { v0[e] = sigmoidf_(v0[e]); v1[e] = sigmoidf_(v1[e]); }
                v4u w; w.x = cvtpk(v0[0], v0[1]); w.y = cvtpk(v0[2], v0[3]); w.z = cvtpk(v1[0], v1[1]); w.w = cvtpk(v1[2], v1[3]);
                *(v4u*)(base + (size_t)RR * 1024 + col0 + bj * 128) = w; asm volatile("" ::: "memory"); }
        }
    }
};
struct EpiMul {
    static constexpr bool PERM = true, AFTER_DRAIN = false;
    bf16* G;
    __device__ __forceinline__ void operator()(const af4 (&acc)[2][2][4][2], const pg8::Unit& u, int wr, int wc, int fr_, int fq_) const {
        const int ln_ = lane_id_v(); const int fr = ln_ & 15, fq = ln_ >> 4;
        const int row0 = u.pm * 256 + wr * 64 + fr, col0 = u.pn * 256 + wc * 32 + 8 * fq;
        v4u o[2][2][2];
#define MUL_LOAD(buf, b_) do { int RRl = row0 + ((b_) >> 1) * 128 + ((b_) & 1) * 32; asm volatile("" : "+v"(RRl)); const bf16* pl = G + (size_t)RRl * 1024 + col0; \
            _Pragma("unroll") for (int mi = 0; mi < 2; ++mi) _Pragma("unroll") for (int bj = 0; bj < 2; ++bj) o[buf][mi][bj] = *(const v4u*)(pl + mi * 16 * 1024 + bj * 128); } while (0)
        MUL_LOAD(0, 0);
#pragma unroll
        for (int b_ = 0; b_ < 4; ++b_) {
            const int ai = b_ >> 1, mp = b_ & 1, cur = b_ & 1;
            if (b_ + 1 < 4) { if (cur == 0) MUL_LOAD(1, b_ + 1); else MUL_LOAD(0, b_ + 1); }
            int RRb = row0 + ai * 128 + mp * 32; asm volatile("" : "+v"(RRb));
            bf16* pb = G + (size_t)RRb * 1024 + col0;
#pragma unroll
            for (int mi = 0; mi < 2; ++mi)
#pragma unroll
                for (int bj = 0; bj < 2; ++bj) { const af4 v0 = acc[ai][bj][mp * 2 + mi][0], v1 = acc[ai][bj][mp * 2 + mi][1]; const v4u oo = o[cur][mi][bj];
                    v4u w; w.x = cvtpk(v0[0] * bflo(oo.x), v0[1] * bfhi(oo.x)); w.y = cvtpk(v0[2] * bflo(oo.y), v0[3] * bfhi(oo.y)); w.z = cvtpk(v1[0] * bflo(oo.z), v1[1] * bfhi(oo.z)); w.w = cvtpk(v1[2] * bflo(oo.w), v1[3] * bfhi(oo.w));
                    *(v4u*)(pb + mi * 16 * 1024 + bj * 128) = w; }
            asm volatile("" ::: "memory");
        }
#undef MUL_LOAD
    }
};
struct EpiMulAdd {
    static constexpr bool PERM = true, AFTER_DRAIN = false;
    bf16* G; const bf16* Y;
    __device__ __forceinline__ void operator()(const af4 (&acc)[2][2][4][2], const pg8::Unit& u, int wr, int wc, int fr_, int fq_) const {
        const int ln_ = lane_id_v(); const int fr = ln_ & 15, fq = ln_ >> 4;
        const int row0 = u.pm * 256 + wr * 64 + fr, col0 = u.pn * 256 + wc * 32 + 8 * fq;
        v4u o[2][2][2], yv[2][2][2];
#define MA_LOAD(buf, b_) do { int RRl = row0 + ((b_) >> 1) * 128 + ((b_) & 1) * 32; asm volatile("" : "+v"(RRl)); const size_t ol = (size_t)RRl * 1024 + col0; \
            _Pragma("unroll") for (int mi = 0; mi < 2; ++mi) _Pragma("unroll") for (int bj = 0; bj < 2; ++bj) { o[buf][mi][bj] = *(const v4u*)(G + ol + mi * 16 * 1024 + bj * 128); yv[buf][mi][bj] = *(const v4u*)(Y + ol + mi * 16 * 1024 + bj * 128); } } while (0)
        MA_LOAD(0, 0);
#pragma unroll
        for (int b_ = 0; b_ < 4; ++b_) {
            const int ai = b_ >> 1, mp = b_ & 1, cur = b_ & 1;
            if (b_ + 1 < 4) { if (cur == 0) MA_LOAD(1, b_ + 1); else MA_LOAD(0, b_ + 1); }
            int RRb = row0 + ai * 128 + mp * 32; asm volatile("" : "+v"(RRb));
            const size_t ob = (size_t)RRb * 1024 + col0;
#pragma unroll
            for (int mi = 0; mi < 2; ++mi)
#pragma unroll
                for (int bj = 0; bj < 2; ++bj) { const af4 v0 = acc[ai][bj][mp * 2 + mi][0], v1 = acc[ai][bj][mp * 2 + mi][1]; const v4u oo = o[cur][mi][bj], y = yv[cur][mi][bj];
                    v4u w; w.x = cvtpk(bflo(y.x) + v0[0] * bflo(oo.x), bfhi(y.x) + v0[1] * bfhi(oo.x)); w.y = cvtpk(bflo(y.y) + v0[2] * bflo(oo.y), bfhi(y.y) + v0[3] * bfhi(oo.y));
                    w.z = cvtpk(bflo(y.z) + v1[0] * bflo(oo.z), bfhi(y.z) + v1[1] * bfhi(oo.z)); w.w = cvtpk(bflo(y.w) + v1[2] * bflo(oo.w), bfhi(y.w) + v1[3] * bfhi(oo.w));
                    *(v4u*)(G + ob + mi * 16 * 1024 + bj * 128) = w; }
            asm volatile("" ::: "memory");
        }
#undef MA_LOAD
    }
};
struct EpiRes {
    static constexpr bool PERM = true, AFTER_DRAIN = false;
    float* xl; float* xc; const float* gate; int rowbase; const float* stats; const float* lnw; const float* lnb;
    __device__ __forceinline__ void operator()(const af4 (&acc)[2][2][4][2], const pg8::Unit& u, int wr, int wc, int fr_, int fq_) const {
        const int ln_ = lane_id_v(); const int fr = ln_ & 15, fq = ln_ >> 4;
        const int grow = rowbase + u.pm * 256; const int bi = grow < TL ? grow / LSEQ : NB;
        float* xb = grow < TL ? xl + (size_t)grow * DM : xc + (size_t)(grow - TL) * DM;
        const float* stb = stats + 2 * (size_t)grow;
        const int col0 = u.pn * 256 + wc * 32 + 8 * fq; const float* gp = gate + (size_t)bi * 6144 + col0;
        f32x4 g[2][2], wa[2][2], ba[2][2];
#pragma unroll
        for (int bj = 0; bj < 2; ++bj)
#pragma unroll
            for (int hf = 0; hf < 2; ++hf) { g[bj][hf] = *(const f32x4*)(gp + bj * 128 + 4 * hf);
                if (lnw) { wa[bj][hf] = *(const f32x4*)(lnw + col0 + bj * 128 + 4 * hf) * ALPHA; ba[bj][hf] = *(const f32x4*)(lnb + col0 + bj * 128 + 4 * hf) * ALPHA; }
                else { wa[bj][hf] = (f32x4){ALPHA, ALPHA, ALPHA, ALPHA}; ba[bj][hf] = (f32x4){0.f, 0.f, 0.f, 0.f}; } }
        const int row0 = wr * 64 + fr;
#pragma unroll
        for (int b_ = 0; b_ < 4; ++b_) {
            const int ai = b_ >> 1, mp = b_ & 1;
            int RRb = row0 + ai * 128 + mp * 32; asm volatile("" : "+v"(RRb));
            float* pb = xb + (size_t)RRb * DM + col0;
            f32x4 xv[2][2][2]; f32x2 st[2];
#pragma unroll
            for (int mi = 0; mi < 2; ++mi) { st[mi] = *(const f32x2*)(stb + 2 * (RRb + mi * 16));
#pragma unroll
                for (int bj = 0; bj < 2; ++bj) { xv[mi][bj][0] = *(const f32x4*)(pb + mi * 16 * DM + bj * 128); xv[mi][bj][1] = *(const f32x4*)(pb + mi * 16 * DM + bj * 128 + 4); } }
#pragma unroll
            for (int mi = 0; mi < 2; ++mi)
#pragma unroll
                for (int bj = 0; bj < 2; ++bj) { f32x4 o0, o1; const float mean = st[mi].x, rstd = st[mi].y;
#pragma unroll
                    for (int e = 0; e < 4; ++e) {
                        o0[e] = (xv[mi][bj][0][e] - mean) * (wa[bj][0][e] * rstd) + (ba[bj][0][e] + g[bj][0][e] * acc[ai][bj][mp * 2 + mi][0][e]);
                        o1[e] = (xv[mi][bj][1][e] - mean) * (wa[bj][1][e] * rstd) + (ba[bj][1][e] + g[bj][1][e] * acc[ai][bj][mp * 2 + mi][1][e]); }
                    *(f32x4*)(pb + mi * 16 * DM + bj * 128) = o0; *(f32x4*)(pb + mi * 16 * DM + bj * 128 + 4) = o1; }
            asm volatile("" ::: "memory");
        }
    }
};
struct EpiUp {
    static constexpr bool PERM = true, AFTER_DRAIN = false;
    bf16* UP;
    __device__ __forceinline__ void operator()(const af4 (&acc)[2][2][4][2], const pg8::Unit& u, int wr, int wc, int fr_, int fq_) const {
        const int ln_ = lane_id_v(); const int fr = ln_ & 15, fq = ln_ >> 4;
        const int row0 = u.pm * 256 + wr * 64 + fr, col0 = u.pn * 256 + wc * 32 + 8 * fq;
#pragma unroll
        EPI_LOOP { EPI_RR(row0) const af4 v0 = acc[ai][bj][m][0], v1 = acc[ai][bj][m][1]; v4u w; w.x = cvtpk(v0[0], v0[1]); w.y = cvtpk(v0[2], v0[3]); w.z = cvtpk(v1[0], v1[1]); w.w = cvtpk(v1[2], v1[3]);
            *(v4u*)(UP + (size_t)RR * NU + col0 + bj * 128) = w; }
    }
};


__device__ __forceinline__ float gelu_erf(float v) {
    const float av = fabsf(v), t = __builtin_amdgcn_rcpf(av * 0.2316418882f + 1.0f);
    float q = t * 0.5307027145f + (-0.7265760135f); q = q * t + 0.7107068705f; q = q * t + (-0.142248368f); q = q * t + 0.127414796f; q = q * t;
    const float e = __builtin_amdgcn_exp2f((v * v) * (-0.72134752044f));
    const float mm = v * (q * e);
    return v < 0.f ? mm : v - mm;
}

__device__ __forceinline__ f32x2 gelu_pk(f32x2 v) {
    const f32x2 av = __builtin_elementwise_abs(v), d = av * 0.2316418882f + 1.0f;
    f32x2 t; t.x = __builtin_amdgcn_rcpf(d.x); t.y = __builtin_amdgcn_rcpf(d.y);
    f32x2 q = t * 0.5307027145f + (-0.7265760135f); q = q * t + 0.7107068705f; q = q * t + (-0.142248368f); q = q * t + 0.127414796f; q = q * t;
    const f32x2 sq = (v * v) * (-0.72134752044f);
    f32x2 e; e.x = __builtin_amdgcn_exp2f(sq.x); e.y = __builtin_amdgcn_exp2f(sq.y);
    const f32x2 mm = v * (q * e), rr = v - mm;
    f32x2 o; o.x = v.x < 0.f ? mm.x : rr.x; o.y = v.y < 0.f ? mm.y : rr.y; return o;
}
#define DPP_ROR1(x) __int_as_float(__builtin_amdgcn_update_dpp(0, __float_as_int(x), 0x121, 0xf, 0xf, false))
#define DPP_ROR15(x) __int_as_float(__builtin_amdgcn_update_dpp(0, __float_as_int(x), 0x12F, 0xf, 0xf, false))
struct EpiUpConv {
    static constexpr bool PERM = true, AFTER_DRAIN = false;
    bf16* HID; const float* cw; const float* cb; LAS float* xch;
    __device__ __forceinline__ void operator()(const af4 (&acc)[2][2][4][2], const pg8::Unit& u, int wr, int wc, int fr_, int fq_) const {
        const int ln_ = lane_id_v(); const int fr = ln_ & 15, fq = ln_ >> 4;
        const int row0 = u.pm * 256 + wr * 64 + fr, jl = 32 * wc + 8 * fq, j0 = 128 * u.pn + jl;
        const bool isctx = u.pm >= TL / 256;
        f32x4 cwv[2][4];
#pragma unroll
        for (int n = 0; n < 2; ++n) { cwv[n][0] = *(const f32x4*)(cw + j0 + 4 * n); cwv[n][1] = *(const f32x4*)(cw + FF + j0 + 4 * n); cwv[n][2] = *(const f32x4*)(cw + 2 * FF + j0 + 4 * n); cwv[n][3] = *(const f32x4*)(cb + j0 + 4 * n); }
        if (isctx) {
#pragma unroll
            for (int ai = 0; ai < 2; ++ai) { const int blk = 2 * ai + wr;
                if (fr == 0) { *(LAS f32x4*)(xch + (blk * 2 + 0) * 128 + jl) = acc[ai][0][0][0]; *(LAS f32x4*)(xch + (blk * 2 + 0) * 128 + jl + 4) = acc[ai][0][0][1]; }
                if (fr == 15) { *(LAS f32x4*)(xch + (blk * 2 + 1) * 128 + jl) = acc[ai][0][3][0]; *(LAS f32x4*)(xch + (blk * 2 + 1) * 128 + jl + 4) = acc[ai][0][3][1]; } }
            asm volatile("s_waitcnt lgkmcnt(0)" ::: "memory"); __builtin_amdgcn_s_barrier(); asm volatile("" ::: "memory");
        }
#pragma unroll
        for (int ai = 0; ai < 2; ++ai)
#pragma unroll
            for (int n = 0; n < 2; ++n) {
                const f32x4 w0 = cwv[n][0], w1 = cwv[n][1], w2 = cwv[n][2], bb = cwv[n][3];
                f32x4 bprev = {0.f, 0.f, 0.f, 0.f}, bnext = {0.f, 0.f, 0.f, 0.f};
                if (isctx) { const int blk = 2 * ai + wr;
                    if (blk > 0) bprev = *(const LAS f32x4*)(xch + ((blk - 1) * 2 + 1) * 128 + jl + 4 * n);
                    if (blk < 3) bnext = *(const LAS f32x4*)(xch + ((blk + 1) * 2 + 0) * 128 + jl + 4 * n); }
                f32x4 R[4], L[4];
#pragma unroll
                for (int m = 0; m < 4; ++m)
#pragma unroll
                    for (int e = 0; e < 4; ++e) { R[m][e] = DPP_ROR1(acc[ai][0][m][n][e]); L[m][e] = DPP_ROR15(acc[ai][0][m][n][e]); }
#pragma unroll
                for (int m = 0; m < 4; ++m) {
                    f32x2 o2[2];
#pragma unroll
                    for (int ep = 0; ep < 2; ++ep) {
                        f32x2 pv, nv;
#pragma unroll
                        for (int q = 0; q < 2; ++q) { const int e = 2 * ep + q;
                            pv[q] = (fr == 0) ? (m == 0 ? bprev[e] : R[m == 0 ? 0 : m - 1][e]) : R[m][e];
                            nv[q] = (fr == 15) ? (m == 3 ? bnext[e] : L[m == 3 ? 3 : m + 1][e]) : L[m][e]; }
                        const f32x2 a2 = {acc[ai][0][m][n][2 * ep], acc[ai][0][m][n][2 * ep + 1]}, g2 = {acc[ai][1][m][n][2 * ep], acc[ai][1][m][n][2 * ep + 1]};
                        const f32x2 w0p = {w0[2 * ep], w0[2 * ep + 1]}, w1p = {w1[2 * ep], w1[2 * ep + 1]}, w2p = {w2[2 * ep], w2[2 * ep + 1]}, bbp = {bb[2 * ep], bb[2 * ep + 1]};
                        const f32x2 c2 = w0p * pv + (w1p * a2 + (w2p * nv + bbp));
                        o2[ep] = gelu_pk(c2) * g2;
                    }
                    v2u w; w.x = cvtpk(o2[0].x, o2[0].y); w.y = cvtpk(o2[1].x, o2[1].y);
                    *(v2u*)(HID + (size_t)(row0 + ai * 128 + m * 16) * FF + j0 + 4 * n) = w;
                }
            }
    }
};
template <class Epi, bool ALIGN = false> __device__ __forceinline__ void run_gemm(LAS unsigned char* lds, const bf16* A, const bf16* Bt, int nM, int N, int K, const Epi& E, const int wave_s) {
    pg8::Gemm g{A, Bt, nM * 256, N, K}; RangeOrder S; S.init(nM, N / 256, (int)gridDim.x, (int)blockIdx.x);
    pg8::gemm_phase<Epi, RangeOrder, ALIGN, true>(lds, g, S, E, wave_s);
}

__device__ __forceinline__ void transpose_block(const float* W, int ldw, int src_n0, int k0, bf16* WT, int K, int dst_n0, LAS float* scr, int lane) {
    if (src_n0 >= 0) {
#pragma unroll
        for (int i = 0; i < 32; ++i) { const int kk = 2 * i + (lane >> 5); scr[kk * 33 + (lane & 31)] = W[(size_t)(k0 + kk) * ldw + src_n0 + (lane & 31)]; }
    } else {
#pragma unroll 8
        for (int i = 0; i < 32; ++i) { const int kk = 2 * i + (lane >> 5); scr[kk * 33 + (lane & 31)] = 0.f; }
    }
    asm volatile("s_waitcnt lgkmcnt(0)" ::: "memory");
    const int c = lane & 7;
#pragma unroll
    for (int j = 0; j < 4; ++j) { const int n = (lane >> 3) + 8 * j; const LAS float* s = scr + (8 * c) * 33 + n;
        v4u o; o.x = cvtpk(s[0 * 33], s[1 * 33]); o.y = cvtpk(s[2 * 33], s[3 * 33]); o.z = cvtpk(s[4 * 33], s[5 * 33]); o.w = cvtpk(s[6 * 33], s[7 * 33]);
        *(v4u*)(WT + (size_t)(dst_n0 + n) * K + k0 + 8 * c) = o; }
    asm volatile("s_waitcnt lgkmcnt(0)" ::: "memory");
}

struct P {
    const float* in[25]; float* out; unsigned char* ws;
};

__device__ __forceinline__ void ln_core(f32x4 (&v)[4], int lane) {
    float s = 0.f;
#pragma unroll
    for (int j = 0; j < 4; ++j) s += (v[j][0] + v[j][1]) + (v[j][2] + v[j][3]);
    const float mean = wave_sum(s, lane) * (1.f / DM); float s2 = 0.f;
#pragma unroll
    for (int j = 0; j < 4; ++j) { v[j] = v[j] - mean; s2 += (v[j][0] * v[j][0] + v[j][1] * v[j][1]) + (v[j][2] * v[j][2] + v[j][3] * v[j][3]); }
    const float rstd = 1.0f / sqrtf(wave_sum(s2, lane) * (1.f / DM) + LN_EPS);
#pragma unroll
    for (int j = 0; j < 4; ++j) v[j] = v[j] * rstd;
}
__device__ __forceinline__ void store_x_ux(const f32x4 (&v)[4], float* xrow, bf16* uxrow, const float* sh, const float* sc, int lane) {
#pragma unroll
    for (int j = 0; j < 4; ++j) {
        const int c = 4 * lane + 256 * j;
        *(f32x4*)(xrow + c) = v[j];
        if (uxrow) { const f32x4 a = *(const f32x4*)(sc + c), b = *(const f32x4*)(sh + c);
            v2u w; w.x = cvtpk(v[j][0] * (1.f + a[0]) + b[0], v[j][1] * (1.f + a[1]) + b[1]); w.y = cvtpk(v[j][2] * (1.f + a[2]) + b[2], v[j][3] * (1.f + a[3]) + b[3]);
            *(v2u*)(uxrow + c) = w; }
    }
}


__device__ __forceinline__ float dpp_row_total(float v) {
    v += __int_as_float(__builtin_amdgcn_update_dpp(0, __float_as_int(v), 0xB1, 0xf, 0xf, false));
    v += __int_as_float(__builtin_amdgcn_update_dpp(0, __float_as_int(v), 0x4E, 0xf, 0xf, false));
    v += __int_as_float(__builtin_amdgcn_update_dpp(0, __float_as_int(v), 0x141, 0xf, 0xf, false));
    v += __int_as_float(__builtin_amdgcn_update_dpp(0, __float_as_int(v), 0x140, 0xf, 0xf, false));
    return v;
}
__device__ __forceinline__ float wave_sum_dpp(float v) {
    v = dpp_row_total(v); const int i = __float_as_int(v);
    return (__int_as_float(__builtin_amdgcn_readlane(i, 0)) + __int_as_float(__builtin_amdgcn_readlane(i, 16))) + (__int_as_float(__builtin_amdgcn_readlane(i, 32)) + __int_as_float(__builtin_amdgcn_readlane(i, 48)));
}
__device__ __forceinline__ float half_sum_dpp(float v, int lane) {
    v = dpp_row_total(v); const int i = __float_as_int(v);
    const float t0 = __int_as_float(__builtin_amdgcn_readlane(i, 0)) + __int_as_float(__builtin_amdgcn_readlane(i, 16));
    const float t1 = __int_as_float(__builtin_amdgcn_readlane(i, 32)) + __int_as_float(__builtin_amdgcn_readlane(i, 48));
    return lane < 32 ? t0 : t1;
}
__device__ __forceinline__ void ln_phase(const int lane, const int gw, const int NGW, const int rows, float* xl, float* xcp, const float* lw, const float* lb,
                                         const float* modl, const int sh_off, const int sc_off, bf16* UXp, const float* x_init, const float* ctx_init, const float* POSp, float* stats, const bool final_x) {
    for (int row0 = gw * 4; row0 < rows; row0 += NGW * 4) {
        f32x4 v[4][4]; const bool lat = row0 < TL; const int bi = lat ? row0 / LSEQ : NB;
#pragma unroll
        for (int rr = 0; rr < 4; ++rr) { const int row = row0 + rr;
            const float* src = x_init ? (lat ? x_init + (size_t)row * DM : ctx_init + (size_t)(row - TL) * DM) : (lat ? xl + (size_t)row * DM : xcp + (size_t)(row - TL) * DM);
#pragma unroll
            for (int j = 0; j < 4; ++j) v[rr][j] = __builtin_nontemporal_load((const f32x4*)(src + 4 * lane + 256 * j)); }
        if (x_init && lat) {
#pragma unroll
            for (int rr = 0; rr < 4; ++rr) { const int t = (row0 + rr) % LSEQ; const float* e0 = POSp + (t >> 6) * 512; const float* e1 = POSp + (t & 63) * 512;
#pragma unroll
                for (int j = 0; j < 4; ++j) { const int c = 4 * lane + 256 * j; v[rr][j] += (j < 2) ? *(const f32x4*)(e0 + c) : *(const f32x4*)(e1 + c - 512); } }
        }
        if (x_init) {
#pragma unroll
            for (int rr = 0; rr < 4; ++rr) { const int row = row0 + rr; float* dst = lat ? xl + (size_t)row * DM : xcp + (size_t)(row - TL) * DM;
#pragma unroll
                for (int j = 0; j < 4; ++j) *(f32x4*)(dst + 4 * lane + 256 * j) = v[rr][j]; }
        }
        float mean[4], rstd[4];
#pragma unroll
        for (int rr = 0; rr < 4; ++rr) { float s = 0.f;
#pragma unroll
            for (int j = 0; j < 4; ++j) s += (v[rr][j][0] + v[rr][j][1]) + (v[rr][j][2] + v[rr][j][3]);
            mean[rr] = wave_sum_dpp(s) * (1.f / DM); }
#pragma unroll
        for (int rr = 0; rr < 4; ++rr) { float s2 = 0.f;
#pragma unroll
            for (int j = 0; j < 4; ++j) { v[rr][j] = v[rr][j] - mean[rr]; s2 += (v[rr][j][0] * v[rr][j][0] + v[rr][j][1] * v[rr][j][1]) + (v[rr][j][2] * v[rr][j][2] + v[rr][j][3] * v[rr][j][3]); }
            rstd[rr] = 1.0f / sqrtf(wave_sum_dpp(s2) * (1.f / DM) + LN_EPS); }
        if (lane == 0) {
#pragma unroll
            for (int rr = 0; rr < 4; ++rr) *(f32x2*)(stats + 2 * (size_t)(row0 + rr)) = (f32x2){mean[rr], rstd[rr]};
        }
        const float* md = modl + (size_t)bi * 6144;
#pragma unroll
        for (int j = 0; j < 4; ++j) { const int c = 4 * lane + 256 * j;
            f32x4 w4 = {1.f, 1.f, 1.f, 1.f}, b4 = {0.f, 0.f, 0.f, 0.f}; if (lw) { w4 = *(const f32x4*)(lw + c); b4 = *(const f32x4*)(lb + c); }
            f32x4 sc4 = {0.f, 0.f, 0.f, 0.f}, sh4 = {0.f, 0.f, 0.f, 0.f}; if (UXp) { sc4 = *(const f32x4*)(md + sc_off + c); sh4 = *(const f32x4*)(md + sh_off + c); }
#pragma unroll
            for (int rr = 0; rr < 4; ++rr) { const int row = row0 + rr; const f32x4 y = v[rr][j] * rstd[rr] * w4 + b4;
                if (final_x) { float* dst = lat ? xl + (size_t)row * DM : xcp + (size_t)(row - TL) * DM; *(f32x4*)(dst + c) = y; }
                if (UXp) { v2u w; w.x = cvtpk(y[0] * (1.f + sc4[0]) + sh4[0], y[1] * (1.f + sc4[1]) + sh4[1]); w.y = cvtpk(y[2] * (1.f + sc4[2]) + sh4[2], y[3] * (1.f + sc4[3]) + sh4[3]); *(v2u*)(UXp + (size_t)row * DM + c) = w; } }
        }
    }
}
#define MFMA32(a, b, c) __builtin_amdgcn_mfma_f32_32x32x16_bf16((a), (b), (c), 0, 0, 0)
__device__ __forceinline__ bf16x8 pack_step(const f32x16& x, int s) {
    v4u p; p.x = cvtpk(x[8 * s + 0], x[8 * s + 1]); p.y = cvtpk(x[8 * s + 2], x[8 * s + 3]); p.z = cvtpk(x[8 * s + 4], x[8 * s + 5]); p.w = cvtpk(x[8 * s + 6], x[8 * s + 7]);
    return __builtin_bit_cast(bf16x8, p);
}
constexpr int G_QE = 0, G_KE = 17408, G_KT = 34816, G_VT = 53248, G_BC = 71680, G_ZS = G_BC + 64 * 528, G_SEG = G_ZS + 4096, G_DEC = G_SEG + 2048, G_END = G_DEC + 512;
static_assert(G_END <= 131072, "gla lds");
constexpr int NCHUNK = 68;

__device__ __forceinline__ int gla_row(int n, int p, int b, int dir) {
    const bool isctx = n < 4; const int nn = isctx ? n : n - 4; const int Ls = isctx ? CTXL : LSEQ; const int Pp = 64 * nn + p;
    const int tok = dir ? (Ls - 1 - Pp) : Pp; return (isctx ? TL + b * CTXL : b * LSEQ) + tok;
}

__device__ __forceinline__ void gla_phase(LAS unsigned char* lds, const bf16* Q, const bf16* K, const bf16* V, const bf16* Z, bf16* OF, bf16* OB,
                                          const float* wgf, const float* bgf, const float* wgb, const float* bgb, const int wave_s) {
    const int lane = lane_id_v(), wid = wave_s, tid = wid * 64 + lane, r = lane & 31, h = lane >> 5, wv = wid & 3, wi = wid >> 2;
    LAS unsigned char* Qe = lds + G_QE; LAS unsigned char* Ke = lds + G_KE; LAS unsigned char* KT = lds + G_KT; LAS unsigned char* VT = lds + G_VT;
    LAS float* Bc = (LAS float*)(lds + G_BC); LAS unsigned char* Zs = lds + G_ZS; LAS float* Seg = (LAS float*)(lds + G_SEG); LAS float* Dec = (LAS float*)(lds + G_DEC);
    for (int w = blockIdx.x; w < 256; w += gridDim.x) {
        const int wm = ((((w & 7) << 4) + (w >> 4)) << 1) | ((w >> 3) & 1);
        const int b = wm >> 4, hh = (wm >> 2) & 3, dir = (wm >> 1) & 1, vh = wm & 1;
        const float* wg = dir ? wgb : wgf; const float* bg = dir ? bgb : bgf; bf16* O = dir ? OB : OF;
        const float bgl = bg[hh * 128 + 32 * wv + r];
        bf16x8 wghi;
        { float wf[8];
#pragma unroll
          for (int j = 0; j < 8; ++j) wf[j] = wg[(8 * h + j) * 512 + hh * 128 + 32 * wv + r];
          v4u ph; ph.x = cvtpk(wf[0], wf[1]); ph.y = cvtpk(wf[2], wf[3]); ph.z = cvtpk(wf[4], wf[5]); ph.w = cvtpk(wf[6], wf[7]);
          wghi = __builtin_bit_cast(bf16x8, ph); }
        f32x16 S[4];
#pragma unroll
        for (int t = 0; t < 4; ++t)
#pragma unroll
            for (int e = 0; e < 16; ++e) S[t][e] = 0.f;
        v4u rq[2], rk[2], rv[2], rz;
        rz = (v4u){0u, 0u, 0u, 0u};
#define GLA_LOAD(n) do { _Pragma("unroll") for (int i = 0; i < 2; ++i) { const int idx = tid + 512 * i, p = idx >> 4, c8 = idx & 15; const size_t row = (size_t)gla_row((n), p, b, dir); \
            rq[i] = *(const v4u*)(Q + row * 512 + hh * 128 + 8 * c8); rk[i] = *(const v4u*)(K + row * 512 + hh * 128 + 8 * c8); rv[i] = *(const v4u*)(V + row * 1024 + hh * 256 + vh * 128 + 8 * c8); } } while (0)
#define GLA_LOADZ(n) do { if (tid < 128) { const size_t row = (size_t)gla_row((n), tid >> 1, b, dir); rz = *(const v4u*)(Z + row * 32 + dir * 16 + 8 * (tid & 1)); } } while (0)
#define GLA_ZSTORE() do { if (tid < 128) *(LAS v4u*)(Zs + (tid >> 1) * 32 + 16 * (tid & 1)) = rz; } while (0)
#define GLA_GATEB() do { const bf16x8 za = *(const LAS bf16x8*)(Zs + (32 * wi + r) * 32 + 16 * h); f32x16 gt_; \
            _Pragma("unroll") for (int e = 0; e < 16; ++e) gt_[e] = 0.f; \
            gt_ = MFMA32(za, wghi, gt_); \
            float c_[16], s_[4], t_[4]; \
            _Pragma("unroll") for (int j = 0; j < 4; ++j) { float run = 0.f; \
                _Pragma("unroll") for (int i = 0; i < 4; ++i) { const float g = gt_[4 * j + i] + bgl; \
                    const float la = (fminf(g, 0.f) - __logf(1.0f + __expf(-fabsf(g)))) * (1.0f / 16.0f); run += la; c_[4 * j + i] = run; } \
                s_[j] = run; } \
            _Pragma("unroll") for (int j = 0; j < 4; ++j) t_[j] = __int_as_float(__builtin_amdgcn_ds_bpermute((lane ^ 32) << 2, __float_as_int(s_[j]))); \
            float offj = 0.f; \
            _Pragma("unroll") for (int j = 0; j < 4; ++j) { const float o_ = offj + (h ? t_[j] : 0.f); \
                _Pragma("unroll") for (int i = 0; i < 4; ++i) Bc[(32 * wi + 8 * j + 4 * h + i) * 132 + 32 * wv + r] = c_[4 * j + i] + o_; \
                offj += s_[j] + t_[j]; } \
            if (h == 0) Seg[wi * 128 + 32 * wv + r] = offj; } while (0)
        GLA_LOAD(0); GLA_LOADZ(0);
        __syncthreads();
        GLA_ZSTORE();
        GLA_LOADZ(1);
        __syncthreads();
        GLA_GATEB();
        for (int n = 0; n < NCHUNK; ++n) {
            __syncthreads();
#pragma unroll
            for (int i = 0; i < 2; ++i) { const int idx = tid + 512 * i, p = idx >> 4, c8 = idx & 15; const int pcol = ((((p >> 3) ^ (c8 & 7)) << 4) + ((p & 7) << 1));
                const f32x4 b0 = *(const LAS f32x4*)(Bc + p * 132 + 8 * c8), b1 = *(const LAS f32x4*)(Bc + p * 132 + 8 * c8 + 4);
                const f32x4 t00 = *(const LAS f32x4*)(Seg + 8 * c8), t01 = *(const LAS f32x4*)(Seg + 8 * c8 + 4), t10 = *(const LAS f32x4*)(Seg + 128 + 8 * c8), t11 = *(const LAS f32x4*)(Seg + 128 + 8 * c8 + 4);
                float qf[8], kf[8], bc[8], dc[8];
                qf[0] = bflo(rq[i].x); qf[1] = bfhi(rq[i].x); qf[2] = bflo(rq[i].y); qf[3] = bfhi(rq[i].y); qf[4] = bflo(rq[i].z); qf[5] = bfhi(rq[i].z); qf[6] = bflo(rq[i].w); qf[7] = bfhi(rq[i].w);
                kf[0] = bflo(rk[i].x); kf[1] = bfhi(rk[i].x); kf[2] = bflo(rk[i].y); kf[3] = bfhi(rk[i].y); kf[4] = bflo(rk[i].z); kf[5] = bfhi(rk[i].z); kf[6] = bflo(rk[i].w); kf[7] = bfhi(rk[i].w);
#pragma unroll
                for (int e = 0; e < 4; ++e) { bc[e] = b0[e] + (p >= 32 ? t00[e] : 0.f); bc[4 + e] = b1[e] + (p >= 32 ? t01[e] : 0.f); dc[e] = __expf(t00[e] + t10[e]); dc[4 + e] = __expf(t01[e] + t11[e]); }
                if (p == 0) { *(LAS f32x4*)(Dec + 8 * c8) = (f32x4){dc[0], dc[1], dc[2], dc[3]}; *(LAS f32x4*)(Dec + 8 * c8 + 4) = (f32x4){dc[4], dc[5], dc[6], dc[7]}; }
                float qe[8], ke[8], kn[8];
#pragma unroll
                for (int e = 0; e < 8; ++e) { const float ex = __expf(bc[e]); const float inv = __builtin_amdgcn_rcpf(ex); qe[e] = qf[e] * ex; ke[e] = kf[e] * inv; kn[e] = ke[e] * dc[e]; }
                v4u wq, wk; wq.x = cvtpk(qe[0], qe[1]); wq.y = cvtpk(qe[2], qe[3]); wq.z = cvtpk(qe[4], qe[5]); wq.w = cvtpk(qe[6], qe[7]);
                wk.x = cvtpk(ke[0], ke[1]); wk.y = cvtpk(ke[2], ke[3]); wk.z = cvtpk(ke[4], ke[5]); wk.w = cvtpk(ke[6], ke[7]);
                *(LAS v4u*)(Qe + p * 272 + 16 * c8) = wq; *(LAS v4u*)(Ke + p * 272 + 16 * c8) = wk;
#pragma unroll
                for (int e = 0; e < 8; e += 2) { const unsigned pk = cvtpk(kn[e], kn[e + 1]);
                    *(LAS unsigned short*)(KT + (8 * c8 + e) * 144 + pcol) = (unsigned short)(pk & 0xffffu); *(LAS unsigned short*)(KT + (8 * c8 + e + 1) * 144 + pcol) = (unsigned short)(pk >> 16); }
                const unsigned vv[4] = {rv[i].x, rv[i].y, rv[i].z, rv[i].w};
#pragma unroll
                for (int e = 0; e < 4; ++e) { *(LAS unsigned short*)(VT + (8 * c8 + 2 * e) * 144 + pcol) = (unsigned short)(vv[e] & 0xffffu); *(LAS unsigned short*)(VT + (8 * c8 + 2 * e + 1) * 144 + pcol) = (unsigned short)(vv[e] >> 16); }
                asm volatile("" ::: "memory");
            }
            GLA_ZSTORE();
            if (n + 2 < NCHUNK) GLA_LOADZ(n + 2);
            if (n + 1 < NCHUNK) GLA_LOAD(n + 1);
            __syncthreads();
            if (wi == 0 && n + 1 < NCHUNK) GLA_GATEB();
            __builtin_amdgcn_s_setprio(1);
            f32x16 oT;
#pragma unroll
            for (int e = 0; e < 16; ++e) oT[e] = 0.f;
            const LAS unsigned char* qrow = Qe + (32 * wi + r) * 272;
            const LAS unsigned char* vrow = VT + (32 * wv + r) * 144;
            {
                f32x16 at0;
#pragma unroll
                for (int e = 0; e < 16; ++e) at0[e] = 0.f;
#pragma unroll
                for (int hb = 0; hb < 2; ++hb) {
                    bf16x8 bq[4], ka[4];
#pragma unroll
                    for (int t = 0; t < 4; ++t) { bq[t] = *(const LAS bf16x8*)(qrow + 32 * (4 * hb + t) + 16 * h); ka[t] = *(const LAS bf16x8*)(Ke + r * 272 + 32 * (4 * hb + t) + 16 * h); }
                    asm volatile("" ::: "memory");
#pragma unroll
                    for (int t = 0; t < 4; ++t) at0 = MFMA32(ka[t], bq[t], at0);
                }
#pragma unroll
                for (int dkt = 0; dkt < 4; ++dkt) {
                    v4u qq[2];
#pragma unroll
                    for (int s2 = 0; s2 < 2; ++s2) { const v2u q0 = *(const LAS v2u*)(qrow + 64 * dkt + 32 * s2 + 8 * h), q1 = *(const LAS v2u*)(qrow + 64 * dkt + 32 * s2 + 8 * h + 16); qq[s2] = (v4u){q0.x, q0.y, q1.x, q1.y}; }
                    asm volatile("" ::: "memory");
#pragma unroll
                    for (int s2 = 0; s2 < 2; ++s2) oT = MFMA32(pack_step(S[dkt], s2), __builtin_bit_cast(bf16x8, qq[s2]), oT);
                }
                const int lim = 32 * wi + r - 4 * h;
                {
                    v4u va[2];
#pragma unroll
                    for (int t = 0; t < 2; ++t) { const v2u v0 = *(const LAS v2u*)(vrow + (((2 * t) ^ ((4 * wv + (r >> 3)) & 7)) << 4) + 8 * h), v1 = *(const LAS v2u*)(vrow + (((2 * t + 1) ^ ((4 * wv + (r >> 3)) & 7)) << 4) + 8 * h); va[t] = (v4u){v0.x, v0.y, v1.x, v1.y}; }
#pragma unroll
                    for (int e = 0; e < 16; ++e) at0[e] = (((e & 3) + 8 * (e >> 2)) > lim) ? 0.f : at0[e];
#pragma unroll
                    for (int s2 = 0; s2 < 2; ++s2) oT = MFMA32(__builtin_bit_cast(bf16x8, va[s2]), pack_step(at0, s2), oT);
                }
                if (wi) {
                    f32x16 at1;
#pragma unroll
                    for (int e = 0; e < 16; ++e) at1[e] = 0.f;
#pragma unroll
                    for (int hb = 0; hb < 2; ++hb) {
                        bf16x8 bq[4], ka[4];
#pragma unroll
                        for (int t = 0; t < 4; ++t) { bq[t] = *(const LAS bf16x8*)(qrow + 32 * (4 * hb + t) + 16 * h); ka[t] = *(const LAS bf16x8*)(Ke + (32 + r) * 272 + 32 * (4 * hb + t) + 16 * h); }
                        asm volatile("" ::: "memory");
#pragma unroll
                        for (int t = 0; t < 4; ++t) at1 = MFMA32(ka[t], bq[t], at1);
                    }
                    v4u va[2];
#pragma unroll
                    for (int t = 0; t < 2; ++t) { const v2u v0 = *(const LAS v2u*)(vrow + (((4 + 2 * t) ^ ((4 * wv + (r >> 3)) & 7)) << 4) + 8 * h), v1 = *(const LAS v2u*)(vrow + (((4 + 2 * t + 1) ^ ((4 * wv + (r >> 3)) & 7)) << 4) + 8 * h); va[t] = (v4u){v0.x, v0.y, v1.x, v1.y}; }
#pragma unroll
                    for (int e = 0; e < 16; ++e) at1[e] = ((32 + (e & 3) + 8 * (e >> 2)) > lim) ? 0.f : at1[e];
#pragma unroll
                    for (int s2 = 0; s2 < 2; ++s2) oT = MFMA32(__builtin_bit_cast(bf16x8, va[s2]), pack_step(at1, s2), oT);
                }
            }
            {
                bf16x8 vt[4];
#pragma unroll
                for (int t = 0; t < 4; ++t) vt[t] = *(const LAS bf16x8*)(vrow + (((2 * t + h) ^ ((4 * wv + (r >> 3)) & 7)) << 4));
#pragma unroll
                for (int dkt = 0; dkt < 4; ++dkt) {
                    bf16x8 kt[4]; f32x4 dd[4];
#pragma unroll
                    for (int t = 0; t < 4; ++t) { kt[t] = *(const LAS bf16x8*)(KT + (32 * dkt + r) * 144 + (((2 * t + h) ^ ((4 * dkt + (r >> 3)) & 7)) << 4)); dd[t] = *(const LAS f32x4*)(Dec + 32 * dkt + 8 * t + 4 * h); }
                    asm volatile("" ::: "memory");
#pragma unroll
                    for (int g4 = 0; g4 < 4; ++g4)
#pragma unroll
                        for (int e = 0; e < 4; ++e) S[dkt][4 * g4 + e] *= dd[g4][e];
#pragma unroll
                    for (int t = 0; t < 4; ++t) S[dkt] = MFMA32(kt[t], vt[t], S[dkt]);
                }
            }
            __builtin_amdgcn_s_setprio(0);
            if (wi == 1 && n + 1 < NCHUNK) GLA_GATEB();
            { const size_t row = (size_t)gla_row(n, 32 * wi + r, b, dir); bf16* op = O + row * 1024 + hh * 256 + vh * 128 + 32 * wv + 4 * h;
#pragma unroll
              for (int g4 = 0; g4 < 4; ++g4) { v2u w2; w2.x = cvtpk(oT[4 * g4], oT[4 * g4 + 1]); w2.y = cvtpk(oT[4 * g4 + 2], oT[4 * g4 + 3]); *(v2u*)(op + 8 * g4) = w2; } }
        }
#undef GLA_LOAD
#undef GLA_LOADZ
#undef GLA_ZSTORE
#undef GLA_GATEB
    }
}

#define KA() const P __attribute__((address_space(4)))* ka_ = (const P __attribute__((address_space(4)))*)__builtin_amdgcn_kernarg_segment_ptr(); asm volatile("" : "+s"(ka_)); unsigned char* ws = ka_->ws; float* xl = ka_->out; (void)xl; (void)ws;
constexpr size_t WS_BAR = 512 * 1024;
constexpr int LDS_ST = 131072;
constexpr int LDS_XCH = 131072 + 1024;
#define XB_TMO      128
#define XB_XCNT(j)  (256  + 64 * (j))
#define XB_XSUB(j)  (1280 + 64 * (j))
#define XB_XGEN(j)  (2304 + 64 * (j))
#define XB_TOP      3328
#define XB_TOPGEN   3392
#define XCD_BAR_WORDS 3456
#define XB_SPIN_CAP (1u << 22)
__device__ __forceinline__ unsigned xb_ld(unsigned* p)              { return __hip_atomic_load(p, __ATOMIC_RELAXED, __HIP_MEMORY_SCOPE_AGENT); }
__device__ __forceinline__ unsigned xb_add(unsigned* p, unsigned v) { return __hip_atomic_fetch_add(p, v, __ATOMIC_RELAXED, __HIP_MEMORY_SCOPE_AGENT); }
__device__ __forceinline__ unsigned xb_xcc_id() { return (unsigned)__builtin_amdgcn_s_getreg((3 << 11) | 20) & 0xFu; }
#define XB_SPIN(cond, bar) do { unsigned _sp = 0; while (cond) { __builtin_amdgcn_s_sleep(1); \
    if ((++_sp & 255u) == 0u) { if (xb_ld(&(bar)[XB_TMO])) break; if (_sp > XB_SPIN_CAP) { atomicAdd(&(bar)[XB_TMO], 1u); break; } } } } while (0)
__device__ __forceinline__ void xcd_barrier_complete(unsigned* bar, unsigned x, unsigned& nloc, unsigned& nx) {
    const unsigned G = gridDim.x * gridDim.y * gridDim.z;
    unsigned sum, cnt, mine, sp = 0u;
    for (;;) {
        sum = 0u; cnt = 0u; mine = 0u;
#pragma unroll
        for (unsigned j = 0; j < 16; ++j) { const unsigned c = xb_ld(&bar[XB_XCNT(j)]); sum += c; cnt += (c > 0u) ? 1u : 0u; mine = (j == x) ? c : mine; }
        if (sum == G) break;
        __builtin_amdgcn_s_sleep(1);
        if ((++sp & 255u) == 0u) { if (xb_ld(&bar[XB_TMO])) break; if (sp > XB_SPIN_CAP) { atomicAdd(&bar[XB_TMO], 1u); break; } }
    }
    nloc = mine > 0u ? mine : 1u; nx = cnt > 0u ? cnt : 1u;
}
__device__ __forceinline__ void grid_barrier(unsigned char* wsb, LAS unsigned char* lds, const int wave_s) {
    asm volatile("s_waitcnt vmcnt(0)" ::: "memory");
    __syncthreads();
    if (wave_s == 0 && lane_id_v() == 0) {
        unsigned* bar = (unsigned*)(wsb + WS_BAR);
        volatile LAS unsigned* st = (volatile LAS unsigned*)(lds + LDS_ST);
        const unsigned x = xb_xcc_id();
        __builtin_amdgcn_s_waitcnt(0);
        unsigned nloc = st[0], nx = st[1];
        if (nloc == 0u) { xcd_barrier_complete(bar, x, nloc, nx); st[0] = nloc; st[1] = nx; }
        const unsigned old = xb_add(&bar[XB_XSUB(x)], 1u);
        const unsigned gen = old / nloc;
        if (old + 1u == (gen + 1u) * nloc) {
            __builtin_amdgcn_fence(__ATOMIC_RELEASE, "agent");
            asm volatile("s_waitcnt vmcnt(0)" ::: "memory");
            const unsigned og = xb_add(&bar[XB_TOP], 1u);
            const unsigned tg = og / nx;
            if (og + 1u == (tg + 1u) * nx) xb_add(&bar[XB_TOPGEN], 1u);
            else XB_SPIN(xb_ld(&bar[XB_TOPGEN]) == tg, bar);
            __builtin_amdgcn_fence(__ATOMIC_ACQUIRE, "agent");
            xb_add(&bar[XB_XGEN(x)], 1u);
            asm volatile("s_waitcnt vmcnt(0)" ::: "memory");
        } else {
            XB_SPIN(xb_ld(&bar[XB_XGEN(x)]) == gen, bar);
            __builtin_amdgcn_fence(__ATOMIC_ACQUIRE, "agent");
            asm volatile("s_waitcnt vmcnt(0)" ::: "memory");
        }
    }
    __syncthreads();
}
#define GSYNC() do { KA(); grid_barrier(ws, lds, wave_s); } while (0)
#define x_in (ka_->in[0])
#define c_in (ka_->in[1])
#define ctx_in (ka_->in[2])
#define cctx_in (ka_->in[3])
#define w_mod (ka_->in[4])
#define b_mod (ka_->in[5])
#define w_in (ka_->in[6])
#define w_gate_f (ka_->in[7])
#define b_gate_f (ka_->in[8])
#define w_gate_b (ka_->in[9])
#define b_gate_b (ka_->in[10])
#define gla_norm_w (ka_->in[11])
#define w_pool (ka_->in[12])
#define pool_scale (ka_->in[13])
#define w_br_pool (ka_->in[14])
#define w_br_gla (ka_->in[15])
#define w_out (ka_->in[16])
#define ln1_w (ka_->in[17])
#define ln1_b (ka_->in[18])
#define w_up (ka_->in[19])
#define conv_w (ka_->in[20])
#define conv_b (ka_->in[21])
#define w_down (ka_->in[22])
#define ln2_w (ka_->in[23])
#define ln2_b (ka_->in[24])
#define POS ((float*)(ws + WS_POS))
#define MOD ((float*)(ws + WS_MOD))
#define W1T ((bf16*)(ws + WS_W1T))
#define W2T ((bf16*)(ws + WS_W2T))
#define WPT ((bf16*)(ws + WS_WPT))
#define WGT ((bf16*)(ws + WS_WGT))
#define WOT ((bf16*)(ws + WS_WOT))
#define WUT ((bf16*)(ws + WS_WUT))
#define WDT ((bf16*)(ws + WS_WDT))
#define xc ((float*)(ws + WS_XC))
#define UX ((bf16*)(ws + WS_UX))
#define Qb ((bf16*)(ws + WS_R + R_Q))
#define Kb ((bf16*)(ws + WS_R + R_K))
#define Vb ((bf16*)(ws + WS_R + R_V))
#define OFb ((bf16*)(ws + WS_R + R_OF))
#define OBb ((bf16*)(ws + WS_R + R_OB))
#define Zb ((bf16*)(ws + WS_R + R_Z))
#define POOLb ((bf16*)(ws + WS_R + R_POOL))
#define GPb ((bf16*)(ws + WS_R + R_GP))
#define GGb ((bf16*)(ws + WS_R + R_GG))
#define POOLEDb ((bf16*)(ws + WS_R + R_POOLED))
#define HIDb ((bf16*)(ws + WS_R + R_HID))
#define STATS ((float*)(ws + WS_STATS))
#define FRESH() KA(); const int lane = lane_id_v(), wave = wave_s, tid = wave * 64 + lane, gw = blockIdx.x * 8 + wave, gt = blockIdx.x * NTHREADS + tid; (void)lane; (void)gw; (void)gt; (void)wave;
template <int l> __device__ __forceinline__ void layer_body(LAS unsigned char* lds, const int wave_s) {
    const int G = gridDim.x, NGW = G * 8, NGT = G * NTHREADS; (void)NGW; (void)NGT;
        const bool last = (l == DEPTH - 1);
        const int nMall = TT / 256, nMpost = last ? TL / 256 : TT / 256, rows_post = nMpost * 256;
        { KA(); EpiA1 E{Qb, Kb, Vb, Zb}; run_gemm(lds, UX, W1T + (size_t)l * N1 * 1024, nMall, N1, 1024, E, wave_s); }
        GSYNC();
        { KA(); gla_phase(lds, Qb, Kb, Vb, Zb, OFb, OBb, w_gate_f + (size_t)l * 16 * 512, b_gate_f + l * 512, w_gate_b + (size_t)l * 16 * 512, b_gate_b + l * 512, wave_s); }
        GSYNC();
        { KA(); EpiA2 E{POOLb, OFb, GPb, GGb, OBb, gla_norm_w + l * 1024, (LAS float*)(lds + LDS_XCH)}; run_gemm<EpiA2, true>(lds, UX, W2T + (size_t)l * N2 * 1024, nMpost, N2, 1024, E, wave_s); }
        GSYNC();
        { FRESH();
        for (int row = gw; row < rows_post; row += NGW) {
            int pos, Ls; if (row < TL) { pos = row & 63; Ls = 64; } else { pos = (row - TL) & 255; Ls = 256; }
            const int hw = 1 << (lane >> 4);
            const int lo = max(pos - hw, 0), hi = min(pos + hw, Ls);
            const bf16* base = POOLb + (size_t)(row - pos) * 512 + 8 * lane;
            float s[8];
#pragma unroll
            for (int e = 0; e < 8; ++e) s[e] = 0.f;
            v4u av[16];
#pragma unroll
            for (int k = 0; k < 16; ++k) { const int p = lo + k; const int pc = p < hi ? p : pos; av[k] = *(const v4u*)(base + (size_t)pc * 512); }
#pragma unroll
            for (int k = 0; k < 16; ++k) { const float vm = (lo + k < hi) ? 1.f : 0.f; const v4u a = av[k];
                s[0] += vm * bflo(a.x); s[1] += vm * bfhi(a.x); s[2] += vm * bflo(a.y); s[3] += vm * bfhi(a.y); s[4] += vm * bflo(a.z); s[5] += vm * bfhi(a.z); s[6] += vm * bflo(a.w); s[7] += vm * bfhi(a.w); }
            const v4u me = *(const v4u*)(base + (size_t)pos * 512); const float inv = 1.0f / (float)(hi - lo);
            v4u w; w.x = cvtpk(s[0] * inv - bflo(me.x), s[1] * inv - bfhi(me.x)); w.y = cvtpk(s[2] * inv - bflo(me.y), s[3] * inv - bfhi(me.y));
            w.z = cvtpk(s[4] * inv - bflo(me.z), s[5] * inv - bfhi(me.z)); w.w = cvtpk(s[6] * inv - bflo(me.w), s[7] * inv - bfhi(me.w));
            *(v4u*)(POOLEDb + (size_t)row * 512 + 8 * lane) = w;
        } }
        GSYNC();
        { KA(); EpiMul E{GPb}; run_gemm(lds, POOLEDb, WPT + (size_t)l * 1024 * 512, nMpost, 1024, 512, E, wave_s); }
        { KA(); EpiMulAdd E{GGb, GPb}; run_gemm(lds, OFb, WGT + (size_t)l * 1024 * 1024, nMpost, 1024, 1024, E, wave_s); }
        GSYNC();
        { KA(); EpiRes E{xl, xc, MOD + (size_t)l * 17 * 6144 + 2048, 0, STATS, l > 0 ? ln2_w + (l - 1) * 1024 : (const float*)nullptr, l > 0 ? ln2_b + (l - 1) * 1024 : (const float*)nullptr}; run_gemm(lds, GGb, WOT + (size_t)l * 1024 * 1024, nMpost, 1024, 1024, E, wave_s); }
        GSYNC();
        { FRESH(); ln_phase(lane, gw, NGW, rows_post, xl, xc, ln1_w + l * 1024, ln1_b + l * 1024, MOD + (size_t)l * 17 * 6144, 3072, 4096, UX, nullptr, nullptr, nullptr, STATS, false); }
        GSYNC();
        { KA(); EpiUpConv E{HIDb, conv_w + (size_t)l * 3 * FF, conv_b + (size_t)l * FF, (LAS float*)(lds + LDS_XCH)}; run_gemm<EpiUpConv, true>(lds, UX, WUT + (size_t)l * NU * 1024, nMpost, NU, 1024, E, wave_s); }
        GSYNC();
        { KA(); EpiRes E{xl, xc, MOD + (size_t)l * 17 * 6144 + 5120, 0, STATS, ln1_w + l * 1024, ln1_b + l * 1024}; run_gemm(lds, HIDb, WDT + (size_t)l * 1024 * FF, nMpost, 1024, FF, E, wave_s); }
        GSYNC();
        { FRESH(); ln_phase(lane, gw, NGW, rows_post, xl, xc, ln2_w + l * 1024, ln2_b + l * 1024, MOD + (size_t)(last ? l : l + 1) * 17 * 6144, 0, 1024, last ? (bf16*)nullptr : UX, nullptr, nullptr, nullptr, STATS, last); }
        if (!last) GSYNC();
}

__global__ void __launch_bounds__(NTHREADS, 2) fwd_mega(P prm) {
    extern __shared__ __attribute__((aligned(16))) unsigned char lds_raw[];
    LAS unsigned char* lds = (LAS unsigned char*)lds_raw;
    cg::grid_group grid = cg::this_grid();
    const int G = gridDim.x, NGW = G * 8, NGT = G * NTHREADS;
    const int wave_s = __builtin_amdgcn_readfirstlane(threadIdx.x >> 6);
    if (threadIdx.x < 64) ((LAS unsigned*)(lds + LDS_ST))[threadIdx.x] = 0u;
    __syncthreads();
    if (threadIdx.x == 0) (void)xb_add((unsigned*)(prm.ws + WS_BAR) + XB_XCNT(xb_xcc_id()), 1u);
    {
        FRESH();
        LAS float* sc = (LAS float*)lds;
        LAS float* part = (LAS float*)(lds + 69632);
        for (int i = tid; i < 17 * 1024; i += NTHREADS) { const float v = i < 16 * 1024 ? c_in[i] : cctx_in[i - 16 * 1024]; sc[i] = v * sigmoidf_(v); }
        __syncthreads();
        for (int it = blockIdx.x; it < 4 * 96; it += G) {
            const int l = it / 96, j0 = (it % 96) * 64, jl = tid & 63, kp = tid >> 6;
            float acc[17];
#pragma unroll
            for (int bi = 0; bi < 17; ++bi) acc[bi] = 0.f;
            const float* wp = w_mod + (size_t)l * 1024 * 6144 + (size_t)(kp * 128) * 6144 + j0 + jl;
            for (int k0 = 0; k0 < 128; k0 += 16) { float wv_[16];
#pragma unroll
                for (int k = 0; k < 16; ++k) wv_[k] = wp[(size_t)(k0 + k) * 6144];
#pragma unroll
                for (int k = 0; k < 16; ++k) { const int kk = kp * 128 + k0 + k;
#pragma unroll
                    for (int bi = 0; bi < 17; ++bi) acc[bi] += sc[bi * 1024 + kk] * wv_[k]; } }
#pragma unroll
            for (int bi = 0; bi < 17; ++bi) part[(kp * 17 + bi) * 64 + jl] = acc[bi];
            __syncthreads();
            for (int o = tid; o < 17 * 64; o += NTHREADS) { const int bi = o >> 6, j = o & 63; float s = b_mod[l * 6144 + j0 + j];
#pragma unroll
                for (int q = 0; q < 8; ++q) s += part[(q * 17 + bi) * 64 + j];
                MOD[((size_t)l * 17 + bi) * 6144 + j0 + j] = s; }
            __syncthreads();
        }
        for (int i = gt; i < 64 * 512; i += NGT) { const int p = i >> 9, q = i & 511, fi = q & 255;
            const double om = exp(-9.210340371976184 * (double)fi / 256.0); double rev = (double)p * om * 0.15915494309189535; rev -= floor(rev);
            POS[i] = (q < 256) ? __builtin_amdgcn_sinf((float)rev) : __builtin_amdgcn_cosf((float)rev); }
        for (int i = gt; i < 4 * 64 * 1024; i += NGT) { const int n = i & 1023, kg = (i >> 10) & 63, l = i >> 16, g = kg >> 4, c0 = (kg & 15) * 8;
            float acc[8];
#pragma unroll
            for (int e = 0; e < 8; ++e) acc[e] = 0.f;
            const float* wpl = w_pool + ((size_t)(l * 4 + g) * 128 + c0) * 128; const float* ps = pool_scale + l * 512 + g * 128; const float* wb = w_br_pool + ((size_t)l * 512 + g * 128) * 1024 + n;
            for (int d0 = 0; d0 < 128; d0 += 16) { float t[16];
#pragma unroll
                for (int d = 0; d < 16; ++d) t[d] = wb[(size_t)(d0 + d) * 1024];
#pragma unroll
                for (int d = 0; d < 16; ++d) { const float tt = t[d] * ps[d0 + d];
#pragma unroll
                    for (int e = 0; e < 8; ++e) acc[e] += wpl[e * 128 + d0 + d] * tt; } }
            v4u o; o.x = cvtpk(acc[0], acc[1]); o.y = cvtpk(acc[2], acc[3]); o.z = cvtpk(acc[4], acc[5]); o.w = cvtpk(acc[6], acc[7]);
            *(v4u*)(WPT + ((size_t)l * 1024 + n) * 512 + g * 128 + c0) = o; }
        LAS float* scr = (LAS float*)(lds + wave * 16384);
        for (int it = gw; it < 4 * 8192; it += NGW) {
            const int l = it >> 13; int rr = it & 8191;
            if (rr < 1152) { const int kb = rr / 72, nb = rr % 72, d0 = nb * 32; const int s0 = d0 < 2048 ? 512 + d0 : (d0 < 2080 ? 3584 + (d0 - 2048) : -1);
                transpose_block(w_in + (size_t)l * 1024 * NIN, NIN, s0, kb * 64, W1T + (size_t)l * N1 * 1024, 1024, d0, scr, lane); continue; } rr -= 1152;
            if (rr < 1792) { const int kb = rr / 112, nb = rr % 112, d0 = nb * 32; const int s0 = d0 < 512 ? d0 : (d0 < 1536 ? 2560 + (d0 - 512) : 3616 + (d0 - 1536));
                transpose_block(w_in + (size_t)l * 1024 * NIN, NIN, s0, kb * 64, W2T + (size_t)l * N2 * 1024, 1024, d0, scr, lane); continue; } rr -= 1792;
            if (rr < 512) { const int kb = rr / 32, nb = rr % 32; transpose_block(w_br_gla + (size_t)l * 1024 * 1024, 1024, nb * 32, kb * 64, WGT + (size_t)l * 1024 * 1024, 1024, nb * 32, scr, lane); continue; } rr -= 512;
            if (rr < 512) { const int kb = rr / 32, nb = rr % 32; transpose_block(w_out + (size_t)l * 1024 * 1024, 1024, nb * 32, kb * 64, WOT + (size_t)l * 1024 * 1024, 1024, nb * 32, scr, lane); continue; } rr -= 512;
            if (rr < 2816) { const int kb = rr / 176, nb = rr % 176, d0 = nb * 32, pn = d0 >> 8, wq = d0 & 255; const int s0 = wq < 128 ? 128 * pn + wq : FF + 128 * pn + (wq - 128);
                transpose_block(w_up + (size_t)l * 1024 * NU, NU, s0, kb * 64, WUT + (size_t)l * NU * 1024, 1024, d0, scr, lane); continue; } rr -= 2816;
            { const int kb = rr / 32, nb = rr % 32; transpose_block(w_down + (size_t)l * FF * 1024, 1024, nb * 32, kb * 64, WDT + (size_t)l * 1024 * FF, FF, nb * 32, scr, lane); }
        }
    }
    grid.sync();
    { FRESH(); ln_phase(lane, gw, NGW, TT, xl, xc, nullptr, nullptr, MOD, 0, 1024, UX, x_in, ctx_in, POS, STATS, false); }
    GSYNC();

    layer_body<0>(lds, wave_s); layer_body<1>(lds, wave_s); layer_body<2>(lds, wave_s); layer_body<3>(lds, wave_s);
}

extern "C" void kernel_launch(void* const* d_in, const int* in_sizes, int n_in, void* d_out, int out_size, void* d_ws, size_t ws_size, hipStream_t stream) {
    static int grid = 0;
    if (grid == 0) {
        if (n_in != 25 || out_size != TL * DM || ws_size < WS_END) { fprintf(stderr, "kernel_launch: unexpected shapes (n_in %d out %d ws %zu need %zu)\n", n_in, out_size, ws_size, (size_t)WS_END); grid = -1; return; }
        int dev = 0, cus = 0, per_cu = 0;
        if (hipGetDevice(&dev) != hipSuccess || hipDeviceGetAttribute(&cus, hipDeviceAttributeMultiprocessorCount, dev) != hipSuccess) { grid = -1; return; }
        if (hipFuncSetAttribute((const void*)fwd_mega, hipFuncAttributeMaxDynamicSharedMemorySize, LDS_BYTES) != hipSuccess) { fprintf(stderr, "hipFuncSetAttribute failed\n"); grid = -1; return; }
        if (hipOccupancyMaxActiveBlocksPerMultiprocessor(&per_cu, (const void*)fwd_mega, NTHREADS, LDS_BYTES) != hipSuccess || per_cu < 1) { fprintf(stderr, "occupancy query: %d\n", per_cu); per_cu = 1; }
        (void)hipGetLastError();
        grid = cus;
    }
    if (grid < 0) return;
    if (hipMemsetAsync((char*)d_ws + WS_BAR, 0, 16384, stream) != hipSuccess) { fprintf(stderr, "memset failed\n"); return; }
    P prm{};
    for (int i = 0; i < 25; ++i) prm.in[i] = (const float*)d_in[i];
    prm.out = (float*)d_out; prm.ws = (unsigned char*)d_ws;
    void* args[] = {&prm};
    hipError_t e = hipLaunchCooperativeKernel((const void*)fwd_mega, dim3(grid), dim3(NTHREADS), args, LDS_BYTES, stream);
    if (e != hipSuccess) fprintf(stderr, "cooperative launch failed: %s\n", hipGetErrorString(e));
}
```
